# Optimizing an MI355X kernel written in HIP

```python
import jax, jax.numpy as jnp
from jax import lax
import numpy as np

D_MODEL = 2048
BATCH = 2
SEQ = 4096
DEPTH = 2

EPS = 1e-6
N_EVEN = (DEPTH + 1) // 2
N_ODD = DEPTH // 2

D_MLSTM = D_MODEL // 2
MLSTM_HEADS = 4
MLSTM_DH = D_MLSTM // MLSTM_HEADS
MLSTM_CHUNK = 64
CONV_K = 4
D_POOL = D_MODEL // 2
POOL_WINDOWS = (2, 4, 8, 16)
POOL_GROUPS = len(POOL_WINDOWS)
POOL_DG = D_POOL // POOL_GROUPS
D_MIX = D_MLSTM + D_POOL
D_IN_EVEN = 4 * D_MLSTM + 2 * MLSTM_HEADS + D_POOL
D_FF = 5632

SB_HEADS = 16
SB_DH = D_MODEL // SB_HEADS
SB_BLOCK = 128
N_EXPERTS = 8
TOP_K = 2
D_FF_EXPERT = 7168

kernel_name = "hybrid_mlstm_pool_stickbreak_moe_adaln"

F32 = jnp.float32


def rmsnorm(x, g):
    xf = x.astype(F32)
    y = xf * lax.rsqrt(jnp.mean(xf * xf, axis=-1, keepdims=True) + EPS)
    return (y * g.astype(F32)).astype(x.dtype)


def modulate(h, shift, scale):
    return h * (1 + scale[:, None, :]) + shift[:, None, :]


def causal_depthwise_conv(x, w, b):
    C = x.shape[-1]
    y = lax.conv_general_dilated(
        x, w[:, None, :].astype(x.dtype), window_strides=(1,),
        padding=[(CONV_K - 1, 0)], dimension_numbers=("NWC", "WIO", "NWC"),
        feature_group_count=C)
    return y + b.astype(x.dtype)


def mlstm_chunkwise(q, k, v, i_raw, f_raw):
    B, H, S, dh = q.shape
    L = MLSTM_CHUNK
    NC = S // L
    dtype = v.dtype
    q = q.astype(F32) * (dh ** -0.5)
    k = k.astype(F32)
    v = v.astype(F32)
    logf = jax.nn.log_sigmoid(f_raw.astype(F32))
    i_raw = i_raw.astype(F32)

    def to_chunks(a):
        a = a.reshape(a.shape[:2] + (NC, L) + a.shape[3:])
        return jnp.moveaxis(a, 2, 0)

    qc, kc, vc, ic = to_chunks(q), to_chunks(k), to_chunks(v), to_chunks(i_raw)
    bc = jnp.cumsum(to_chunks(logf), axis=-1)
    causal = jnp.tril(jnp.ones((L, L), dtype=bool))

    def step(carry, xs):
        C, n, m = carry
        qb, kb, vb, ib, bb = xs
        D = bb[..., :, None] - bb[..., None, :] + ib[..., None, :]
        D = jnp.where(causal, D, -jnp.inf)
        inter = bb + m[..., None]
        m_t = jnp.maximum(inter, jnp.max(D, axis=-1))
        w_inter = jnp.exp(inter - m_t)
        W = jnp.exp(D - m_t[..., None]) * jnp.einsum("bhtd,bhsd->bhts", qb, kb)
        num = (w_inter[..., None] * jnp.einsum("bhtd,bhde->bhte", qb, C)
               + jnp.einsum("bhts,bhse->bhte", W, vb))
        den = w_inter * jnp.einsum("bhtd,bhd->bht", qb, n) + jnp.sum(W, axis=-1)
        h = num / jnp.maximum(jnp.abs(den), jnp.exp(-m_t))[..., None]
        g = bb[..., -1]
        wl = g[..., None] - bb + ib
        m_new = jnp.maximum(g + m, jnp.max(wl, axis=-1))
        decay = jnp.exp(g + m - m_new)
        wk = jnp.exp(wl - m_new[..., None])[..., None] * kb
        C_new = decay[..., None, None] * C + jnp.einsum("bhsd,bhse->bhde", wk, vb)
        n_new = decay[..., None] * n + jnp.sum(wk, axis=-2)
        return (C_new, n_new, m_new), h

    init = (jnp.zeros((B, H, dh, dh), F32), jnp.zeros((B, H, dh), F32), jnp.zeros((B, H), F32))
    _, hc = lax.scan(step, init, (qc, kc, vc, ic, bc))
    return jnp.moveaxis(hc, 0, 2).reshape(B, H, S, dh).astype(dtype)


def multiscale_pool(xp, pool_w, pool_scale):
    B, S, _ = xp.shape
    xg = xp.reshape(B, S, POOL_GROUPS, POOL_DG).astype(F32)
    cs = jnp.cumsum(xg, axis=1)
    pos = jnp.arange(S)
    outs = []
    for g, w in enumerate(POOL_WINDOWS):
        c_g = cs[:, :, g]
        lagged = jnp.pad(c_g, ((0, 0), (w, 0), (0, 0)))[:, :S]
        cnt = jnp.minimum(pos + 1, w).astype(F32)[None, :, None]
        outs.append((c_g - lagged) / cnt - xg[:, :, g])
    pooled = jnp.stack(outs, axis=2).astype(xp.dtype)
    mixed = jnp.einsum("bsgc,gcd->bsgd", pooled, pool_w)
    return mixed.reshape(B, S, D_POOL) * pool_scale


def mlstm_pool_mixer(h, w_in, b_gates, conv_w, conv_b, head_g, pool_w, pool_scale, w_out):
    B, S, _ = h.shape
    proj = h @ w_in
    qk, v, o, gates, xp = jnp.split(
        proj, [2 * D_MLSTM, 3 * D_MLSTM, 4 * D_MLSTM, 4 * D_MLSTM + 2 * MLSTM_HEADS], axis=-1)
    qk = jax.nn.silu(causal_depthwise_conv(qk, conv_w, conv_b))
    q, k = jnp.split(qk, 2, axis=-1)
    gates = gates.astype(F32) + b_gates.astype(F32)
    i_raw, f_raw = jnp.split(gates, 2, axis=-1)

    def heads(a):
        return a.reshape(B, S, MLSTM_HEADS, MLSTM_DH).transpose(0, 2, 1, 3)

    hm = mlstm_chunkwise(heads(q), heads(k), heads(v),
                         i_raw.transpose(0, 2, 1), f_raw.transpose(0, 2, 1))
    hm = rmsnorm(hm.transpose(0, 2, 1, 3), head_g.reshape(MLSTM_HEADS, MLSTM_DH))
    hm = hm.reshape(B, S, D_MLSTM) * jax.nn.sigmoid(o)
    hp = multiscale_pool(xp, pool_w, pool_scale)
    return jnp.concatenate([hm, hp], axis=-1) @ w_out


def stick_breaking_attention(q, k, v):
    B, S, H, dh = q.shape
    scale = dh ** -0.5
    outs = []
    for blk in range(S // SB_BLOCK):
        t0 = blk * SB_BLOCK
        t1 = t0 + SB_BLOCK
        qb, kb, vb = q[:, t0:t1], k[:, :t1], v[:, :t1]
        z = jnp.einsum("bthd,bshd->bhts", qb, kb).astype(F32) * scale
        strict = jnp.arange(t1)[None, :] < (t0 + jnp.arange(SB_BLOCK))[:, None]
        log_one_minus = jnp.where(strict, jax.nn.log_sigmoid(-z), 0.0)
        log_remain = lax.cumsum(log_one_minus, axis=3, reverse=True) - log_one_minus
        A = jnp.where(strict, jnp.exp(jax.nn.log_sigmoid(z) + log_remain), 0.0)
        outs.append(jnp.einsum("bhts,bshd->bthd", A.astype(v.dtype), vb))
    return jnp.concatenate(outs, axis=1)


def stick_breaking_mixer(h, w_qkv, w_o):
    B, S, _ = h.shape
    q, k, v = jnp.split(h @ w_qkv, 3, axis=-1)
    shp = (B, S, SB_HEADS, SB_DH)
    o = stick_breaking_attention(q.reshape(shp), k.reshape(shp), v.reshape(shp))
    return o.reshape(B, S, D_MODEL) @ w_o


def swiglu(h, w1, w3, w2):
    return (jax.nn.silu(h @ w1) * (h @ w3)) @ w2


def moe_swiglu(h, w_router, w1, w3, w2):
    B, S, D = h.shape
    t = h.reshape(B * S, D)
    logits = (t @ w_router).astype(F32)
    top_val, top_idx = lax.top_k(logits, TOP_K)
    gate = jax.nn.softmax(top_val, axis=-1)
    combine = jnp.sum(jax.nn.one_hot(top_idx, N_EXPERTS, dtype=F32) * gate[..., None], axis=1)
    combine = combine.astype(t.dtype)
    out = jnp.zeros_like(t)
    for e in range(N_EXPERTS):
        out = out + combine[:, e:e + 1] * swiglu(t, w1[e], w3[e], w2[e])
    return out.reshape(B, S, D)


def setup_inputs(seed: int = 0) -> dict:
    key = jax.random.key(seed)
    ks = jax.random.split(key, 26)

    def nrm(k, shape, s):
        return jax.random.normal(k, shape, F32) * s

    x = nrm(ks[0], (BATCH, SEQ, D_MODEL), 1.0)
    c = nrm(ks[1], (BATCH, D_MODEL), 1.0)
    ada_w = nrm(ks[2], (DEPTH, D_MODEL, 6 * D_MODEL), 0.5 * D_MODEL ** -0.5)
    ada_b = nrm(ks[3], (DEPTH, 6 * D_MODEL), 0.02)
    norm_mix_g = 1.0 + nrm(ks[4], (DEPTH, D_MODEL), 0.05)
    norm_ffn_g = 1.0 + nrm(ks[5], (DEPTH, D_MODEL), 0.05)
    norm_final_g = 1.0 + nrm(ks[6], (D_MODEL,), 0.05)
    ev_w_in = nrm(ks[7], (N_EVEN, D_MODEL, D_IN_EVEN), D_MODEL ** -0.5)
    i_bias = nrm(ks[8], (N_EVEN, MLSTM_HEADS), 0.1)
    f_bias = jnp.linspace(3.0, 6.0, MLSTM_HEADS, dtype=F32) + nrm(ks[9], (N_EVEN, MLSTM_HEADS), 0.1)
    ev_b_gates = jnp.concatenate([i_bias, f_bias], axis=-1)
    ev_conv_w = nrm(ks[10], (N_EVEN, CONV_K, 2 * D_MLSTM), CONV_K ** -0.5)
    ev_conv_b = nrm(ks[11], (N_EVEN, 2 * D_MLSTM), 0.02)
    ev_head_g = 1.0 + nrm(ks[12], (N_EVEN, D_MLSTM), 0.05)
    ev_pool_w = nrm(ks[13], (N_EVEN, POOL_GROUPS, POOL_DG, POOL_DG), POOL_DG ** -0.5)
    ev_pool_scale = 1.0 + nrm(ks[14], (N_EVEN, D_POOL), 0.1)
    ev_w_out = nrm(ks[15], (N_EVEN, D_MIX, D_MODEL), D_MIX ** -0.5)
    ev_ffn_w1 = nrm(ks[16], (N_EVEN, D_MODEL, D_FF), D_MODEL ** -0.5)
    ev_ffn_w3 = nrm(ks[17], (N_EVEN, D_MODEL, D_FF), D_MODEL ** -0.5)
    ev_ffn_w2 = nrm(ks[18], (N_EVEN, D_FF, D_MODEL), D_FF ** -0.5)
    od_w_qkv = nrm(ks[19], (N_ODD, D_MODEL, 3 * D_MODEL), D_MODEL ** -0.5)
    od_w_o = nrm(ks[20], (N_ODD, D_MODEL, D_MODEL), D_MODEL ** -0.5)
    od_router = nrm(ks[21], (N_ODD, D_MODEL, N_EXPERTS), D_MODEL ** -0.5)
    od_moe_w1 = nrm(ks[22], (N_ODD, N_EXPERTS, D_MODEL, D_FF_EXPERT), D_MODEL ** -0.5)
    od_moe_w3 = nrm(ks[23], (N_ODD, N_EXPERTS, D_MODEL, D_FF_EXPERT), D_MODEL ** -0.5)
    od_moe_w2 = nrm(ks[24], (N_ODD, N_EXPERTS, D_FF_EXPERT, D_MODEL), D_FF_EXPERT ** -0.5)
    return {
        "x": x, "c": c, "ada_w": ada_w, "ada_b": ada_b,
        "norm_mix_g": norm_mix_g, "norm_ffn_g": norm_ffn_g, "norm_final_g": norm_final_g,
        "ev_w_in": ev_w_in, "ev_b_gates": ev_b_gates, "ev_conv_w": ev_conv_w,
        "ev_conv_b": ev_conv_b, "ev_head_g": ev_head_g, "ev_pool_w": ev_pool_w,
        "ev_pool_scale": ev_pool_scale, "ev_w_out": ev_w_out,
        "ev_ffn_w1": ev_ffn_w1, "ev_ffn_w3": ev_ffn_w3, "ev_ffn_w2": ev_ffn_w2,
        "od_w_qkv": od_w_qkv, "od_w_o": od_w_o, "od_router": od_router,
        "od_moe_w1": od_moe_w1, "od_moe_w3": od_moe_w3, "od_moe_w2": od_moe_w2,
    }


def reference(x, c, ada_w, ada_b, norm_mix_g, norm_ffn_g, norm_final_g,
              ev_w_in, ev_b_gates, ev_conv_w, ev_conv_b, ev_head_g, ev_pool_w,
              ev_pool_scale, ev_w_out, ev_ffn_w1, ev_ffn_w3, ev_ffn_w2,
              od_w_qkv, od_w_o, od_router, od_moe_w1, od_moe_w3, od_moe_w2):
    c_act = jax.nn.silu(c)
    for l in range(DEPTH):
        mod = c_act @ ada_w[l] + ada_b[l]
        sh1, sc1, g1, sh2, sc2, g2 = jnp.split(mod, 6, axis=-1)
        h = modulate(rmsnorm(x, norm_mix_g[l]), sh1, sc1)
        if l % 2 == 0:
            e = l // 2
            mix = mlstm_pool_mixer(h, ev_w_in[e], ev_b_gates[e], ev_conv_w[e], ev_conv_b[e],
                                   ev_head_g[e], ev_pool_w[e], ev_pool_scale[e], ev_w_out[e])
        else:
            o = l // 2
            mix = stick_breaking_mixer(h, od_w_qkv[o], od_w_o[o])
        x = x + g1[:, None, :] * mix
        h = modulate(rmsnorm(x, norm_ffn_g[l]), sh2, sc2)
        if l % 2 == 0:
            e = l // 2
            ffn = swiglu(h, ev_ffn_w1[e], ev_ffn_w3[e], ev_ffn_w2[e])
        else:
            o = l // 2
            ffn = moe_swiglu(h, od_router[o], od_moe_w1[o], od_moe_w3[o], od_moe_w2[o])
        x = x + g2[:, None, :] * ffn
    return rmsnorm(x, norm_final_g)
```

```cpp
#include <hip/hip_runtime.h>
#include <cstdio>
#include <cstdint>

#ifndef SKELETON
#define SKELETON 0
#endif

namespace pg8 {
#define PG8_LAS __attribute__((address_space(3)))
typedef unsigned short bf16_t;
typedef short bf16x8 __attribute__((ext_vector_type(8)));
typedef float f32x4 __attribute__((ext_vector_type(4)));
typedef unsigned u32x4 __attribute__((ext_vector_type(4)));
constexpr int BM = 256, BK = 64, HALF = 128, HTB = HALF * BK * 2  , STAGE_BYTES = 8 * HTB, NXCD = 8, WGM = 4;

__host__ __device__ __forceinline__ int lds_byte(int r, int c) { const int st = (r >> 4) * 2 + (c >> 5), rr = r & 15, cc = c & 31, ob = rr * 64 + cc * 2; return st * 1024 + (ob ^ (((ob >> 9) & 1) << 5)); }
__host__ __device__ __forceinline__ void stage_rc(int b, int& R, int& C) { const int st = b / 1024, sb = b % 1024, swz = sb ^ (((sb >> 9) & 1) << 5); R = (st >> 1) * 16 + swz / 64; C = (st & 1) * 32 + (swz % 64) / 2; }
__host__ __device__ __forceinline__ int perm32(int rho) { const int n = rho >> 4, i = rho & 15; return 8 * (i >> 2) + 4 * n + (i & 3); }

struct Unit { int pm, pn; const char* a; const char* b; };
struct Dims { int lda, ldb, K; };

__device__ __forceinline__ unsigned cvt_pk_bf16(float lo, float hi) { unsigned r; asm volatile("v_cvt_pk_bf16_f32 %0, %1, %2" : "=v"(r) : "v"(lo), "v"(hi)); return r; }

__device__ __forceinline__ int xcd_remap(int wgid, int nwg) { const int q = nwg / NXCD, r = nwg % NXCD, xcd = wgid % NXCD, off = wgid / NXCD; return (xcd < r ? xcd * (q + 1) : r * (q + 1) + (xcd - r) * q) + off; }

struct DenseOrder {
    int nM, nN, nwg, G, c; const char* A; const char* Bt; size_t tsa, tsb;
    __device__ __forceinline__ void init(int M, int N, int G_, int c_, const void* A_, const void* Bt_, int lda, int ldb) { nM = M / BM; nN = N / BM; nwg = nM * nN; G = G_; c = c_; A = (const char*)A_; Bt = (const char*)Bt_; tsa = (size_t)BM * lda * 2; tsb = (size_t)BM * ldb * 2; }
    __device__ __forceinline__ bool next(int i, Unit& u) const {
        const long L = (long)i * G + c; if (L >= nwg) return false;
        const int wgid = xcd_remap((int)L, nwg);
        const int nig = WGM * nN, gid = wgid / nig, fm = gid * WGM, gsz = (nM - fm) < WGM ? (nM - fm) : WGM;
        u.pm = fm + ((wgid % nig) % gsz); u.pn = (wgid % nig) / gsz; u.a = A + (size_t)u.pm * tsa; u.b = Bt + (size_t)u.pn * tsb; return true;
    }
    __device__ __forceinline__ void a_ready(const Unit&) const {}
    __device__ __forceinline__ void done(const Unit&) const {}
};
struct BatchOrder {
    int n, G, c; const char* A; const char* Bt; size_t tsa, tsb;
    __device__ __forceinline__ bool next(int i, Unit& u) const { const long L = (long)i * G + c; if (c < 0 || L >= n) return false; u.pm = (int)L; u.pn = (int)L; u.a = A + (size_t)L * tsa; u.b = Bt + (size_t)L * tsb; return true; }
    __device__ __forceinline__ void a_ready(const Unit&) const {}
    __device__ __forceinline__ void done(const Unit&) const {}
};
struct PoolOrder {
    int G, c; const char* A; const char* Bt;
    __device__ __forceinline__ bool next(int i, Unit& u) const { const long L = (long)i * G + c; if (c < 0 || L >= 128) return false; u.pm = (int)L & 31; u.pn = (int)L >> 5; u.a = A + (size_t)u.pm * (256 * 1024 * 2) + (size_t)u.pn * 512; u.b = Bt + (size_t)u.pn * (256 * 256 * 2); return true; }
    __device__ __forceinline__ void a_ready(const Unit&) const {}
    __device__ __forceinline__ void done(const Unit&) const {}
};
struct MoeOrder {
    int G, c, nNl; int cumP[9]; const char* A; const char* Bt; size_t tsa, tsb;
    __device__ __forceinline__ bool next(int i, Unit& u) const {
        const int nwg = cumP[8] * nNl; const long L = (long)i * G + c; if (L >= nwg) return false;
        const int wgid = xcd_remap((int)L, nwg);
        int e = 0;
#pragma unroll
        for (int k = 1; k < 8; ++k) e += (wgid >= cumP[k] * nNl) ? 1 : 0;
        int p0 = cumP[0], p1 = cumP[1];
#pragma unroll
        for (int k = 1; k < 8; ++k) { p0 = (e == k) ? cumP[k] : p0; p1 = (e == k) ? cumP[k + 1] : p1; }
        const int local = wgid - p0 * nNl, Pe = p1 - p0;
        u.pm = p0 + local % Pe; u.pn = e * nNl + local / Pe; u.a = A + (size_t)u.pm * tsa; u.b = Bt + (size_t)u.pn * tsb; return true;
    }
    __device__ __forceinline__ void a_ready(const Unit&) const {}
    __device__ __forceinline__ void done(const Unit&) const {}
};

struct SplitOrder {
    int G, c; int cumP[9]; const char* A; const char* Bt; size_t tsa, tsb; int kq_bytes;
    __device__ __forceinline__ bool next(int i, Unit& u) const {
        const long L = (long)i * G + c; const int n = (cumP[8] - 64) * 32; if (L >= n) return false;
        const int p = 64 + (int)L / 32, rem = (int)L & 31, pnl = rem >> 2, kq = rem & 3;
        int e = 0;
#pragma unroll
        for (int k = 1; k < 8; ++k) e += (p >= cumP[k]) ? 1 : 0;
        u.pm = p; u.pn = pnl + 64 * kq; u.a = A + (size_t)p * tsa + (size_t)kq * kq_bytes; u.b = Bt + (size_t)(e * 8 + pnl) * tsb + (size_t)kq * kq_bytes; return true;
    }
    __device__ __forceinline__ void a_ready(const Unit&) const {}
    __device__ __forceinline__ void done(const Unit&) const {}
};

__device__ __forceinline__ float silu_f(float x) { return x * __builtin_amdgcn_rcpf(1.0f + __expf(-x)); }
typedef float f32x2p __attribute__((ext_vector_type(2)));
__device__ __forceinline__ f32x2p swiglu2(f32x2p a, f32x2p b, float c1, float c2) {
    const f32x2p z = a * c1; f32x2p t; t.x = __builtin_amdgcn_exp2f(z.x); t.y = __builtin_amdgcn_exp2f(z.y);
    const f32x2p d = t + 1.0f; f32x2p s; s.x = __builtin_amdgcn_rcpf(d.x); s.y = __builtin_amdgcn_rcpf(d.y);
    return (a * b) * (s * c2);
}
__device__ __forceinline__ f32x2p sigm2(unsigned w) {
    f32x2p x; x.x = __uint_as_float(w << 16); x.y = __uint_as_float(w & 0xffff0000u);
    const f32x2p z = x * -1.4426950408889634f; f32x2p t; t.x = __builtin_amdgcn_exp2f(z.x); t.y = __builtin_amdgcn_exp2f(z.y);
    const f32x2p d = t + 1.0f; f32x2p s; s.x = __builtin_amdgcn_rcpf(d.x); s.y = __builtin_amdgcn_rcpf(d.y); return s;
}

struct EpiBf16 {
    static constexpr bool PERM = true;
    bf16_t* O; int ldc;
    __device__ __forceinline__ void operator()(const f32x4 (&acc)[2][2][4][2], const Unit& u, int wr, int wc, int fr_, int fq_) const {
        int z_; asm volatile("v_mov_b32 %0, 0" : "=v"(z_)); const int fr = fr_ + z_, fq = fq_ + z_;
        const int row0 = u.pm * BM + wr * 64 + fr, col0 = u.pn * BM + wc * 32 + 8 * fq;
#pragma unroll
        for (int ai = 0; ai < 2; ++ai)
#pragma unroll
            for (int m = 0; m < 4; ++m) { bf16_t* rowp = O + (size_t)(row0 + ai * HALF + m * 16) * ldc + col0;
#pragma unroll
                for (int bj = 0; bj < 2; ++bj) { const f32x4 v0 = acc[ai][bj][m][0], v1 = acc[ai][bj][m][1];
                    u32x4 w; w.x = cvt_pk_bf16(v0[0], v0[1]); w.y = cvt_pk_bf16(v0[2], v0[3]); w.z = cvt_pk_bf16(v1[0], v1[1]); w.w = cvt_pk_bf16(v1[2], v1[3]);
                    *(u32x4*)(rowp + bj * HALF) = w; } }
    }
};
struct EpiQKblk {
    static constexpr bool PERM = true;
    bf16_t* Q; bf16_t* K; float qs;
    __device__ __forceinline__ void operator()(const f32x4 (&acc)[2][2][4][2], const Unit& u, int wr, int wc, int fr_, int fq_) const {
        int z_; asm volatile("v_mov_b32 %0, 0" : "=v"(z_)); const int fr = fr_ + z_, fq = fq_ + z_;
#pragma unroll
        for (int bj = 0; bj < 2; ++bj) { const int c0 = u.pn * BM + bj * HALF + wc * 32 + 8 * fq; bf16_t* base = (c0 >= 2048) ? K : Q; const float sc = (c0 >= 2048) ? 1.0f : qs;
            const int hh = (c0 & 2047) >> 7, d0 = c0 & 127; const size_t cofs = (size_t)hh * (128 * 4096) + (d0 >> 4) * 512 + ((d0 >> 3) & 1) * 8;
#pragma unroll
            for (int ai = 0; ai < 2; ++ai)
#pragma unroll
                for (int m = 0; m < 4; ++m) { const int t = u.pm * BM + ai * HALF + wr * 64 + m * 16 + fr, b = t >> 12, pos = t & 4095;
                    bf16_t* dst = base + (size_t)b * (16 * 128 * 4096) + cofs + (size_t)(pos >> 5) * 4096 + (pos & 31) * 16;
                    const f32x4 v0 = acc[ai][bj][m][0] * sc, v1 = acc[ai][bj][m][1] * sc;
                    u32x4 w; w.x = cvt_pk_bf16(v0[0], v0[1]); w.y = cvt_pk_bf16(v0[2], v0[3]); w.z = cvt_pk_bf16(v1[0], v1[1]); w.w = cvt_pk_bf16(v1[2], v1[3]);
                    *(u32x4*)dst = w; } }
    }
};
struct EpiVblk {
    static constexpr bool PERM = true;
    bf16_t* V;
    __device__ __forceinline__ void operator()(const f32x4 (&acc)[2][2][4][2], const Unit& u, int wr, int wc, int fr_, int fq_) const {
        int z_; asm volatile("v_mov_b32 %0, 0" : "=v"(z_)); const int fr = fr_ + z_, fq = fq_ + z_;
        typedef unsigned u32x2v __attribute__((ext_vector_type(2)));
#pragma unroll
        for (int bj = 0; bj < 2; ++bj) { const int tok0 = u.pn * BM + bj * HALF + wc * 32 + 8 * fq, b = tok0 >> 12, pos0 = tok0 & 4095, k0 = pos0 & 31;
            const size_t cofs = (size_t)b * (16 * 128 * 4096) + (size_t)(pos0 >> 5) * 4096 + (k0 >> 4) * 2048 + ((k0 >> 3) & 1) * 4;
#pragma unroll
            for (int ai = 0; ai < 2; ++ai)
#pragma unroll
                for (int m = 0; m < 4; ++m) { const int f = u.pm * BM + ai * HALF + wr * 64 + m * 16 + fr, hh = f >> 7, e = f & 127;
                    bf16_t* dst = V + cofs + (size_t)hh * (128 * 4096) + (e >> 5) * 512 + (e & 31) * 16;
                    const f32x4 v0 = acc[ai][bj][m][0], v1 = acc[ai][bj][m][1];
                    u32x2v w0, w1; w0.x = cvt_pk_bf16(v0[0], v0[1]); w0.y = cvt_pk_bf16(v0[2], v0[3]); w1.x = cvt_pk_bf16(v1[0], v1[1]); w1.y = cvt_pk_bf16(v1[2], v1[3]);
                    *(u32x2v*)dst = w0; *(u32x2v*)(dst + 8) = w1; } }
    }
};
template <bool BASE16> struct EpiResid {
    static constexpr bool PERM = true;
    const void* base; bf16_t* out; const float* gate; float gs;
    __device__ __forceinline__ void operator()(const f32x4 (&acc)[2][2][4][2], const Unit& u, int wr, int wc, int fr_, int fq_) const {
        int z_; asm volatile("v_mov_b32 %0, 0" : "=v"(z_)); const int fr = fr_ + z_, fq = fq_ + z_;
        const int row0 = u.pm * BM + wr * 64 + fr, col0 = u.pn * BM + wc * 32 + 8 * fq;
        const float* gp = gate + (size_t)((u.pm * BM) >> 12) * 12288 + col0;
        f32x4 gv[2][2];
#pragma unroll
        for (int bj = 0; bj < 2; ++bj)
#pragma unroll
            for (int n = 0; n < 2; ++n) gv[bj][n] = *(const f32x4*)(gp + bj * HALF + 4 * n) * gs;
#pragma unroll
        for (int ai = 0; ai < 2; ++ai)
#pragma unroll
            for (int m = 0; m < 4; ++m) { const size_t off = (size_t)(row0 + ai * HALF + m * 16) * 2048 + col0;
#pragma unroll
                for (int bj = 0; bj < 2; ++bj) { f32x4 b0, b1;
                    if (BASE16) { const u32x4 w = *(const u32x4*)((const bf16_t*)base + off + bj * HALF);
                        b0 = (f32x4){__uint_as_float(w.x << 16), __uint_as_float(w.x & 0xffff0000u), __uint_as_float(w.y << 16), __uint_as_float(w.y & 0xffff0000u)};
                        b1 = (f32x4){__uint_as_float(w.z << 16), __uint_as_float(w.z & 0xffff0000u), __uint_as_float(w.w << 16), __uint_as_float(w.w & 0xffff0000u)}; }
                    else { b0 = *(const f32x4*)((const float*)base + off + bj * HALF); b1 = *(const f32x4*)((const float*)base + off + bj * HALF + 4); }
                    const f32x4 v0 = b0 + gv[bj][0] * acc[ai][bj][m][0], v1 = b1 + gv[bj][1] * acc[ai][bj][m][1];
                    u32x4 o; o.x = cvt_pk_bf16(v0[0], v0[1]); o.y = cvt_pk_bf16(v0[2], v0[3]); o.z = cvt_pk_bf16(v1[0], v1[1]); o.w = cvt_pk_bf16(v1[2], v1[3]);
                    *(u32x4*)(out + off + bj * HALF) = o; }
                asm volatile("" ::: "memory"); }
    }
};
struct EpiSwiglu {
    static constexpr bool PERM = true;
    bf16_t* O; int ldo; int nNl;
    __device__ __forceinline__ void operator()(const f32x4 (&acc)[2][2][4][2], const Unit& u, int wr, int wc, int fr_, int fq_) const {
        int z_; asm volatile("v_mov_b32 %0, 0" : "=v"(z_)); const int fr = fr_ + z_, fq = fq_ + z_;
        const int row0 = u.pm * BM + wr * 64 + fr, col0 = (u.pn % nNl) * HALF + wc * 32 + 8 * fq;
#pragma unroll
        for (int ai = 0; ai < 2; ++ai)
#pragma unroll
            for (int m = 0; m < 4; ++m) { bf16_t* rowp = O + (size_t)(row0 + ai * HALF + m * 16) * ldo + col0;
                const f32x4 a0 = acc[ai][0][m][0], a1 = acc[ai][0][m][1], b0 = acc[ai][1][m][0], b1 = acc[ai][1][m][1];
                const f32x2p r0 = swiglu2((f32x2p){a0[0], a0[1]}, (f32x2p){b0[0], b0[1]}, -1.4426950408889634f, 1.0f), r1 = swiglu2((f32x2p){a0[2], a0[3]}, (f32x2p){b0[2], b0[3]}, -1.4426950408889634f, 1.0f);
                const f32x2p r2 = swiglu2((f32x2p){a1[0], a1[1]}, (f32x2p){b1[0], b1[1]}, -1.4426950408889634f, 1.0f), r3 = swiglu2((f32x2p){a1[2], a1[3]}, (f32x2p){b1[2], b1[3]}, -1.4426950408889634f, 1.0f);
                u32x4 w; w.x = cvt_pk_bf16(r0.x, r0.y); w.y = cvt_pk_bf16(r1.x, r1.y); w.z = cvt_pk_bf16(r2.x, r2.y); w.w = cvt_pk_bf16(r3.x, r3.y);
                *(u32x4*)rowp = w; }
    }
};
__device__ __forceinline__ unsigned pk4_fp8(float a, float b, float c, float d) { int w = 0; w = __builtin_amdgcn_cvt_pk_fp8_f32(a, b, w, false); w = __builtin_amdgcn_cvt_pk_fp8_f32(c, d, w, true); return (unsigned)w; }
struct EpiSwiglu8 {
    static constexpr bool PERM = true;
    unsigned char* O; int ldo; int nNl; float inv;
    __device__ __forceinline__ void operator()(const f32x4 (&acc)[2][2][4][2], const Unit& u, int wr, int wc, int fr, int fq) const {
        const int row0 = u.pm * BM + wr * 64 + fr, col0 = (u.pn % nNl) * HALF + wc * 32 + 8 * fq;
#pragma unroll
        for (int ai = 0; ai < 2; ++ai)
#pragma unroll
            for (int m = 0; m < 4; ++m) { unsigned char* rowp = O + (size_t)(row0 + ai * HALF + m * 16) * ldo + col0;
                const f32x4 a0 = acc[ai][0][m][0], a1 = acc[ai][0][m][1], b0 = acc[ai][1][m][0], b1 = acc[ai][1][m][1];
                const float c1 = -1.4426950408889634f * inv, c2 = inv * inv;
                const f32x2p r0 = swiglu2((f32x2p){a0[0], a0[1]}, (f32x2p){b0[0], b0[1]}, c1, c2), r1 = swiglu2((f32x2p){a0[2], a0[3]}, (f32x2p){b0[2], b0[3]}, c1, c2);
                const f32x2p r2 = swiglu2((f32x2p){a1[0], a1[1]}, (f32x2p){b1[0], b1[1]}, c1, c2), r3 = swiglu2((f32x2p){a1[2], a1[3]}, (f32x2p){b1[2], b1[3]}, c1, c2);
                typedef unsigned u32x2v __attribute__((ext_vector_type(2)));
                u32x2v w; w.x = pk4_fp8(r0.x, r0.y, r1.x, r1.y); w.y = pk4_fp8(r2.x, r2.y, r3.x, r3.y);
                *(u32x2v*)rowp = w; }
    }
};
struct EpiY {
    static constexpr bool PERM = true;
    bf16_t* Y; const float* sg; float inv;
    __device__ __forceinline__ void operator()(const f32x4 (&acc)[2][2][4][2], const Unit& u, int wr, int wc, int fr_, int fq_) const {
        int z_; asm volatile("v_mov_b32 %0, 0" : "=v"(z_)); const int fr = fr_ + z_, fq = fq_ + z_;
        const int row0 = u.pm * BM + wr * 64 + fr, col0 = (u.pn & 7) * BM + wc * 32 + 8 * fq;
#pragma unroll
        for (int ai = 0; ai < 2; ++ai)
#pragma unroll
            for (int m = 0; m < 4; ++m) { const int row = row0 + ai * HALF + m * 16; const float g = sg[row] * inv; bf16_t* rowp = Y + (size_t)row * 2048 + col0;
#pragma unroll
                for (int bj = 0; bj < 2; ++bj) { const f32x4 v0 = acc[ai][bj][m][0] * g, v1 = acc[ai][bj][m][1] * g;
                    u32x4 w; w.x = cvt_pk_bf16(v0[0], v0[1]); w.y = cvt_pk_bf16(v0[2], v0[3]); w.z = cvt_pk_bf16(v1[0], v1[1]); w.w = cvt_pk_bf16(v1[2], v1[3]);
                    *(u32x4*)(rowp + bj * HALF) = w; } }
    }
};
struct EpiYp {
    static constexpr bool PERM = true;
    bf16_t* YP; const float* sg; float inv;
    __device__ __forceinline__ void operator()(const f32x4 (&acc)[2][2][4][2], const Unit& u, int wr, int wc, int fr_, int fq_) const {
        int z_; asm volatile("v_mov_b32 %0, 0" : "=v"(z_)); const int fr = fr_ + z_, fq = fq_ + z_;
        const int row0 = u.pm * BM + wr * 64 + fr, col0 = (u.pn & 7) * BM + wc * 32 + 8 * fq; bf16_t* base = YP + (size_t)(u.pn >> 6) * (1792 * 2048);
#pragma unroll
        for (int ai = 0; ai < 2; ++ai)
#pragma unroll
            for (int m = 0; m < 4; ++m) { const int row = row0 + ai * HALF + m * 16; const float g = sg[row] * inv; bf16_t* rowp = base + (size_t)(row - 16384) * 2048 + col0;
#pragma unroll
                for (int bj = 0; bj < 2; ++bj) { const f32x4 v0 = acc[ai][bj][m][0] * g, v1 = acc[ai][bj][m][1] * g;
                    u32x4 w; w.x = cvt_pk_bf16(v0[0], v0[1]); w.y = cvt_pk_bf16(v0[2], v0[3]); w.z = cvt_pk_bf16(v1[0], v1[1]); w.w = cvt_pk_bf16(v1[2], v1[3]);
                    *(u32x4*)(rowp + bj * HALF) = w; } }
    }
};
struct EpiW {
    static constexpr bool PERM = true;
    bf16_t* AP; const float* bcum; const float* ig;
    __device__ __forceinline__ void operator()(const f32x4 (&acc)[2][2][4][2], const Unit& u, int wr, int wc, int fr_, int fq_) const {
        int z_; asm volatile("v_mov_b32 %0, 0" : "=v"(z_)); const int fr = fr_ + z_, fq = fq_ + z_;
        const float* bc = bcum + u.pm * 256; const float* ii = ig + u.pm * 256;
#pragma unroll
        for (int bj = 0; bj < 2; ++bj) { const int s0 = bj * HALF + wc * 32 + 8 * fq;
            const f32x4 b0 = *(const f32x4*)(bc + s0), b1 = *(const f32x4*)(bc + s0 + 4), i0 = *(const f32x4*)(ii + s0), i1 = *(const f32x4*)(ii + s0 + 4);
            const f32x4 c0 = i0 - b0, c1 = i1 - b1;
#pragma unroll
            for (int ai = 0; ai < 2; ++ai)
#pragma unroll
                for (int m = 0; m < 4; ++m) { const int t = ai * HALF + wr * 64 + m * 16 + fr; const float bt = bc[t]; bf16_t* rowp = AP + ((size_t)u.pm * 256 + t) * 512 + 256;
                    const f32x4 v0 = acc[ai][bj][m][0], v1 = acc[ai][bj][m][1]; float r[8];
                    const int dts = t - s0;
#pragma unroll
                    for (int j = 0; j < 4; ++j) { const float m0 = (float)min(max(dts - j + 1, 0), 1), m1 = (float)min(max(dts - j - 3, 0), 1);
                        r[j] = v0[j] * __expf(fminf(bt + c0[j], 80.f)) * m0; r[4 + j] = v1[j] * __expf(fminf(bt + c1[j], 80.f)) * m1; }
                    u32x4 w; w.x = cvt_pk_bf16(r[0], r[1]); w.y = cvt_pk_bf16(r[2], r[3]); w.z = cvt_pk_bf16(r[4], r[5]); w.w = cvt_pk_bf16(r[6], r[7]);
                    *(u32x4*)(rowp + s0) = w; asm volatile("" ::: "memory"); } }
    }
};
struct EpiDC {
    static constexpr bool PERM = false;
    float* D;
    __device__ __forceinline__ void operator()(const f32x4 (&acc)[2][2][4][2], const Unit& u, int wr, int wc, int fr_, int fq_) const {
        int z_; asm volatile("v_mov_b32 %0, 0" : "=v"(z_)); const int fr = fr_ + z_, fq = fq_ + z_;
        const int row0 = wr * 64 + fr, col0 = wc * 32 + 4 * fq;
#pragma unroll
        for (int ai = 0; ai < 2; ++ai)
#pragma unroll
            for (int m = 0; m < 4; ++m) { float* rowp = D + ((size_t)u.pm * 256 + row0 + ai * HALF + m * 16) * 256 + col0;
#pragma unroll
                for (int bj = 0; bj < 2; ++bj)
#pragma unroll
                    for (int n = 0; n < 2; ++n) *(f32x4*)(rowp + bj * HALF + n * 16) = acc[ai][bj][m][n]; }
    }
};
struct EpiNum {
    static constexpr bool PERM = false;
    float* HR;
    __device__ __forceinline__ void operator()(const f32x4 (&acc)[2][2][4][2], const Unit& u, int wr, int wc, int fr_, int fq_) const {
        int z_; asm volatile("v_mov_b32 %0, 0" : "=v"(z_)); const int fr = fr_ + z_, fq = fq_ + z_;
        const int b = u.pm >> 6, h = (u.pm >> 4) & 3, c = u.pm & 15;
        const int row0 = b * 4096 + c * 256 + wr * 64 + fr, col0 = h * 256 + wc * 32 + 4 * fq;
#pragma unroll
        for (int ai = 0; ai < 2; ++ai)
#pragma unroll
            for (int m = 0; m < 4; ++m) { float* rowp = HR + (size_t)(row0 + ai * HALF + m * 16) * 1024 + col0;
#pragma unroll
                for (int bj = 0; bj < 2; ++bj)
#pragma unroll
                    for (int n = 0; n < 2; ++n) *(f32x4*)(rowp + bj * HALF + n * 16) = acc[ai][bj][m][n]; }
    }
};
struct EpiFin {
    static constexpr bool PERM = true;
    bf16_t* O; const bf16_t* PROJ; int ldp; const float* headg; PG8_LAS float* sDen; PG8_LAS float* sSS; float eps;
    __device__ __forceinline__ void operator()(const f32x4 (&acc)[2][2][4][2], const Unit& u, int wr, int wc, int fr_, int fq_) const {
        int z_; asm volatile("v_mov_b32 %0, 0" : "=v"(z_)); const int fr = fr_ + z_, fq = fq_ + z_;
        const int b = u.pm >> 6, h = (u.pm >> 4) & 3, c = u.pm & 15;
        const int rl0 = wr * 64 + fr, col0 = wc * 32 + 8 * fq;
#pragma unroll
        for (int ai = 0; ai < 2; ++ai)
#pragma unroll
            for (int m = 0; m < 4; ++m) { float p = 0.f;
#pragma unroll
                for (int bj = 0; bj < 2; ++bj)
#pragma unroll
                    for (int n = 0; n < 2; ++n) { const f32x4 v = acc[ai][bj][m][n]; p += v[0] * v[0] + v[1] * v[1] + v[2] * v[2] + v[3] * v[3]; }
                p += __shfl_xor(p, 16); p += __shfl_xor(p, 32);
                if (fq == 0) sSS[wc * 256 + rl0 + ai * HALF + m * 16] = p; }
        asm volatile("s_waitcnt lgkmcnt(0)" ::: "memory"); __builtin_amdgcn_s_barrier();
        f32x4 hv[2][2];
#pragma unroll
        for (int bj = 0; bj < 2; ++bj)
#pragma unroll
            for (int n = 0; n < 2; ++n) hv[bj][n] = *(const f32x4*)(headg + h * 256 + col0 + bj * HALF + 4 * n);
#pragma unroll
        for (int ai = 0; ai < 2; ++ai) {
            const size_t t0 = (size_t)b * 4096 + c * 256 + rl0 + ai * HALF;
            u32x4 ow[4][2];
#pragma unroll
            for (int m = 0; m < 4; ++m)
#pragma unroll
                for (int bj = 0; bj < 2; ++bj) ow[m][bj] = *(const u32x4*)(PROJ + (t0 + m * 16) * ldp + 3072 + h * 256 + col0 + bj * HALF);
#pragma unroll
            for (int m = 0; m < 4; ++m) { const int rl = rl0 + ai * HALF + m * 16;
                const float P = (sSS[rl] + sSS[256 + rl]) + (sSS[512 + rl] + sSS[768 + rl]), idd = sDen[rl];
                const float f = idd * (1.0f / sqrtf(P * idd * idd * (1.0f / 256.0f) + eps));
                bf16_t* rowp = O + (t0 + m * 16) * 2048 + h * 256 + col0;
#pragma unroll
                for (int bj = 0; bj < 2; ++bj) { const f32x4 v0 = acc[ai][bj][m][0] * f * hv[bj][0], v1 = acc[ai][bj][m][1] * f * hv[bj][1]; const u32x4 o = ow[m][bj];
                    const f32x2p s0 = sigm2(o.x), s1 = sigm2(o.y), s2 = sigm2(o.z), s3 = sigm2(o.w);
                    u32x4 w; w.x = cvt_pk_bf16(v0[0] * s0.x, v0[1] * s0.y); w.y = cvt_pk_bf16(v0[2] * s1.x, v0[3] * s1.y); w.z = cvt_pk_bf16(v1[0] * s2.x, v1[1] * s2.y); w.w = cvt_pk_bf16(v1[2] * s3.x, v1[3] * s3.y);
                    *(u32x4*)(rowp + bj * HALF) = w; } } }
    }
};
struct EpiPool {
    static constexpr bool PERM = true;
    bf16_t* O; const float* scale;
    __device__ __forceinline__ void operator()(const f32x4 (&acc)[2][2][4][2], const Unit& u, int wr, int wc, int fr_, int fq_) const {
        int z_; asm volatile("v_mov_b32 %0, 0" : "=v"(z_)); const int fr = fr_ + z_, fq = fq_ + z_;
        const int row0 = u.pm * BM + wr * 64 + fr, col0 = u.pn * 256 + wc * 32 + 8 * fq;
        f32x4 sv[2][2];
#pragma unroll
        for (int bj = 0; bj < 2; ++bj)
#pragma unroll
            for (int n = 0; n < 2; ++n) sv[bj][n] = *(const f32x4*)(scale + col0 + bj * HALF + 4 * n);
#pragma unroll
        for (int ai = 0; ai < 2; ++ai)
#pragma unroll
            for (int m = 0; m < 4; ++m) { bf16_t* rowp = O + (size_t)(row0 + ai * HALF + m * 16) * 2048 + 1024 + col0;
#pragma unroll
                for (int bj = 0; bj < 2; ++bj) { const f32x4 v0 = acc[ai][bj][m][0] * sv[bj][0], v1 = acc[ai][bj][m][1] * sv[bj][1];
                    u32x4 w; w.x = cvt_pk_bf16(v0[0], v0[1]); w.y = cvt_pk_bf16(v0[2], v0[3]); w.z = cvt_pk_bf16(v1[0], v1[1]); w.w = cvt_pk_bf16(v1[2], v1[3]);
                    *(u32x4*)(rowp + bj * HALF) = w; } }
    }
};

typedef int v8i_t __attribute__((ext_vector_type(8)));
typedef int v4i_t __attribute__((ext_vector_type(4)));
__device__ __forceinline__ v8i_t cat8(bf16x8 lo, bf16x8 hi) { return __builtin_shufflevector(__builtin_bit_cast(v4i_t, lo), __builtin_bit_cast(v4i_t, hi), 0, 1, 2, 3, 4, 5, 6, 7); }
template <class Epi, class Sched, bool ALIGN_EPI = false, bool SP2 = false, bool F8 = false>
__device__ __forceinline__ void gemm_phase(PG8_LAS unsigned char* lds, const Dims g, const Sched& S, const Epi& E) {
    int tid_ = threadIdx.x; asm volatile("" : "+v"(tid_));
    const int tid = tid_, wid = __builtin_amdgcn_readfirstlane(tid >> 6), lane = tid & 63, wr = wid >> 2, wc = wid & 3, fr = lane & 15, fq = lane >> 4;
    const int K = g.K, nt = K / BK;
    unsigned voffA[2], voffB[2];
#pragma unroll
    for (int i = 0; i < 2; ++i) { int R, C; stage_rc(tid * 16 + i * 8192, R, C); const int Rb = Epi::PERM ? ((R & ~31) + perm32(R & 31)) : R;
        voffA[i] = (unsigned)(R * g.lda + C) * 2u; voffB[i] = (unsigned)(Rb * g.ldb + C) * 2u; }
    const size_t kstep = (size_t)(BK * 2);
    const size_t hstepA = (size_t)HALF * g.lda * 2, hstepB = (size_t)HALF * g.ldb * 2;
    const unsigned ldsw = (unsigned)wid * 1024u;
    const int aoff = lds_byte(wr * 64 + fr, fq * 8), boff = lds_byte(wc * 32 + fr, fq * 8);
#define PG8_SA(b, h) (((b) * 2 + (h)) * HTB)
#define PG8_SB(b, h) ((4 + (b) * 2 + (h)) * HTB)
#define PG8_STAGE(bufoff, gbase, voff) do { _Pragma("unroll") for (int _i = 0; _i < 2; ++_i) \
        __builtin_amdgcn_global_load_lds((const unsigned*)((const char*)(gbase) + (voff)[_i]), (PG8_LAS unsigned*)(lds + (bufoff) + ldsw + _i * 8192), 16, 0, 0); } while (0)
#define PG8_LDA(dst, b, h) do { if constexpr (F8) { _Pragma("unroll") for (int m = 0; m < 4; ++m) { const v4i_t lo_ = *(const PG8_LAS v4i_t*)(lds + PG8_SA(b, h) + aoff + m * 2048), hi_ = *(const PG8_LAS v4i_t*)(lds + PG8_SA(b, h) + aoff + m * 2048 + 1024); dst##8[m] = __builtin_shufflevector(lo_, hi_, 0, 1, 2, 3, 4, 5, 6, 7); } } else { \
        _Pragma("unroll") for (int m = 0; m < 4; ++m) _Pragma("unroll") for (int k = 0; k < 2; ++k) dst[m][k] = *(const PG8_LAS bf16x8*)(lds + PG8_SA(b, h) + aoff + m * 2048 + k * 1024); } } while (0)
#define PG8_LDB(dst, b, h) do { if constexpr (F8) { _Pragma("unroll") for (int n = 0; n < 2; ++n) { const v4i_t lo_ = *(const PG8_LAS v4i_t*)(lds + PG8_SB(b, h) + boff + n * 2048), hi_ = *(const PG8_LAS v4i_t*)(lds + PG8_SB(b, h) + boff + n * 2048 + 1024); dst##8[n] = __builtin_shufflevector(lo_, hi_, 0, 1, 2, 3, 4, 5, 6, 7); } } else { \
        _Pragma("unroll") for (int n = 0; n < 2; ++n) _Pragma("unroll") for (int k = 0; k < 2; ++k) dst[n][k] = *(const PG8_LAS bf16x8*)(lds + PG8_SB(b, h) + boff + n * 2048 + k * 1024); } } while (0)
#define PG8_MMA(ai, bj, At, Bt) do { __builtin_amdgcn_s_setprio(1); if constexpr (F8) { _Pragma("unroll") for (int m = 0; m < 4; ++m) _Pragma("unroll") for (int n = 0; n < 2; ++n) \
        asm volatile("v_mfma_scale_f32_16x16x128_f8f6f4 %0, %1, %2, %0, %3, %3 op_sel_hi:[0,0,0]" : "+v"(acc[ai][bj][m][n]) : "v"(Bt##8[n]), "v"(At##8[m]), "v"(sc8)); } else { \
        _Pragma("unroll") for (int m = 0; m < 4; ++m) _Pragma("unroll") for (int n = 0; n < 2; ++n) _Pragma("unroll") for (int k = 0; k < 2; ++k) \
        acc[ai][bj][m][n] = __builtin_amdgcn_mfma_f32_16x16x32_bf16(Bt[n][k], At[m][k], acc[ai][bj][m][n], 0, 0, 0); } __builtin_amdgcn_s_setprio(0); } while (0)
#define PG8_WAIT_V(n) asm volatile("s_waitcnt vmcnt(" #n ")" ::: "memory")
#define PG8_WAIT_L(n) asm volatile("s_waitcnt lgkmcnt(" #n ")" ::: "memory")
#define PG8_BAR __builtin_amdgcn_s_barrier()
#define PG8_SCHED __builtin_amdgcn_sched_barrier(0)
    Unit cur, nxt; int ui = 0;
    if (!S.next(0, cur)) return;
    f32x4 acc[2][2][4][2];
#pragma unroll
    for (int a = 0; a < 2; ++a)
#pragma unroll
        for (int b = 0; b < 2; ++b)
#pragma unroll
            for (int m = 0; m < 4; ++m)
#pragma unroll
                for (int n = 0; n < 2; ++n) acc[a][b][m][n] = (f32x4){0.f, 0.f, 0.f, 0.f};
    int sc8 = 0x7f7f7f7f; asm volatile("" : "+v"(sc8));
    bf16x8 At[4][2], B0[2][2], B1[2][2]; v8i_t At8[4], B08[2], B18[2]; (void)At; (void)B0; (void)B1; (void)At8; (void)B08; (void)B18;
    const char* cA = cur.a; const char* cB = cur.b;
    S.a_ready(cur);
    if constexpr (SP2) {
        PG8_STAGE(PG8_SB(0, 0), cB, voffB); PG8_STAGE(PG8_SB(0, 1), cB + hstepB, voffB); PG8_STAGE(PG8_SA(0, 0), cA, voffA); PG8_STAGE(PG8_SA(0, 1), cA + hstepA, voffA);
        if (wr == 1) PG8_BAR;
        PG8_WAIT_V(2); PG8_BAR;
        PG8_STAGE(PG8_SB(1, 0), cB + kstep, voffB); PG8_STAGE(PG8_SA(1, 0), cA + kstep, voffA); PG8_STAGE(PG8_SB(1, 1), cB + hstepB + kstep, voffB);
        PG8_WAIT_V(6); PG8_BAR;
    } else {
        PG8_STAGE(PG8_SB(0, 0), cB, voffB); PG8_STAGE(PG8_SA(0, 0), cA, voffA); PG8_STAGE(PG8_SB(0, 1), cB + hstepB, voffB); PG8_STAGE(PG8_SA(0, 1), cA + hstepA, voffA);
        if (wr == 1) PG8_BAR;
        PG8_WAIT_V(4); PG8_BAR;
        PG8_STAGE(PG8_SB(1, 0), cB + kstep, voffB); PG8_STAGE(PG8_SA(1, 0), cA + kstep, voffA); PG8_STAGE(PG8_SB(1, 1), cB + hstepB + kstep, voffB);
        PG8_WAIT_V(6); PG8_BAR;
    }
    for (;;) {
        const bool has_next = S.next(ui + 1, nxt);
        const char* nA = has_next ? nxt.a : cA; const char* nB = has_next ? nxt.b : cB;
#pragma nounroll
        for (int t = 0; t < nt; t += 2) {
            const bool last = (t == nt - 2);
            const char* a1 = cA + (size_t)(t + 1) * kstep;
            const char* a2 = last ? nA : cA + (size_t)(t + 2) * kstep; const char* b2 = last ? nB : cB + (size_t)(t + 2) * kstep;
            const char* a3 = a2 + kstep; const char* b3 = b2 + kstep;
            if (last && has_next) S.a_ready(nxt);
            if constexpr (SP2) {
            PG8_LDB(B0, 0, 0); PG8_LDB(B1, 0, 1); PG8_SCHED; PG8_LDA(At, 0, 0); PG8_STAGE(PG8_SA(1, 1), a1 + hstepA, voffA);
            PG8_WAIT_V(8); PG8_WAIT_L(0); PG8_BAR; PG8_MMA(0, 0, At, B0); PG8_MMA(0, 1, At, B1); PG8_BAR; PG8_SCHED;
            PG8_LDA(At, 0, 1); PG8_STAGE(PG8_SB(0, 0), b2, voffB); PG8_STAGE(PG8_SB(0, 1), b2 + hstepB, voffB); PG8_STAGE(PG8_SA(0, 0), a2, voffA);
            PG8_WAIT_V(8); PG8_WAIT_L(0); PG8_BAR; PG8_MMA(1, 0, At, B0); PG8_MMA(1, 1, At, B1); PG8_BAR; PG8_SCHED;
            PG8_LDB(B0, 1, 0); PG8_LDB(B1, 1, 1); PG8_SCHED; PG8_LDA(At, 1, 0); PG8_STAGE(PG8_SA(0, 1), a2 + hstepA, voffA);
            PG8_WAIT_V(8); PG8_WAIT_L(0); PG8_BAR; PG8_MMA(0, 0, At, B0); PG8_MMA(0, 1, At, B1); PG8_BAR; PG8_SCHED;
            PG8_LDA(At, 1, 1); PG8_STAGE(PG8_SB(1, 0), b3, voffB); PG8_STAGE(PG8_SB(1, 1), b3 + hstepB, voffB); PG8_STAGE(PG8_SA(1, 0), a3, voffA);
            PG8_WAIT_V(8); PG8_WAIT_L(0); PG8_BAR; PG8_MMA(1, 0, At, B0); PG8_MMA(1, 1, At, B1); PG8_BAR; PG8_SCHED;
            } else {
            PG8_LDB(B0, 0, 0); PG8_SCHED; PG8_LDA(At, 0, 0); PG8_STAGE(PG8_SA(1, 1), a1 + hstepA, voffA);
            PG8_WAIT_L(8); PG8_BAR; PG8_WAIT_L(0); PG8_MMA(0, 0, At, B0); PG8_BAR; PG8_SCHED;
            PG8_LDB(B1, 0, 1); PG8_STAGE(PG8_SB(0, 0), b2, voffB);
            PG8_BAR; PG8_WAIT_L(0); PG8_MMA(0, 1, At, B1); PG8_BAR;
            PG8_LDA(At, 0, 1); PG8_STAGE(PG8_SA(0, 0), a2, voffA);
            PG8_BAR; PG8_WAIT_L(0); PG8_MMA(1, 0, At, B0); PG8_BAR; PG8_SCHED;
            PG8_STAGE(PG8_SB(0, 1), b2 + hstepB, voffB);
            PG8_WAIT_V(6); PG8_BAR; PG8_MMA(1, 1, At, B1); PG8_BAR;
            PG8_LDB(B0, 1, 0); PG8_SCHED; PG8_LDA(At, 1, 0); PG8_STAGE(PG8_SA(0, 1), a2 + hstepA, voffA);
            PG8_WAIT_L(8); PG8_BAR; PG8_WAIT_L(0); PG8_MMA(0, 0, At, B0); PG8_BAR; PG8_SCHED;
            PG8_LDB(B1, 1, 1); PG8_STAGE(PG8_SB(1, 0), b3, voffB);
            PG8_BAR; PG8_WAIT_L(0); PG8_MMA(0, 1, At, B1); PG8_BAR;
            PG8_LDA(At, 1, 1); PG8_STAGE(PG8_SA(1, 0), a3, voffA);
            PG8_BAR; PG8_WAIT_L(0); PG8_MMA(1, 0, At, B0); PG8_BAR; PG8_SCHED;
            PG8_STAGE(PG8_SB(1, 1), b3 + hstepB, voffB);
            PG8_WAIT_V(6); PG8_BAR; PG8_MMA(1, 1, At, B1); PG8_BAR;
            }
        }
        if constexpr (F8) {
#pragma unroll
            for (int a = 0; a < 2; ++a)
#pragma unroll
                for (int b = 0; b < 2; ++b)
                    asm volatile("s_nop 15\n\ts_nop 15" : "+v"(acc[a][b][0][0]), "+v"(acc[a][b][0][1]), "+v"(acc[a][b][1][0]), "+v"(acc[a][b][1][1]), "+v"(acc[a][b][2][0]), "+v"(acc[a][b][2][1]), "+v"(acc[a][b][3][0]), "+v"(acc[a][b][3][1]));
        }
        if constexpr (ALIGN_EPI) { if (wr == 0) PG8_BAR; }
        E(acc, cur, wr, wc, fr, fq); S.done(cur);
        if (!has_next) break;
#pragma unroll
        for (int a = 0; a < 2; ++a)
#pragma unroll
            for (int b = 0; b < 2; ++b)
#pragma unroll
                for (int m = 0; m < 4; ++m)
#pragma unroll
                    for (int n = 0; n < 2; ++n) acc[a][b][m][n] = (f32x4){0.f, 0.f, 0.f, 0.f};
        cur = nxt; cA = nA; cB = nB; ++ui;
        if constexpr (ALIGN_EPI) { if (wr == 1) PG8_BAR; }
    }
    PG8_WAIT_V(0);
    if constexpr (!ALIGN_EPI) { if (wr == 0) PG8_BAR; }
    PG8_BAR;
#undef PG8_SA
#undef PG8_SB
#undef PG8_STAGE
#undef PG8_LDA
#undef PG8_LDB
#undef PG8_MMA
#undef PG8_WAIT_V
#undef PG8_WAIT_L
#undef PG8_BAR
#undef PG8_SCHED
}
}

constexpr int NWAVES = 8;
constexpr int DM = 2048, NTOK = 8192, SEQ = 4096;
constexpr int DINS = 5128, DINP = 5120;
constexpr int DFF = 5632, NE = 8, DFE = 7168;
constexpr int NUNIT = 128;
constexpr int MAXSLOT = 18432;
constexpr float EPS = 1e-6f;

constexpr size_t MiB = 1u << 20;
constexpr size_t WS_CTL = 0, CTL_ZERO_BYTES = 1 * MiB;
constexpr size_t WS_MOD = 1 * MiB;
constexpr size_t WS_GWT = WS_MOD + 256 * 1024;
constexpr size_t WS_RWT = WS_GWT + 64 * 1024;
constexpr size_t WS_GATES = WS_RWT + 64 * 1024;
constexpr size_t WS_BCUM = WS_GATES + 256 * 1024;
constexpr size_t WS_IG = WS_BCUM + 128 * 1024;
constexpr size_t WS_GTOT = WS_IG + 128 * 1024;
constexpr size_t WS_DN = WS_GTOT + 4 * 1024;
constexpr size_t WS_NVEC = WS_DN + 128 * 1024;
constexpr size_t WS_TOKINFO = WS_NVEC + 128 * 1024;
constexpr size_t WS_TOKSLOT = WS_TOKINFO + 256 * 1024;
constexpr size_t WS_SLOTGATE = WS_TOKSLOT + 64 * 1024;
static_assert(WS_SLOTGATE + 128 * 1024 <= 4 * MiB, "small arrays");
constexpr size_t WS_WIN = 4 * MiB, WS_WOUT = 24 * MiB, WS_W13 = 32 * MiB, WS_W2 = 76 * MiB, WS_WQKV = 98 * MiB, WS_WO = 122 * MiB, WS_POOLW = 130 * MiB;
constexpr size_t WS_W13E = 132 * MiB, WS_W2E = 580 * MiB;
constexpr size_t WS_XR = 804 * MiB, WS_HN = 868 * MiB;
constexpr size_t WS_L = 900 * MiB;
constexpr size_t WS_PROJ = WS_L, WS_QB = WS_L + 80 * MiB, WS_KB = WS_L + 96 * MiB, WS_KWT = WS_L + 112 * MiB, WS_AP = WS_L + 128 * MiB, WS_BP = WS_L + 160 * MiB,
                 WS_DCT = WS_L + 192 * MiB, WS_HR = WS_L + 224 * MiB, WS_POOLED = WS_L + 256 * MiB, WS_MIXCAT = WS_L + 272 * MiB, WS_U = WS_L + 304 * MiB;
constexpr size_t WS_QB2 = WS_L, WS_KB2 = WS_L + 32 * MiB, WS_VT = WS_L + 64 * MiB, WS_ATTO = WS_L + 96 * MiB, WS_HPERM = WS_L + 128 * MiB, WS_UE = WS_L + 200 * MiB, WS_Y = WS_L + 452 * MiB;
constexpr size_t WS_YP = WS_L + 528 * MiB;
constexpr size_t WS_END = WS_L + 596 * MiB;

constexpr int CW_TMO = 0, CW_CODE = 1;
constexpr int CW_BAR = 4096;
constexpr int CW_QCVT = 10496;
constexpr int CW_RDONE = 10240;
constexpr int CW_CNT = 8192;

constexpr int RING_OFF = 0, RING_BYTES = 131072;
constexpr int LDS_BYTES = 147456;
constexpr int LDSCTL_OFF = LDS_BYTES - 512, MISC_OFF = LDSCTL_OFF;

#define GAS __attribute__((address_space(1)))
#define LAS __attribute__((address_space(3)))
typedef unsigned short bf16;
typedef unsigned v4u __attribute__((ext_vector_type(4)));
typedef unsigned v2u __attribute__((ext_vector_type(2)));
typedef float f32x4 __attribute__((ext_vector_type(4)));
typedef GAS unsigned gu32;
#define RLX_AGENT __ATOMIC_RELAXED, __HIP_MEMORY_SCOPE_AGENT
#define LDS_WAIT() asm volatile("s_waitcnt lgkmcnt(0)" ::: "memory")
#define VM_WAIT() asm volatile("s_waitcnt vmcnt(0)" ::: "memory")
__device__ __forceinline__ unsigned pk2(float lo, float hi) { return pg8::cvt_pk_bf16(lo, hi); }
__device__ __forceinline__ float bflo(unsigned w) { return __uint_as_float(w << 16); }
__device__ __forceinline__ float bfhi(unsigned w) { return __uint_as_float(w & 0xffff0000u); }
__device__ __forceinline__ float logsig(float x) { return fminf(x, 0.f) - log1pf(expf(-fabsf(x))); }
__device__ __forceinline__ float dot4(f32x4 a, f32x4 b) { return (a.x * b.x + a.y * b.y) + (a.z * b.z + a.w * b.w); }

#define XB_TMO      128
#define XB_XCNT(j)  (256  + 64 * (j))
#define XB_XSUB(j)  (1280 + 64 * (j))
#define XB_XGEN(j)  (2304 + 64 * (j))
#define XB_TOP      3328
#define XB_TOPGEN   3392
#define XCD_BAR_WORDS 3456
#define XB_SPIN_CAP (1u << 20)

__device__ __forceinline__ unsigned xb_ld(unsigned* p)              { return __hip_atomic_load(p, __ATOMIC_RELAXED, __HIP_MEMORY_SCOPE_AGENT); }
__device__ __forceinline__ unsigned xb_add(unsigned* p, unsigned v) { return __hip_atomic_fetch_add(p, v, __ATOMIC_RELAXED, __HIP_MEMORY_SCOPE_AGENT); }
__device__ __forceinline__ unsigned xb_xcc_id() { return (unsigned)__builtin_amdgcn_s_getreg((3 << 11) | 20) & 0xFu; }
#define XB_SPIN(cond, bar) do { unsigned _sp = 0; while (cond) { __builtin_amdgcn_s_sleep(1); \
    if ((++_sp & 255u) == 0u) { if (xb_ld(&(bar)[XB_TMO])) break; if (_sp > XB_SPIN_CAP) { atomicAdd(&(bar)[XB_TMO], 1u); break; } } } } while (0)

struct XcdBarrier { unsigned* bar; unsigned x; volatile LAS unsigned* st; };

__device__ __forceinline__ XcdBarrier xcd_barrier_post(unsigned* bar, volatile LAS unsigned* st) {
    XcdBarrier b; b.bar = bar; b.x = xb_xcc_id(); b.st = st;
    if (threadIdx.x == 0) (void)xb_add(&bar[XB_XCNT(b.x)], 1u);
    return b;
}
__device__ __forceinline__ void xcd_barrier_complete(unsigned* bar, unsigned x, unsigned& nloc, unsigned& nx) {
    const unsigned G = gridDim.x * gridDim.y * gridDim.z;
    unsigned sum, cnt, mine, sp = 0u;
    for (;;) {
        sum = 0u; cnt = 0u; mine = 0u;
#pragma unroll
        for (unsigned j = 0; j < 16; ++j) { const unsigned c = xb_ld(&bar[XB_XCNT(j)]); sum += c; cnt += (c > 0u) ? 1u : 0u; mine = (j == x) ? c : mine; }
        if (sum == G) break;
        __builtin_amdgcn_s_sleep(1);
        if ((++sp & 255u) == 0u) { if (xb_ld(&bar[XB_TMO])) break; if (sp > XB_SPIN_CAP) { atomicAdd(&bar[XB_TMO], 1u); break; } }
    }
    nloc = mine > 0u ? mine : 1u; nx = cnt > 0u ? cnt : 1u;
}
__device__ __forceinline__ void xcd_barrier(const XcdBarrier& b) {
    asm volatile("s_waitcnt vmcnt(0)" ::: "memory");
    __syncthreads();
    int tid0 = threadIdx.x; asm volatile("" : "+v"(tid0));
    if (tid0 == 0) {
        unsigned* bar = b.bar;
        __builtin_amdgcn_s_waitcnt(0);
        unsigned nloc = b.st[0], nx = b.st[1];
        if (nloc == 0u) { xcd_barrier_complete(bar, b.x, nloc, nx); b.st[0] = nloc; b.st[1] = nx; }
        const unsigned old = xb_add(&bar[XB_XSUB(b.x)], 1u);
        const unsigned gen = old / nloc;
        if (old + 1u == (gen + 1u) * nloc) {
            __builtin_amdgcn_fence(__ATOMIC_RELEASE, "agent");
            asm volatile("s_waitcnt vmcnt(0)" ::: "memory");
            const unsigned og = xb_add(&bar[XB_TOP], 1u);
            const unsigned tg = og / nx;
            if (og + 1u == (tg + 1u) * nx) xb_add(&bar[XB_TOPGEN], 1u);
            else XB_SPIN(xb_ld(&bar[XB_TOPGEN]) == tg, bar);
            __builtin_amdgcn_fence(__ATOMIC_ACQUIRE, "agent");
            xb_add(&bar[XB_XGEN(b.x)], 1u);
            asm volatile("s_waitcnt vmcnt(0)" ::: "memory");
        } else {
            XB_SPIN(xb_ld(&bar[XB_XGEN(b.x)]) == gen, bar);
            __builtin_amdgcn_fence(__ATOMIC_ACQUIRE, "agent");
            asm volatile("s_waitcnt vmcnt(0)" ::: "memory");
        }
    }
    __syncthreads();
}

struct Args { const float* in[24]; float* out; unsigned char* ws; };
struct Frame {
    LAS unsigned char* lds; volatile LAS unsigned* MISC; gu32* ctl;
    int G, bid;
    unsigned char* ws;
};
__device__ __forceinline__ float wave_sum(float v) {
#pragma unroll
    for (int o = 1; o < 64; o <<= 1) v += __shfl_xor(v, o);
    return v;
}

__device__ __forceinline__ void transpose_item(const float* src, int spitch, int k0, int n0s, bf16* dst, int dpitch, int n0d, LAS unsigned* T, int lane) {
    const int kr = lane & 3, nq = lane >> 2;
#pragma unroll
    for (int i = 0; i < 8; ++i) {
        const int k = k0 + 8 * i + 2 * kr;
        const f32x4 a = *(const f32x4*)(src + (size_t)k * spitch + n0s + 4 * nq);
        const f32x4 b = *(const f32x4*)(src + (size_t)(k + 1) * spitch + n0s + 4 * nq);
#pragma unroll
        for (int j = 0; j < 4; ++j) T[(4 * nq + j) * 33 + 4 * i + kr] = pk2(a[j], b[j]);
    }
    LDS_WAIT();
#pragma unroll
    for (int it = 0; it < 8; ++it) {
        const int n = (lane >> 3) + 8 * it, c = lane & 7;
        v4u o; o.x = T[n * 33 + 4 * c]; o.y = T[n * 33 + 4 * c + 1]; o.z = T[n * 33 + 4 * c + 2]; o.w = T[n * 33 + 4 * c + 3];
        *(v4u*)(dst + (size_t)(n0d + n) * dpitch + k0 + 8 * c) = o;
    }
    LDS_WAIT();
}
__device__ __forceinline__ void transpose_item8(const float* src, int spitch, int k0, int n0s, unsigned char* dst, int dpitch, int n0d, float scale, LAS unsigned* T, int lane) {
    const int kr = lane & 3, nq = lane >> 2;
    f32x4 a[8][4];
#pragma unroll
    for (int i = 0; i < 8; ++i) { const float* p = src + (size_t)(k0 + 16 * i + 4 * kr) * spitch + n0s + 4 * nq;
#pragma unroll
        for (int q = 0; q < 4; ++q) a[i][q] = *(const f32x4*)(p + (size_t)q * spitch); }
#pragma unroll
    for (int i = 0; i < 8; ++i)
#pragma unroll
        for (int j = 0; j < 4; ++j) T[(4 * nq + j) * 33 + 4 * i + kr] = pg8::pk4_fp8(a[i][0][j] * scale, a[i][1][j] * scale, a[i][2][j] * scale, a[i][3][j] * scale);
    LDS_WAIT();
#pragma unroll
    for (int it = 0; it < 8; ++it) {
        const int n = (lane >> 3) + 8 * it, c = lane & 7;
        v4u o; o.x = T[n * 33 + 4 * c]; o.y = T[n * 33 + 4 * c + 1]; o.z = T[n * 33 + 4 * c + 2]; o.w = T[n * 33 + 4 * c + 3];
        *(v4u*)(dst + (size_t)(n0d + n) * dpitch + k0 + 16 * c) = o;
    }
    LDS_WAIT();
}
constexpr float WS8 = 64.0f;
constexpr int I_W13E = 8 * 16 * 224, I_W2E = 8 * 56 * 32, I_WIN = 32 * 80, I_WOUT = 32 * 32, I_W13 = 32 * 176, I_W2 = 88 * 32, I_WQKV = 32 * 96, I_WO = 32 * 32, I_POOL = 4 * 16;
constexpr int N_ITEMS = I_W13E + I_W2E + I_WIN + I_WOUT + I_W13 + I_W2 + I_WQKV + I_WO + I_POOL;
constexpr int NT_W13E = 8 * 8 * 56, NT_W2E = 8 * 28 * 8, NT_WIN = 16 * 20, NT_WOUT = 16 * 8, NT_W13 = 0, NT_W2 = 0  , NT_WQKV = 16 * 24, NT_WO = 16 * 8, NT_POOL = 8;
constexpr int NT_W13F = 8 * 44, NT_W2F = 22 * 8;
constexpr int NT_ALL = NT_W13E + NT_W2E + NT_W13F + NT_W2F + NT_WIN + NT_WOUT + NT_W13 + NT_W2 + NT_WQKV + NT_WO + NT_POOL;
constexpr int TAILQ2 = 7, TAILQ10 = 5, TAILQ6 = 1, TAILQ4 = 1;
constexpr int P0_TILE0 = 128 * (TAILQ2 + TAILQ10 + TAILQ6 + TAILQ4);
constexpr int QCVT_N = 1024, QCVT_LO = NT_W13E + NT_W2E - QCVT_N;

template <bool DYN = false>
__device__ __forceinline__ void convert_tiles(Frame& F, const Args& args, int first, int last, int stride, gu32* q = nullptr) {
    int tid = threadIdx.x; asm volatile("" : "+v"(tid)); const int lane = tid & 63, wave = __builtin_amdgcn_readfirstlane(tid >> 6);
    unsigned char* ws = F.ws;
    {
        const int nl = 4 * lane;
        struct Tile { const float* s; int spitch; unsigned char* d; size_t dpitch; bool f8; };
        auto decode = [&](int it) -> Tile {
            Tile t; int r = it; if (!DYN && r >= QCVT_LO) r += QCVT_N;
            if (r < NT_W13E) { const int e = r / (8 * 56), rr = r % (8 * 56), kb = rr / 56, nb = rr % 56; t.f8 = true; t.spitch = DFE;
                t.s = (nl < 128 ? args.in[21] + nb * 128 + nl : args.in[22] + nb * 128 + nl - 128) + (size_t)e * 2048 * DFE + (size_t)(kb * 256 + wave * 32) * DFE;
                t.d = ws + WS_W13E + ((size_t)e * 14336 + nb * 256) * 2048 + kb * 256; t.dpitch = 2048; }
            else if ((r -= NT_W13E) < NT_W2E) { const int e = r / (28 * 8), rr = r % (28 * 8), kb = rr / 8, nb = rr % 8; t.f8 = true; t.spitch = 2048;
                t.s = args.in[23] + (size_t)e * DFE * 2048 + (size_t)(kb * 256 + wave * 32) * 2048 + nb * 256 + nl;
                t.d = ws + WS_W2E + ((size_t)e * 2048 + nb * 256) * DFE + kb * 256; t.dpitch = DFE; }
            else if ((r -= NT_W2E) < NT_W13F) { const int kb = r / 44, nb = r % 44; t.f8 = true; t.spitch = DFF;
                t.s = (nl < 128 ? args.in[15] + nb * 128 + nl : args.in[16] + nb * 128 + nl - 128) + (size_t)(kb * 256 + wave * 32) * DFF;
                t.d = ws + WS_W13 + ((size_t)nb * 256) * 2048 + kb * 256; t.dpitch = 2048; }
            else if ((r -= NT_W13F) < NT_W2F) { const int kb = r / 8, nb = r % 8; t.f8 = true; t.spitch = 2048;
                t.s = args.in[17] + (size_t)(kb * 256 + wave * 32) * 2048 + nb * 256 + nl;
                t.d = ws + WS_W2 + ((size_t)nb * 256) * DFF + kb * 256; t.dpitch = DFF; }
            else { t.f8 = false; r -= NT_W2F; int kb, nb, K; const float* base; unsigned char* db; int scol;
                if (r < NT_WIN) { kb = r / 20; nb = r % 20; K = 2048; t.spitch = DINS; base = args.in[7]; db = ws + WS_WIN; scol = nb * 256 + nl + (nb >= 16 ? 8 : 0); }
                else if ((r -= NT_WIN) < NT_WOUT) { kb = r / 8; nb = r % 8; K = 2048; t.spitch = 2048; base = args.in[14]; db = ws + WS_WOUT; scol = nb * 256 + nl; }
                else if ((r -= NT_WOUT) < NT_W13) { kb = r / 44; nb = r % 44; K = 2048; t.spitch = DFF; base = (nl < 128 ? args.in[15] : args.in[16] - 128); db = ws + WS_W13; scol = nb * 128 + nl; }
                else if ((r -= NT_W13) < NT_W2) { kb = r / 8; nb = r % 8; K = DFF; t.spitch = 2048; base = args.in[17]; db = ws + WS_W2; scol = nb * 256 + nl; }
                else if ((r -= NT_W2) < NT_WQKV) { kb = r / 24; nb = r % 24; K = 2048; t.spitch = 6144; base = args.in[18]; db = ws + WS_WQKV; scol = nb * 256 + nl; }
                else if ((r -= NT_WQKV) < NT_WO) { kb = r / 8; nb = r % 8; K = 2048; t.spitch = 2048; base = args.in[19]; db = ws + WS_WO; scol = nb * 256 + nl; }
                else { r -= NT_WO; kb = r & 1; nb = 0; K = 256; t.spitch = 256; base = args.in[12] + (size_t)(r >> 1) * 65536; db = ws + WS_POOLW + (size_t)(r >> 1) * 131072; scol = nl; }
                t.s = base + (size_t)(kb * 128 + wave * 16) * t.spitch + scol; t.d = db + ((size_t)nb * 256 * K + kb * 128) * 2; t.dpitch = (size_t)K * 2; }
            return t; };
        int buf = 0;
        f32x4 a[32];
        LAS int* slot = (LAS int*)(F.lds + RING_OFF + RING_BYTES + 8192);
        int it = first, nxt = 0, kq = 0;
        if (DYN) { if (tid == 0) { slot[0] = first + (int)__hip_atomic_fetch_add(q, 1u, __ATOMIC_RELAXED, __HIP_MEMORY_SCOPE_AGENT); slot[1] = first + (int)__hip_atomic_fetch_add(q, 1u, __ATOMIC_RELAXED, __HIP_MEMORY_SCOPE_AGENT); }
            __syncthreads(); it = __builtin_amdgcn_readfirstlane(slot[0]); nxt = __builtin_amdgcn_readfirstlane(slot[1]); __syncthreads(); }
        Tile cur = decode(it < last ? it : 0);
        if (it < last) {
#pragma unroll
            for (int kk = 0; kk < 32; ++kk) if (kk < 16 || cur.f8) a[kk] = __builtin_nontemporal_load((const f32x4*)(cur.s + (size_t)kk * cur.spitch));
        }
        for (; it < last; ) {
            LAS unsigned char* T = F.lds + buf * 65536;
            int tk = 0; if (DYN && tid == 0) tk = first + (int)__hip_atomic_fetch_add(q, 1u, __ATOMIC_RELAXED, __HIP_MEMORY_SCOPE_AGENT);
            const int c0 = 2 * wave, sw = lane & 15;
            if (cur.f8) {
#pragma unroll
                for (int j = 0; j < 4; ++j) { v4u o0, o1;
                    o0.x = pg8::pk4_fp8(a[0][j] * WS8, a[1][j] * WS8, a[2][j] * WS8, a[3][j] * WS8);     o0.y = pg8::pk4_fp8(a[4][j] * WS8, a[5][j] * WS8, a[6][j] * WS8, a[7][j] * WS8);
                    o0.z = pg8::pk4_fp8(a[8][j] * WS8, a[9][j] * WS8, a[10][j] * WS8, a[11][j] * WS8);   o0.w = pg8::pk4_fp8(a[12][j] * WS8, a[13][j] * WS8, a[14][j] * WS8, a[15][j] * WS8);
                    o1.x = pg8::pk4_fp8(a[16][j] * WS8, a[17][j] * WS8, a[18][j] * WS8, a[19][j] * WS8); o1.y = pg8::pk4_fp8(a[20][j] * WS8, a[21][j] * WS8, a[22][j] * WS8, a[23][j] * WS8);
                    o1.z = pg8::pk4_fp8(a[24][j] * WS8, a[25][j] * WS8, a[26][j] * WS8, a[27][j] * WS8); o1.w = pg8::pk4_fp8(a[28][j] * WS8, a[29][j] * WS8, a[30][j] * WS8, a[31][j] * WS8);
                    *(LAS v4u*)(T + (nl + j) * 256 + ((c0 ^ sw) << 4)) = o0; *(LAS v4u*)(T + (nl + j) * 256 + (((c0 + 1) ^ sw) << 4)) = o1; }
            } else {
#pragma unroll
                for (int j = 0; j < 4; ++j) { v4u o0, o1;
                    o0.x = pk2(a[0][j], a[1][j]); o0.y = pk2(a[2][j], a[3][j]); o0.z = pk2(a[4][j], a[5][j]); o0.w = pk2(a[6][j], a[7][j]);
                    o1.x = pk2(a[8][j], a[9][j]); o1.y = pk2(a[10][j], a[11][j]); o1.z = pk2(a[12][j], a[13][j]); o1.w = pk2(a[14][j], a[15][j]);
                    *(LAS v4u*)(T + (nl + j) * 256 + ((c0 ^ sw) << 4)) = o0; *(LAS v4u*)(T + (nl + j) * 256 + (((c0 + 1) ^ sw) << 4)) = o1; }
            }
            const Tile done = cur; const int nx = DYN ? nxt : it + stride;
            if (nx < last) { cur = decode(nx);
#pragma unroll
                for (int kk = 0; kk < 32; ++kk) if (kk < 16 || cur.f8) a[kk] = __builtin_nontemporal_load((const f32x4*)(cur.s + (size_t)kk * cur.spitch)); }
            if (DYN && tid == 0) slot[kq & 1] = tk;
            __syncthreads();
#pragma unroll
            for (int i = 0; i < 8; ++i) { const int row = (tid >> 4) + 32 * i, c = tid & 15;
                const v4u o = *(const LAS v4u*)(T + row * 256 + ((c ^ ((row >> 2) & 15)) << 4));
                __builtin_nontemporal_store(o, (v4u*)(done.d + (size_t)row * done.dpitch + 16 * c)); }
            buf ^= 1;
            if (DYN) { it = nxt; nxt = __builtin_amdgcn_readfirstlane(slot[kq & 1]); ++kq; } else it += stride;
        }
    }
    __syncthreads();
}

__device__ __forceinline__ void p0_prologue(Frame& F, const Args& args) {
    int tid = threadIdx.x; asm volatile("" : "+v"(tid)); const int lane = tid & 63, wave = __builtin_amdgcn_readfirstlane(tid >> 6); (void)lane; (void)wave;
    unsigned char* ws = F.ws;
    {
        LAS float* sC = (LAS float*)(F.lds);
        LAS float* sR = sC + 4096;
        const float* c = args.in[1]; const float* adaw = args.in[2]; const float* adab = args.in[3]; float* MOD = (float*)(ws + WS_MOD);
        bool have = false;
        for (int task = F.bid; task < 256; task += F.G) {
            if (!have) { for (int i = tid; i < 4096; i += 512) { const float cv = c[i]; sC[i] = cv / (1.0f + expf(-cv)); } __syncthreads(); have = true; }
            const int l = task >> 7, n0 = (task & 127) * 96, cq = tid % 24, ks = tid / 24;
            if (ks < 21) {
                const int k0 = ks * 98, k1 = (k0 + 98 < 2048) ? k0 + 98 : 2048;
                const float* W = adaw + (size_t)l * 2048 * 12288 + n0 + 4 * cq;
                f32x4 a0 = {0.f, 0.f, 0.f, 0.f}, a1 = {0.f, 0.f, 0.f, 0.f};
#pragma unroll 7
                for (int k = k0; k < k1; ++k) { const f32x4 w = __builtin_nontemporal_load((const f32x4*)(W + (size_t)k * 12288)); a0 += sC[k] * w; a1 += sC[2048 + k] * w; }
#pragma unroll
                for (int j = 0; j < 4; ++j) { sR[(ks * 2 + 0) * 96 + 4 * cq + j] = a0[j]; sR[(ks * 2 + 1) * 96 + 4 * cq + j] = a1[j]; }
            }
            __syncthreads();
            if (tid < 192) { const int b = tid / 96, n = tid % 96; float s = 0.f;
#pragma unroll
                for (int k2 = 0; k2 < 21; ++k2) s += sR[(k2 * 2 + b) * 96 + n];
                MOD[(size_t)(l * 2 + b) * 12288 + n0 + n] = s + adab[l * 12288 + n0 + n]; }
            __syncthreads();
        }
        __syncthreads();
    }
    {
        const float* win = args.in[7]; const float* rw = args.in[20]; float* GWT = (float*)(ws + WS_GWT); float* RWT = (float*)(ws + WS_RWT);
        for (int i = F.bid * 512 + tid; i < 16384; i += F.G * 512) { const int g = i >> 11, k = i & 2047; GWT[i] = win[(size_t)k * DINS + 4096 + g]; RWT[i] = rw[k * 8 + g]; }
    }
    convert_tiles(F, args, (F.G == 256 ? P0_TILE0 : 0) + F.bid, NT_ALL - QCVT_N, F.G);
}

template <int MODE, bool X16, bool OUT8 = false>
__device__ __forceinline__ void norm_phase(Frame& F, const void* xin, const float* gain, const float* modl, int sh_off, int sc_off, bf16* HN,
                                           const float* tab, const float* bias8, float* gates_out, unsigned* tokinfo, gu32* cnt) {
    int tid = threadIdx.x; asm volatile("" : "+v"(tid)); const int lane = tid & 63, wave = __builtin_amdgcn_readfirstlane(tid >> 6); (void)lane; (void)wave;
    LAS float* sT = (LAS float*)(F.lds);
    if (MODE != 1) { for (int i = tid; i < 16384; i += 512) sT[i] = tab[i]; __syncthreads(); }
    const int gw = F.bid * NWAVES + wave, NGW = F.G * NWAVES;
    for (int t0 = gw * 4; t0 < NTOK; t0 += NGW * 4) {
        const int b = t0 >> 12;
        f32x4 ga[8], sb[8];
#pragma unroll
        for (int j = 0; j < 8; ++j) { const int col = 4 * (lane + 64 * j);
            const f32x4 g = *(const f32x4*)(gain + col), sc = *(const f32x4*)(modl + (size_t)b * 12288 + sc_off + col);
            ga[j] = g * (sc + 1.0f); sb[j] = *(const f32x4*)(modl + (size_t)b * 12288 + sh_off + col); }
        v2u xw4[4][8]; (void)xw4;
        if (X16) {
#pragma unroll
            for (int i = 0; i < 4; ++i)
#pragma unroll
                for (int j = 0; j < 8; ++j) xw4[i][j] = *(const v2u*)((const bf16*)xin + (size_t)(t0 + i) * DM + 4 * (lane + 64 * j)); }
#pragma unroll
        for (int i = 0; i < 4; ++i) {
            const int t = t0 + i;
            f32x4 v[8]; float ss = 0.f;
#pragma unroll
            for (int j = 0; j < 8; ++j) {
                if (X16) { const v2u w = xw4[i][j]; v[j] = (f32x4){bflo(w.x), bfhi(w.x), bflo(w.y), bfhi(w.y)}; }
                else v[j] = *(const f32x4*)((const float*)xin + (size_t)t * DM + 4 * (lane + 64 * j));
                ss += dot4(v[j], v[j]); }
            ss = wave_sum(ss);
            const float r = 1.0f / sqrtf(ss * (1.0f / DM) + EPS);
#pragma unroll
            for (int j = 0; j < 8; ++j) { v[j] = v[j] * r * ga[j] + sb[j];
                if (OUT8) *(unsigned*)((unsigned char*)HN + (size_t)t * DM + 4 * (lane + 64 * j)) = pg8::pk4_fp8(v[j].x, v[j].y, v[j].z, v[j].w);
                else { v2u o; o.x = pk2(v[j].x, v[j].y); o.y = pk2(v[j].z, v[j].w);
                *(v2u*)(HN + (size_t)t * DM + 4 * (lane + 64 * j)) = o; } }
            if (MODE != 1) {
                float a8[8];
#pragma unroll
                for (int g = 0; g < 8; ++g) { float s = 0.f;
#pragma unroll
                    for (int j = 0; j < 8; ++j) { const f32x4 tv = *(const LAS f32x4*)(sT + g * 2048 + 4 * (lane + 64 * j)); s += dot4(v[j], tv); }
                    a8[g] = wave_sum(s); }
                if (MODE == 0) {
                    if (lane == 0) {
                        f32x4 o0 = {a8[0] + bias8[0], a8[1] + bias8[1], a8[2] + bias8[2], a8[3] + bias8[3]}, o1 = {a8[4] + bias8[4], a8[5] + bias8[5], a8[6] + bias8[6], a8[7] + bias8[7]};
                        *(f32x4*)(gates_out + (size_t)t * 8) = o0; *(f32x4*)(gates_out + (size_t)t * 8 + 4) = o1; }
                } else {
                    if (lane == 0) {
                        int e0 = 0; float v0 = a8[0];
#pragma unroll
                        for (int g = 1; g < 8; ++g) if (a8[g] > v0) { v0 = a8[g]; e0 = g; }
                        int e1 = -1; float v1 = -3.0e38f;
#pragma unroll
                        for (int g = 0; g < 8; ++g) if (g != e0 && a8[g] > v1) { v1 = a8[g]; e1 = g; }
                        const float ex = expf(v1 - v0), g0 = 1.0f / (1.0f + ex), g1 = ex / (1.0f + ex);
                        const unsigned p0 = __hip_atomic_fetch_add(cnt + 64 * e0, 1u, RLX_AGENT), p1 = __hip_atomic_fetch_add(cnt + 64 * e1, 1u, RLX_AGENT);
                        v4u w0; w0.x = (unsigned)e0; w0.y = (unsigned)e1; w0.z = p0; w0.w = p1;
                        v4u w1; w1.x = __float_as_uint(g0); w1.y = __float_as_uint(g1); w1.z = 0u; w1.w = 0u;
                        *(v4u*)(tokinfo + (size_t)t * 8) = w0; *(v4u*)(tokinfo + (size_t)t * 8 + 4) = w1; }
                }
            }
        }
    }
    if (MODE != 1) __syncthreads();
}

template <int W>
__device__ __forceinline__ void pool_rows(const bf16* __restrict__ PROJ, bf16* __restrict__ POOLED, int tb, int posb, int col) {
    float h0[W - 1], h1[W - 1];
#pragma unroll
    for (int j = 0; j < W - 1; ++j) { const bool in = posb - 1 - j >= 0; const unsigned rr = *(const unsigned*)(PROJ + (size_t)(in ? tb - 1 - j : tb) * DINP + 4096 + col); const unsigned r = in ? rr : 0u; h0[j] = bflo(r); h1[j] = bfhi(r); }
    for (int i8 = 0; i8 < 32; i8 += 8) {
        unsigned r8[8];
#pragma unroll
        for (int ii = 0; ii < 8; ++ii) r8[ii] = *(const unsigned*)(PROJ + (size_t)(tb + i8 + ii) * DINP + 4096 + col);
#pragma unroll
        for (int ii = 0; ii < 8; ++ii) {
            const int t = tb + i8 + ii, pos = posb + i8 + ii, cnt = (pos + 1 < W) ? pos + 1 : W;
            const float x0 = bflo(r8[ii]), x1 = bfhi(r8[ii]);
            float s0 = x0, s1 = x1;
#pragma unroll
            for (int j = 0; j < W - 1; ++j) { s0 += h0[j]; s1 += h1[j]; }
            const float ic = __builtin_amdgcn_rcpf((float)cnt);
            *(unsigned*)(POOLED + (size_t)t * 1024 + col) = pk2(s0 * ic - x0, s1 * ic - x1);
#pragma unroll
            for (int j = W - 2; j > 0; --j) { h0[j] = h0[j - 1]; h1[j] = h1[j - 1]; }
            h0[0] = x0; h1[0] = x1;
        }
    }
}
__device__ __forceinline__ void prep_phase(Frame& F, const Args& args) {
    int tid = threadIdx.x; asm volatile("" : "+v"(tid)); const int lane = tid & 63, wave = __builtin_amdgcn_readfirstlane(tid >> 6);
    unsigned char* ws = F.ws;
    const bf16* __restrict__ PROJ = (const bf16*)(ws + WS_PROJ); const float* __restrict__ GATES = (const float*)(ws + WS_GATES);
    float* __restrict__ BCUM = (float*)(ws + WS_BCUM); float* __restrict__ IG = (float*)(ws + WS_IG); float* __restrict__ GTOT = (float*)(ws + WS_GTOT); float* __restrict__ DN = (float*)(ws + WS_DN);
    bf16* __restrict__ QB = (bf16*)(ws + WS_QB); bf16* __restrict__ KB = (bf16*)(ws + WS_KB); bf16* __restrict__ KWT = (bf16*)(ws + WS_KWT); bf16* __restrict__ AP = (bf16*)(ws + WS_AP); bf16* __restrict__ BP = (bf16*)(ws + WS_BP);
    bf16* __restrict__ POOLED = (bf16*)(ws + WS_POOLED);
    const float* __restrict__ convw = args.in[9]; const float* __restrict__ convb = args.in[10];
    LAS float* sB = (LAS float*)(F.lds); LAS float* sI = sB + 256; LAS float* sW = sI + 256;
    LAS unsigned* TK = (LAS unsigned*)(F.lds + 4096); LAS unsigned* TV = TK + 128 * 129;
    for (int task = F.bid; task < 2 * NUNIT; task += F.G) {
        const int u = task >> 1, half = task & 1, b = u >> 6, h = (u >> 4) & 3, c = u & 15, t0 = b * SEQ + c * 256;
        float sc = 0.f, ir = 0.f;
        if (tid < 256) { const float fr = GATES[(size_t)(t0 + tid) * 8 + 4 + h]; ir = GATES[(size_t)(t0 + tid) * 8 + h]; sc = logsig(fr);
#pragma unroll
            for (int o = 1; o < 64; o <<= 1) { const float y = __shfl_up(sc, o); if (lane >= o) sc += y; }
            sI[tid] = ir; if (lane == 63) sW[wave] = sc; }
        __syncthreads();
        if (tid < 256) { for (int w2 = 0; w2 < wave; ++w2) sc += sW[w2]; sB[tid] = sc; if (half == 0) { BCUM[u * 256 + tid] = sc; IG[u * 256 + tid] = ir; } }
        __syncthreads();
        const float Gt = sB[255];
        if (half == 0 && tid == 0) GTOT[u] = Gt;
        {
            const int cp = tid & 63, tg = tid >> 6, dc = half * 128 + 2 * cp, chq = h * 256 + dc, chk = 1024 + h * 256 + dc, chv = 2048 + h * 256 + dc;
            float wq[4][2], wk[4][2], bq[2], bk[2];
#pragma unroll
            for (int j = 0; j < 4; ++j) { wq[j][0] = convw[j * 2048 + chq]; wq[j][1] = convw[j * 2048 + chq + 1]; wk[j][0] = convw[j * 2048 + chk]; wk[j][1] = convw[j * 2048 + chk + 1]; }
            bq[0] = convb[chq]; bq[1] = convb[chq + 1]; bk[0] = convb[chk]; bk[1] = convb[chk + 1];
            const int tl0 = tg * 32, pos0 = c * 256 + tl0;
            float xq[3][2], xk[3][2];
#pragma unroll
            for (int jj = 0; jj < 3; ++jj) { const int p = pos0 - 3 + jj; unsigned rq = 0u, rk = 0u;
                if (p >= 0) { const bf16* row = PROJ + (size_t)(b * SEQ + p) * DINP; rq = *(const unsigned*)(row + chq); rk = *(const unsigned*)(row + chk); }
                xq[jj][0] = bflo(rq); xq[jj][1] = bfhi(rq); xk[jj][0] = bflo(rk); xk[jj][1] = bfhi(rk); }
            for (int i8 = 0; i8 < 32; i8 += 8) {
                unsigned rq8[8], rk8[8], rv8[8];
#pragma unroll
                for (int ii = 0; ii < 8; ++ii) { const bf16* row = PROJ + (size_t)(t0 + tl0 + i8 + ii) * DINP; rq8[ii] = *(const unsigned*)(row + chq); rk8[ii] = *(const unsigned*)(row + chk); rv8[ii] = *(const unsigned*)(row + chv); }
                float pkw0 = 0.f, pkw1 = 0.f, pv0 = 0.f, pv1 = 0.f;
#pragma unroll
                for (int ii = 0; ii < 8; ++ii) {
                    const int tl = tl0 + i8 + ii; const unsigned rq = rq8[ii], rk = rk8[ii], rv = rv8[ii];
                    const float cq0 = bflo(rq), cq1 = bfhi(rq), ck0 = bflo(rk), ck1 = bfhi(rk);
                    const float yq0 = bq[0] + wq[0][0] * xq[0][0] + wq[1][0] * xq[1][0] + wq[2][0] * xq[2][0] + wq[3][0] * cq0;
                    const float yq1 = bq[1] + wq[0][1] * xq[0][1] + wq[1][1] * xq[1][1] + wq[2][1] * xq[2][1] + wq[3][1] * cq1;
                    const float yk0 = bk[0] + wk[0][0] * xk[0][0] + wk[1][0] * xk[1][0] + wk[2][0] * xk[2][0] + wk[3][0] * ck0;
                    const float yk1 = bk[1] + wk[0][1] * xk[0][1] + wk[1][1] * xk[1][1] + wk[2][1] * xk[2][1] + wk[3][1] * ck1;
                    xq[0][0] = xq[1][0]; xq[1][0] = xq[2][0]; xq[2][0] = cq0; xq[0][1] = xq[1][1]; xq[1][1] = xq[2][1]; xq[2][1] = cq1;
                    xk[0][0] = xk[1][0]; xk[1][0] = xk[2][0]; xk[2][0] = ck0; xk[0][1] = xk[1][1]; xk[1][1] = xk[2][1]; xk[2][1] = ck1;
                    const float q0 = yq0 * __builtin_amdgcn_rcpf(1.0f + __expf(-yq0)) * 0.0625f, q1 = yq1 * __builtin_amdgcn_rcpf(1.0f + __expf(-yq1)) * 0.0625f;
                    const float k0 = yk0 * __builtin_amdgcn_rcpf(1.0f + __expf(-yk0)), k1 = yk1 * __builtin_amdgcn_rcpf(1.0f + __expf(-yk1));
                    const float bt = sB[tl], it = sI[tl], eb = __expf(bt), kwf = __expf(Gt - bt + it);
                    const size_t ro = (size_t)u * 256 + tl;
                    *(unsigned*)(QB + ro * 256 + dc) = pk2(q0, q1);
                    *(unsigned*)(AP + ro * 512 + dc) = pk2(eb * q0, eb * q1);
                    *(unsigned*)(KB + ro * 256 + dc) = pk2(k0, k1);
                    const float kw0 = kwf * k0, kw1 = kwf * k1, v0 = bflo(rv), v1 = bfhi(rv);
                    if (ii & 1) { TK[(2 * cp) * 129 + (tl >> 1)] = pk2(pkw0, kw0); TK[(2 * cp + 1) * 129 + (tl >> 1)] = pk2(pkw1, kw1);
                                  TV[(2 * cp) * 129 + (tl >> 1)] = pk2(pv0, v0);   TV[(2 * cp + 1) * 129 + (tl >> 1)] = pk2(pv1, v1); }
                    else { pkw0 = kw0; pkw1 = kw1; pv0 = v0; pv1 = v1; }
                }
            }
        }
        __syncthreads();
        for (int idx = tid; idx < 128 * 32; idx += 512) { const int dl = idx >> 5, ch = idx & 31;
            v4u o; o.x = TK[dl * 129 + 4 * ch]; o.y = TK[dl * 129 + 4 * ch + 1]; o.z = TK[dl * 129 + 4 * ch + 2]; o.w = TK[dl * 129 + 4 * ch + 3];
            *(v4u*)(KWT + ((size_t)u * 256 + half * 128 + dl) * 256 + 8 * ch) = o;
            o.x = TV[dl * 129 + 4 * ch]; o.y = TV[dl * 129 + 4 * ch + 1]; o.z = TV[dl * 129 + 4 * ch + 2]; o.w = TV[dl * 129 + 4 * ch + 3];
            *(v4u*)(BP + ((size_t)u * 256 + half * 128 + dl) * 512 + 256 + 8 * ch) = o; }
        if (tid < 128) { float s = 0.f; for (int w2 = 0; w2 < 128; ++w2) { const unsigned p = TK[tid * 129 + w2]; s += bflo(p) + bfhi(p); } DN[u * 256 + half * 128 + tid] = s; }
        __syncthreads();
    }
    for (int pb = F.bid; pb < NTOK / 32; pb += F.G) {
        const int col = 2 * tid, g = __builtin_amdgcn_readfirstlane(col >> 8), tb = pb * 32, posb = tb & (SEQ - 1);
        if (g == 0) pool_rows<2>(PROJ, POOLED, tb, posb, col); else if (g == 1) pool_rows<4>(PROJ, POOLED, tb, posb, col);
        else if (g == 2) pool_rows<8>(PROJ, POOLED, tb, posb, col); else pool_rows<16>(PROJ, POOLED, tb, posb, col);
    }
}

__device__ __forceinline__ void scan_phase(Frame& F) {
    int tid = threadIdx.x; asm volatile("" : "+v"(tid)); const int lane = tid & 63, wave = __builtin_amdgcn_readfirstlane(tid >> 6); (void)lane; (void)wave;
    unsigned char* ws = F.ws;
    const float* DCT = (const float*)(ws + WS_DCT); const float* GTOT = (const float*)(ws + WS_GTOT); const float* DN = (const float*)(ws + WS_DN);
    bf16* BP = (bf16*)(ws + WS_BP); float* NVEC = (float*)(ws + WS_NVEC);
    for (int eg = F.bid * 512 + tid; eg < 8 * 16384; eg += F.G * 512) {
        const int bh = eg >> 14, rem = eg & 16383, e = rem >> 6, d4 = (rem & 63) * 4;
        f32x4 C = {0.f, 0.f, 0.f, 0.f};
        for (int c = 0; c < 16; ++c) { const int u = bh * 16 + c;
            v2u o; o.x = pk2(C.x, C.y); o.y = pk2(C.z, C.w);
            *(v2u*)(BP + ((size_t)u * 256 + e) * 512 + d4) = o;
            const f32x4 d = *(const f32x4*)(DCT + ((size_t)u * 256 + e) * 256 + d4);
            C = C * __expf(GTOT[u]) + d; }
    }
    for (int id = F.bid * 512 + tid; id < 2048; id += F.G * 512) {
        const int bh = id >> 8, d = id & 255; float n = 0.f;
        for (int c = 0; c < 16; ++c) { const int u = bh * 16 + c; NVEC[u * 256 + d] = n; n = n * __expf(GTOT[u]) + DN[u * 256 + d]; }
    }
}

typedef float f32x16 __attribute__((ext_vector_type(16)));
typedef short s16x8 __attribute__((ext_vector_type(8)));
typedef float f32x2_t __attribute__((ext_vector_type(2))); typedef __bf16 bf16x2_t __attribute__((ext_vector_type(2)));
__device__ __forceinline__ unsigned cvtpk_s(float lo, float hi) { f32x2_t v = {lo, hi}; bf16x2_t b = __builtin_convertvector(v, bf16x2_t); return __builtin_bit_cast(unsigned, b); }
__device__ __forceinline__ void attn_phase(Frame& F) {
    int tid = threadIdx.x; asm volatile("" : "+v"(tid)); const int lane = tid & 63, wave = __builtin_amdgcn_readfirstlane(tid >> 6);
    unsigned char* ws = F.ws;
    const bf16* QB = (const bf16*)(ws + WS_QB2); const bf16* KB = (const bf16*)(ws + WS_KB2); const bf16* VT = (const bf16*)(ws + WS_VT);
    bf16* ATTO = (bf16*)(ws + WS_ATTO);
    const int gw = F.bid * NWAVES + wave, NGW = F.G * NWAVES;
    const int r = lane & 31, hlf = lane >> 5;
    for (int p = gw; p < 4096; p += NGW) {
        const int qt = p & 127, hh = (p >> 7) & 15, b = p >> 11, t0 = qt * 32;
        const size_t hb = ((size_t)(b * 16 + hh) * 128) * 4096; const int lo16 = r * 16 + hlf * 8;
        const bf16* qrow = QB + hb + (size_t)qt * 4096 + lo16;
        s16x8 qf[8];
#pragma unroll
        for (int kk = 0; kk < 8; ++kk) qf[kk] = *(const s16x8*)(qrow + 512 * kk);
        f32x16 O[4];
#pragma unroll
        for (int et = 0; et < 4; ++et)
#pragma unroll
            for (int i = 0; i < 16; ++i) O[et][i] = 0.f;
        float R = 1.0f;
        s16x8 kf[8];
        { const bf16* krow = KB + hb + (size_t)qt * 4096 + lo16;
#pragma unroll
          for (int kk = 0; kk < 8; ++kk) kf[kk] = *(const s16x8*)(krow + 512 * kk); }
        for (int s0 = t0; ; s0 -= 32) {
            s16x8 vf[8];
            { const bf16* vp = VT + hb + (size_t)(s0 >> 5) * 4096 + lo16;
#pragma unroll
              for (int q = 0; q < 8; ++q) vf[q] = *(const s16x8*)(vp + 512 * q); }
            __builtin_amdgcn_sched_barrier(0);
            f32x16 zt;
#pragma unroll
            for (int i = 0; i < 16; ++i) zt[i] = 0.f;
#pragma unroll
            for (int kk = 0; kk < 8; ++kk) zt = __builtin_amdgcn_mfma_f32_32x32x16_bf16(kf[kk], qf[kk], zt, 0, 0, 0);
            __builtin_amdgcn_sched_barrier(0);
            { const int sn = (s0 >= 32) ? s0 - 32 : s0;
              const bf16* krow = KB + hb + (size_t)(sn >> 5) * 4096 + lo16;
#pragma unroll
              for (int kk = 0; kk < 8; ++kk) kf[kk] = *(const s16x8*)(krow + 512 * kk); }
            __builtin_amdgcn_sched_barrier(0);
            const bool diag = (s0 == t0);
            float sg[16], om[16];
            if (diag) {
#pragma unroll
                for (int i = 0; i < 16; ++i) { const int sl = (i & 3) + 8 * (i >> 2) + 4 * hlf;
                    const float s = __builtin_amdgcn_rcpf(1.0f + __builtin_amdgcn_exp2f(-zt[i]));
                    const bool valid = sl < r;
                    sg[i] = valid ? s : 0.f; om[i] = valid ? 1.0f - s : 1.0f; }
            } else {
#pragma unroll
                for (int i = 0; i < 16; ++i) { const float s = __builtin_amdgcn_rcpf(1.0f + __builtin_amdgcn_exp2f(-zt[i])); sg[i] = s; om[i] = 1.0f - s; }
            }
            float Sg[4], Pg[4], tot[4];
#pragma unroll
            for (int g = 0; g < 4; ++g) { Sg[g] = (om[4 * g] * om[4 * g + 1]) * (om[4 * g + 2] * om[4 * g + 3]); Pg[g] = __shfl_xor(Sg[g], 32); tot[g] = Sg[g] * Pg[g]; }
            float after[4]; after[3] = 1.0f; after[2] = tot[3]; after[1] = tot[3] * tot[2]; after[0] = (tot[3] * tot[2]) * tot[1];
            const float T = ((tot[3] * tot[2]) * tot[1]) * tot[0];
            float A[16];
#pragma unroll
            for (int g = 0; g < 4; ++g) { float run = R * after[g] * (hlf == 0 ? Pg[g] : 1.0f);
#pragma unroll
                for (int w = 3; w >= 0; --w) { const int i = 4 * g + w; A[i] = sg[i] * run; run *= om[i]; } }
            R *= T;
#pragma unroll
            for (int sp = 0; sp < 2; ++sp) {
                v4u xa; xa.x = cvtpk_s(A[8 * sp], A[8 * sp + 1]); xa.y = cvtpk_s(A[8 * sp + 2], A[8 * sp + 3]); xa.z = cvtpk_s(A[8 * sp + 4], A[8 * sp + 5]); xa.w = cvtpk_s(A[8 * sp + 6], A[8 * sp + 7]);
                const s16x8 xf = __builtin_bit_cast(s16x8, xa);
#pragma unroll
                for (int et = 0; et < 4; ++et) {
                    O[et] = __builtin_amdgcn_mfma_f32_32x32x16_bf16(xf, vf[sp * 4 + et], O[et], 0, 0, 0);
                }
            }
            if (s0 == 0 || __all(R == 0.f)) break;
        }
        { LAS unsigned char* ot = F.lds + wave * 8704;
#pragma unroll
          for (int et = 0; et < 4; ++et)
#pragma unroll
              for (int i = 0; i < 16; ++i) { const int tr = (i & 3) + 8 * (i >> 2) + 4 * hlf;
                  *(LAS bf16*)(ot + tr * 272 + (32 * et + r) * 2) = (bf16)(cvtpk_s(O[et][i], 0.f) & 0xffffu); }
          LDS_WAIT();
#pragma unroll
          for (int q = 0; q < 8; ++q) { const int tr = 4 * q + (lane >> 4), ch = lane & 15;
              const v4u o = *(const LAS v4u*)(ot + tr * 272 + 16 * ch);
              *(v4u*)(ATTO + (size_t)(b * SEQ + t0 + tr) * DM + hh * 128 + 8 * ch) = o; }
          LDS_WAIT(); }
    }
}

__device__ __forceinline__ void moe_bases(const gu32* cnt, int (&base)[8], int (&cn)[8]) {
    int acc = 0;
#pragma unroll
    for (int e = 0; e < 8; ++e) { cn[e] = (int)__hip_atomic_load(cnt + 64 * e, RLX_AGENT); base[e] = acc; acc += (cn[e] + 255) & ~255; }
}
__device__ __forceinline__ void gather_phase(Frame& F) {
    int tid = threadIdx.x; asm volatile("" : "+v"(tid)); const int lane = tid & 63, wave = __builtin_amdgcn_readfirstlane(tid >> 6);
    unsigned char* ws = F.ws;
    const unsigned* TOKINFO = (const unsigned*)(ws + WS_TOKINFO); int* TOKSLOT = (int*)(ws + WS_TOKSLOT); float* SLOTGATE = (float*)(ws + WS_SLOTGATE);
    const bf16* HN = (const bf16*)(ws + WS_HN); unsigned char* HPERM = ws + WS_HPERM;
    int base[8], cn[8]; moe_bases(F.ctl + CW_CNT, base, cn);
    const int gw = F.bid * NWAVES + wave, NGW = F.G * NWAVES;
    for (int p0 = gw * 4; p0 < NTOK; p0 += NGW * 4) {
        v4u w0[4], w1[4];
#pragma unroll
        for (int i = 0; i < 4; ++i) { w0[i] = *(const v4u*)(TOKINFO + (size_t)(p0 + i) * 8); w1[i] = *(const v4u*)(TOKINFO + (size_t)(p0 + i) * 8 + 4); }
        v4u v[4][4];
#pragma unroll
        for (int i = 0; i < 4; ++i) { const v4u* src = (const v4u*)(HN + (size_t)(p0 + i) * DM);
#pragma unroll
            for (int j = 0; j < 4; ++j) v[i][j] = src[lane + 64 * j]; }
#pragma unroll
        for (int i = 0; i < 4; ++i) {
            int b0 = 0, b1 = 0;
#pragma unroll
            for (int e = 0; e < 8; ++e) { b0 = ((int)w0[i].x == e) ? base[e] : b0; b1 = ((int)w0[i].y == e) ? base[e] : b1; }
            const int s0 = b0 + (int)w0[i].z, s1 = b1 + (int)w0[i].w;
            v2u* d0 = (v2u*)(HPERM + (size_t)s0 * DM); v2u* d1 = (v2u*)(HPERM + (size_t)s1 * DM);
#pragma unroll
            for (int j = 0; j < 4; ++j) { const v4u x = v[i][j];
                v2u o; o.x = pg8::pk4_fp8(bflo(x.x), bfhi(x.x), bflo(x.y), bfhi(x.y)); o.y = pg8::pk4_fp8(bflo(x.z), bfhi(x.z), bflo(x.w), bfhi(x.w));
                d0[lane + 64 * j] = o; d1[lane + 64 * j] = o; }
            if (lane == 0) { TOKSLOT[(p0 + i) * 2] = s0; TOKSLOT[(p0 + i) * 2 + 1] = s1; SLOTGATE[s0] = __uint_as_float(w1[i].x); SLOTGATE[s1] = __uint_as_float(w1[i].y); }
        }
    }
    for (int q = gw; q < 2048; q += NGW) {
        const int e = q >> 8, r = q & 255;
        int be = 0, ce = 0;
#pragma unroll
        for (int k = 0; k < 8; ++k) { be = (e == k) ? base[k] : be; ce = (e == k) ? cn[k] : ce; }
        if ((ce & 255) != 0 && r >= (ce & 255)) { const int row = be + (ce & ~255) + r; v4u* d = (v4u*)(HPERM + (size_t)row * DM); const v4u z = {0u, 0u, 0u, 0u};
#pragma unroll
            for (int j = 0; j < 2; ++j) d[lane + 64 * j] = z;
            if (lane == 0) SLOTGATE[row] = 0.f; }
    }
}

__device__ __forceinline__ void route_phase(Frame& F, const bf16* xin, const float* gain, const float* modl, int sh_off, int sc_off, const float* tab, gu32* cnt, gu32* donec) {
    int tid = threadIdx.x; asm volatile("" : "+v"(tid)); const int lane = tid & 63, wave = __builtin_amdgcn_readfirstlane(tid >> 6);
    unsigned char* ws = F.ws;
    int* TOKSLOT = (int*)(ws + WS_TOKSLOT); float* SLOTGATE = (float*)(ws + WS_SLOTGATE); unsigned char* HPERM = ws + WS_HPERM;
    LAS float* sT = (LAS float*)(F.lds);
    LAS unsigned* lcnt = (LAS unsigned*)(F.lds + 65536 + 16384);
    for (int i = tid; i < 16384; i += 512) sT[i] = tab[i];
    if (tid < 16) lcnt[tid] = 0u;
    __syncthreads();
    const int gw = F.bid * NWAVES + wave, NGW = F.G * NWAVES, t0 = gw * 4;
    unsigned rowq[4][8]; int e0[4], e1[4]; unsigned p0[4], p1[4]; float g0[4], g1[4];
    if (t0 < NTOK) {
        const int b = t0 >> 12;
        f32x4 ga[8], sb[8];
#pragma unroll
        for (int j = 0; j < 8; ++j) { const int col = 4 * (lane + 64 * j);
            const f32x4 g = *(const f32x4*)(gain + col), sc = *(const f32x4*)(modl + (size_t)b * 12288 + sc_off + col);
            ga[j] = g * (sc + 1.0f); sb[j] = *(const f32x4*)(modl + (size_t)b * 12288 + sh_off + col); }
#pragma unroll
        for (int i = 0; i < 4; ++i) {
            const int t = t0 + i;
            f32x4 v[8]; float ss = 0.f;
#pragma unroll
            for (int j = 0; j < 8; ++j) { const v2u w = *(const v2u*)(xin + (size_t)t * DM + 4 * (lane + 64 * j)); v[j] = (f32x4){bflo(w.x), bfhi(w.x), bflo(w.y), bfhi(w.y)}; ss += dot4(v[j], v[j]); }
            ss = wave_sum(ss);
            const float r = 1.0f / sqrtf(ss * (1.0f / DM) + EPS);
#pragma unroll
            for (int j = 0; j < 8; ++j) { v[j] = v[j] * r * ga[j] + sb[j]; rowq[i][j] = pg8::pk4_fp8(v[j].x, v[j].y, v[j].z, v[j].w); }
            float a8[8]; int zi; asm volatile("v_mov_b32 %0, 0" : "=v"(zi));
#pragma unroll
            for (int g = 0; g < 8; ++g) { float s = 0.f;
#pragma unroll
                for (int j = 0; j < 8; ++j) { const f32x4 tv = *(const LAS f32x4*)(sT + g * 2048 + 4 * (lane + 64 * j) + zi); s += dot4(v[j], tv); }
                a8[g] = wave_sum(s); }
            int ea = 0; float va = a8[0];
#pragma unroll
            for (int g = 1; g < 8; ++g) if (a8[g] > va) { va = a8[g]; ea = g; }
            int eb = -1; float vb = -3.0e38f;
#pragma unroll
            for (int g = 0; g < 8; ++g) if (g != ea && a8[g] > vb) { vb = a8[g]; eb = g; }
            ea = __builtin_amdgcn_readfirstlane(ea); eb = __builtin_amdgcn_readfirstlane(eb);
            const float ex = expf(vb - va); g0[i] = 1.0f / (1.0f + ex); g1[i] = ex / (1.0f + ex);
            unsigned pa = 0u, pb = 0u;
            if (lane == 0) { pa = __hip_atomic_fetch_add((LAS unsigned*)(lcnt + ea), 1u, __ATOMIC_RELAXED, __HIP_MEMORY_SCOPE_WORKGROUP); pb = __hip_atomic_fetch_add((LAS unsigned*)(lcnt + eb), 1u, __ATOMIC_RELAXED, __HIP_MEMORY_SCOPE_WORKGROUP); }
            e0[i] = ea; e1[i] = eb; p0[i] = (unsigned)__builtin_amdgcn_readfirstlane((int)pa); p1[i] = (unsigned)__builtin_amdgcn_readfirstlane((int)pb);
        }
    }
    asm volatile("s_waitcnt vmcnt(0) lgkmcnt(0)" ::: "memory");
    __syncthreads();
    if (tid < 8) { const unsigned n = lcnt[tid]; lcnt[8 + tid] = n ? __hip_atomic_fetch_add(cnt + 64 * tid, n, RLX_AGENT) : 0u; }
    asm volatile("s_waitcnt vmcnt(0) lgkmcnt(0)" ::: "memory");
    __syncthreads();
    if (tid == 0) { __hip_atomic_fetch_add(donec, 1u, RLX_AGENT);
        unsigned sp = 0; while (__hip_atomic_load(donec, RLX_AGENT) < (unsigned)F.G) { __builtin_amdgcn_s_sleep(1); if (++sp > (1u << 22)) break; } }
    __syncthreads();
    int base[8], cn[8]; moe_bases(cnt, base, cn);
    LAS unsigned char* stg = F.lds + 65536 + wave * 2048;
    if (t0 < NTOK) {
#pragma unroll
        for (int i = 0; i < 4; ++i) {
            int b0 = 0, b1 = 0;
#pragma unroll
            for (int e = 0; e < 8; ++e) { b0 = (e0[i] == e) ? base[e] : b0; b1 = (e1[i] == e) ? base[e] : b1; }
            const int s0 = b0 + (int)(lcnt[8 + e0[i]] + p0[i]), s1 = b1 + (int)(lcnt[8 + e1[i]] + p1[i]);
#pragma unroll
            for (int j = 0; j < 8; ++j) *(LAS unsigned*)(stg + 4 * (lane + 64 * j)) = rowq[i][j];
            LDS_WAIT();
            const v4u o0 = *(const LAS v4u*)(stg + 32 * lane), o1 = *(const LAS v4u*)(stg + 32 * lane + 16);
            LDS_WAIT();
            v4u* d0 = (v4u*)(HPERM + (size_t)s0 * DM + 32 * lane); v4u* d1 = (v4u*)(HPERM + (size_t)s1 * DM + 32 * lane);
            d0[0] = o0; d0[1] = o1; d1[0] = o0; d1[1] = o1;
            if (lane == 0) { TOKSLOT[(t0 + i) * 2] = s0; TOKSLOT[(t0 + i) * 2 + 1] = s1; SLOTGATE[s0] = g0[i]; SLOTGATE[s1] = g1[i]; }
        }
    }
    for (int q = gw; q < 2048; q += NGW) {
        const int e = q >> 8, r = q & 255;
        int be = 0, ce = 0;
#pragma unroll
        for (int k = 0; k < 8; ++k) { be = (e == k) ? base[k] : be; ce = (e == k) ? cn[k] : ce; }
        if ((ce & 255) != 0 && r >= (ce & 255)) { const int row = be + (ce & ~255) + r; v4u* d = (v4u*)(HPERM + (size_t)row * DM); const v4u z = {0u, 0u, 0u, 0u};
#pragma unroll
            for (int j = 0; j < 2; ++j) d[lane + 64 * j] = z;
            if (lane == 0) SLOTGATE[row] = 0.f; }
    }
    __syncthreads();
}

__device__ __forceinline__ void final_phase(Frame& F, const Args& args) {
    int tid = threadIdx.x; asm volatile("" : "+v"(tid)); const int lane = tid & 63, wave = __builtin_amdgcn_readfirstlane(tid >> 6); (void)lane; (void)wave;
    unsigned char* ws = F.ws;
    const bf16* XR = (const bf16*)(ws + WS_XR); const bf16* Y = (const bf16*)(ws + WS_Y); const bf16* YP = (const bf16*)(ws + WS_YP); const int* TOKSLOT = (const int*)(ws + WS_TOKSLOT);
    const float* g2 = (const float*)(ws + WS_MOD) + (size_t)2 * 12288 + 10240; const float* gfin = args.in[6]; float* out = args.out;
    const int gw = F.bid * NWAVES + wave, NGW = F.G * NWAVES;
    for (int t = gw; t < NTOK; t += NGW) {
        const int b = t >> 12, s0 = __builtin_amdgcn_readfirstlane(TOKSLOT[t * 2]), s1 = __builtin_amdgcn_readfirstlane(TOKSLOT[t * 2 + 1]);
        f32x4 v[8]; float ss = 0.f;
        if (s0 < 16384 && s1 < 16384) {
            v2u xw[8], y0[8], y1[8]; f32x4 g[8];
#pragma unroll
            for (int j = 0; j < 8; ++j) { const int col = 4 * (lane + 64 * j);
                xw[j] = *(const v2u*)(XR + (size_t)t * DM + col); g[j] = *(const f32x4*)(g2 + (size_t)b * 12288 + col);
                y0[j] = *(const v2u*)(Y + (size_t)s0 * DM + col); y1[j] = *(const v2u*)(Y + (size_t)s1 * DM + col); }
#pragma unroll
            for (int j = 0; j < 8; ++j) { const f32x4 x = {bflo(xw[j].x), bfhi(xw[j].x), bflo(xw[j].y), bfhi(xw[j].y)};
                f32x4 ys = {0.f, 0.f, 0.f, 0.f};
                ys.x += bflo(y0[j].x); ys.y += bfhi(y0[j].x); ys.z += bflo(y0[j].y); ys.w += bfhi(y0[j].y);
                ys.x += bflo(y1[j].x); ys.y += bfhi(y1[j].x); ys.z += bflo(y1[j].y); ys.w += bfhi(y1[j].y);
                v[j] = x + g[j] * ys; ss += dot4(v[j], v[j]); }
        } else {
            const bf16* r0[4]; const bf16* r1[4]; float w0[4], w1[4];
#pragma unroll
            for (int q = 0; q < 4; ++q) {
                r0[q] = (s0 < 16384) ? Y + (size_t)s0 * DM : YP + ((size_t)q * 1792 + (s0 - 16384)) * DM; w0[q] = (s0 < 16384 && q > 0) ? 0.f : 1.f;
                r1[q] = (s1 < 16384) ? Y + (size_t)s1 * DM : YP + ((size_t)q * 1792 + (s1 - 16384)) * DM; w1[q] = (s1 < 16384 && q > 0) ? 0.f : 1.f; }
#pragma unroll
            for (int jh = 0; jh < 8; jh += 4) {
                v2u xw[4], ya[4][4], yb[4][4]; f32x4 g[4];
#pragma unroll
                for (int jj = 0; jj < 4; ++jj) { const int col = 4 * (lane + 64 * (jh + jj));
                    xw[jj] = *(const v2u*)(XR + (size_t)t * DM + col); g[jj] = *(const f32x4*)(g2 + (size_t)b * 12288 + col);
#pragma unroll
                    for (int q = 0; q < 4; ++q) { ya[jj][q] = *(const v2u*)(r0[q] + col); yb[jj][q] = *(const v2u*)(r1[q] + col); } }
#pragma unroll
                for (int jj = 0; jj < 4; ++jj) { const f32x4 x = {bflo(xw[jj].x), bfhi(xw[jj].x), bflo(xw[jj].y), bfhi(xw[jj].y)};
                    f32x4 ys = {0.f, 0.f, 0.f, 0.f};
#pragma unroll
                    for (int q = 0; q < 4; ++q) {
                        ys.x += w0[q] * bflo(ya[jj][q].x) + w1[q] * bflo(yb[jj][q].x); ys.y += w0[q] * bfhi(ya[jj][q].x) + w1[q] * bfhi(yb[jj][q].x);
                        ys.z += w0[q] * bflo(ya[jj][q].y) + w1[q] * bflo(yb[jj][q].y); ys.w += w0[q] * bfhi(ya[jj][q].y) + w1[q] * bfhi(yb[jj][q].y); }
                    v[jh + jj] = x + g[jj] * ys; ss += dot4(v[jh + jj], v[jh + jj]); }
            }
        }
        ss = wave_sum(ss);
        const float r = 1.0f / sqrtf(ss * (1.0f / DM) + EPS);
#pragma unroll
        for (int j = 0; j < 8; ++j) { const int col = 4 * (lane + 64 * j); const f32x4 g = *(const f32x4*)(gfin + col); *(f32x4*)(out + (size_t)t * DM + col) = v[j] * r * g; }
    }
}

__global__ void __launch_bounds__(NWAVES * 64, 2) hybrid_fwd(Args args) {
    extern __shared__ __attribute__((aligned(16))) unsigned char lds[];
    Frame F;
    F.lds = (LAS unsigned char*)lds;
    F.MISC = (volatile LAS unsigned*)(F.lds + MISC_OFF);
    F.G = gridDim.x; F.bid = blockIdx.x;
    unsigned char* ws = args.ws; F.ws = ws;
    F.ctl = (gu32*)(ws + WS_CTL);
    for (int u = threadIdx.x; u < (LDS_BYTES - LDSCTL_OFF) / 4; u += NWAVES * 64) ((LAS unsigned*)(F.lds + LDSCTL_OFF))[u] = 0u;
    __syncthreads();
    XcdBarrier bar = xcd_barrier_post((unsigned*)(F.ctl + CW_BAR), F.MISC + 8);
#define GRID_BAR() xcd_barrier(bar)
    using namespace pg8;
    PG8_LAS unsigned char* ring = F.lds + RING_OFF;
    const float* MOD = (const float*)(ws + WS_MOD);
    bf16* HN = (bf16*)(ws + WS_HN); bf16* XR = (bf16*)(ws + WS_XR);

#if SKELETON
    for (int k = 0; k < 20; ++k) GRID_BAR();
    for (size_t i = (size_t)F.bid * 512 + threadIdx.x; i < (size_t)NTOK * DM / 4; i += (size_t)F.G * 512) ((f32x4*)args.out)[i] = ((const f32x4*)args.in[0])[i];
#else
    p0_prologue(F, args);
    GRID_BAR();
    norm_phase<0, false>(F, args.in[0], args.in[4], MOD, 0, 2048, HN, (const float*)(ws + WS_GWT), args.in[8], (float*)(ws + WS_GATES), nullptr, nullptr);
    GRID_BAR();
    { Dims g{DM, DM, DM}; DenseOrder S; S.init(NTOK, DINP, F.G, F.bid, HN, ws + WS_WIN, DM, DM); EpiBf16 E{(bf16*)(ws + WS_PROJ), DINP};
      gemm_phase<EpiBf16, DenseOrder, true, true>(ring, g, S, E);
      if (TAILQ2 > 0 && F.G == 256 && (long)((S.nwg + F.G - 1) / F.G - 1) * F.G + F.bid >= S.nwg) { const int k = F.bid - (S.nwg % F.G); convert_tiles(F, args, k, 128 * TAILQ2, 128); } }
    GRID_BAR();
    prep_phase(F, args);
    GRID_BAR();
    { const int hg = F.G / 2, lo = (F.bid < hg) ? F.bid : -1, hi = (F.bid >= hg) ? F.bid - hg : -1;
      { Dims g{256, 256, 256}; BatchOrder S{NUNIT, hg, lo, (const char*)(ws + WS_QB), (const char*)(ws + WS_KB), (size_t)256 * 256 * 2, (size_t)256 * 256 * 2};
        EpiW E{(bf16*)(ws + WS_AP), (const float*)(ws + WS_BCUM), (const float*)(ws + WS_IG)};
        gemm_phase<EpiW, BatchOrder, true, true>(ring, g, S, E); }
      { Dims g{512, 256, 256}; BatchOrder S{NUNIT, F.G - hg, hi, (const char*)(ws + WS_BP) + 512, (const char*)(ws + WS_KWT), (size_t)256 * 512 * 2, (size_t)256 * 256 * 2};
        EpiDC E{(float*)(ws + WS_DCT)};
        gemm_phase<EpiDC, BatchOrder, true, true>(ring, g, S, E);
        if (TAILQ4 > 0 && F.G == 256 && hi >= 0) convert_tiles(F, args, 128 * (TAILQ2 + TAILQ10 + TAILQ6) + hi, 128 * (TAILQ2 + TAILQ10 + TAILQ6 + TAILQ4), 128); }
      { Dims g{1024, 256, 256}; PoolOrder S{hg, lo, (const char*)(ws + WS_POOLED), (const char*)(ws + WS_POOLW)};
        EpiPool E{(bf16*)(ws + WS_MIXCAT), args.in[13]};
        gemm_phase<EpiPool, PoolOrder, true, true>(ring, g, S, E); } }
    GRID_BAR();
    scan_phase(F);
    GRID_BAR();
    { LAS float* sDen = (LAS float*)(F.lds + RING_OFF + RING_BYTES); LAS float* sSS = sDen + 256;
      if (F.bid < NUNIT) {
          int tid = threadIdx.x; asm volatile("" : "+v"(tid)); const int lane = tid & 63, wave = __builtin_amdgcn_readfirstlane(tid >> 6);
          const bf16* ap0 = (const bf16*)(ws + WS_AP) + (size_t)F.bid * 256 * 512; const f32x4 nv = *(const f32x4*)((const float*)(ws + WS_NVEC) + F.bid * 256 + 4 * lane);
#pragma nounroll
          for (int r0 = wave * 32; r0 < wave * 32 + 32; r0 += 8) {
              v2u qa[8], wa[8];
#pragma unroll
              for (int i = 0; i < 8; ++i) { const bf16* ap = ap0 + (size_t)(r0 + i) * 512; qa[i] = *(const v2u*)(ap + 4 * lane); wa[i] = *(const v2u*)(ap + 256 + 4 * lane); }
#pragma unroll
              for (int i = 0; i < 8; ++i) {
                  const float part = bflo(qa[i].x) * nv.x + bfhi(qa[i].x) * nv.y + bflo(qa[i].y) * nv.z + bfhi(qa[i].y) * nv.w + (bflo(wa[i].x) + bfhi(wa[i].x)) + (bflo(wa[i].y) + bfhi(wa[i].y));
                  const float den = wave_sum(part);
                  if (lane == 0) sDen[r0 + i] = 1.0f / fmaxf(fabsf(den), 1.0f); } }
      }
      Dims g{512, 512, 512}; BatchOrder S{NUNIT, F.G, F.bid, (const char*)(ws + WS_AP), (const char*)(ws + WS_BP), (size_t)256 * 512 * 2, (size_t)256 * 512 * 2};
      EpiFin E{(bf16*)(ws + WS_MIXCAT), (const bf16*)(ws + WS_PROJ), DINP, args.in[11], sDen, sSS, EPS};
      gemm_phase<EpiFin, BatchOrder, true, true>(ring, g, S, E);
      if (TAILQ6 > 0 && F.G == 256 && F.bid >= NUNIT) convert_tiles(F, args, 128 * (TAILQ2 + TAILQ10) + (F.bid - NUNIT), 128 * (TAILQ2 + TAILQ10 + TAILQ6), 128); }
    GRID_BAR();
    { Dims g{DM, DM, DM}; DenseOrder S; S.init(NTOK, DM, F.G, F.bid, ws + WS_MIXCAT, ws + WS_WOUT, DM, DM); EpiResid<false> E{args.in[0], XR, MOD + 4096, 1.0f};
      gemm_phase<EpiResid<false>, DenseOrder, true, true>(ring, g, S, E); }
    GRID_BAR();
    norm_phase<1, true, true>(F, XR, args.in[5], MOD, 6144, 8192, HN, nullptr, nullptr, nullptr, nullptr, nullptr);
    GRID_BAR();
    { Dims g{DM / 2, DM / 2, DM / 2}; DenseOrder S; S.init(NTOK, 2 * DFF, F.G, F.bid, HN, ws + WS_W13, DM / 2, DM / 2); EpiSwiglu8 E{ws + WS_U, DFF, 1 << 20, 1.0f / WS8};
      gemm_phase<EpiSwiglu8, DenseOrder, true, true, true>(ring, g, S, E);
      if (TAILQ10 > 0 && F.G == 256 && (long)((S.nwg + F.G - 1) / F.G - 1) * F.G + F.bid >= S.nwg) { const int k = F.bid - (S.nwg % F.G); convert_tiles(F, args, 128 * TAILQ2 + k, 128 * (TAILQ2 + TAILQ10), 128); } }
    GRID_BAR();
    { Dims g{DFF / 2, DFF / 2, DFF / 2}; DenseOrder S; S.init(NTOK, DM, F.G, F.bid, ws + WS_U, ws + WS_W2, DFF / 2, DFF / 2); EpiResid<true> E{XR, XR, MOD + 10240, 1.0f / WS8};
      gemm_phase<EpiResid<true>, DenseOrder, true, true, true>(ring, g, S, E); }
    GRID_BAR();
    const float* MOD1 = MOD + 2 * 12288;
    norm_phase<1, true>(F, XR, args.in[4] + DM, MOD1, 0, 2048, HN, nullptr, nullptr, nullptr, nullptr, nullptr);
    GRID_BAR();
    { Dims g{DM, DM, DM}; DenseOrder S; S.init(NTOK, 2 * DM, F.G, F.bid, HN, ws + WS_WQKV, DM, DM); EpiQKblk E{(bf16*)(ws + WS_QB2), (bf16*)(ws + WS_KB2), 0.08838834764831845f * 1.4426950408889634f};
      gemm_phase<EpiQKblk, DenseOrder, true, true>(ring, g, S, E); }
    { Dims g{DM, DM, DM}; DenseOrder S; S.init(DM, NTOK, F.G, F.bid, ws + WS_WQKV + (size_t)2 * DM * DM * 2, HN, DM, DM); EpiVblk E{(bf16*)(ws + WS_VT)};
      gemm_phase<EpiVblk, DenseOrder, true, true>(ring, g, S, E); }
    GRID_BAR();
    attn_phase(F);
    GRID_BAR();
    { Dims g{DM, DM, DM}; DenseOrder S; S.init(NTOK, DM, F.G, F.bid, ws + WS_ATTO, ws + WS_WO, DM, DM); EpiResid<true> E{XR, XR, MOD1 + 4096, 1.0f};
      gemm_phase<EpiResid<true>, DenseOrder, true, true>(ring, g, S, E); }
    GRID_BAR();
    if (F.G * NWAVES * 4 >= NTOK) {
        route_phase(F, XR, args.in[5] + DM, MOD1, 6144, 8192, (const float*)(ws + WS_RWT), F.ctl + CW_CNT, F.ctl + CW_RDONE);
    } else {
        norm_phase<2, true>(F, XR, args.in[5] + DM, MOD1, 6144, 8192, HN, (const float*)(ws + WS_RWT), nullptr, nullptr, (unsigned*)(ws + WS_TOKINFO), F.ctl + CW_CNT);
        GRID_BAR();
        gather_phase(F);
    }
    GRID_BAR();
    { int base[8], cn[8]; moe_bases(F.ctl + CW_CNT, base, cn);
      MoeOrder S; S.G = F.G; S.c = F.bid;
#pragma unroll
      for (int e = 0; e < 8; ++e) S.cumP[e] = base[e] >> 8;
      S.cumP[8] = (base[7] + ((cn[7] + 255) & ~255)) >> 8;
      { S.nNl = 56; S.A = (const char*)(ws + WS_HPERM); S.Bt = (const char*)(ws + WS_W13E); S.tsa = (size_t)256 * DM; S.tsb = (size_t)256 * DM;
        Dims g{DM / 2, DM / 2, DM / 2}; EpiSwiglu8 E{ws + WS_UE, DFE, 56, 1.0f / WS8};
        gemm_phase<EpiSwiglu8, MoeOrder, true, true, true>(ring, g, S, E); }
      convert_tiles<true>(F, args, QCVT_LO, QCVT_LO + QCVT_N, 0, F.ctl + CW_QCVT);
      GRID_BAR();
      { const int Ptot = S.cumP[8];
        SplitOrder T; T.G = F.G; T.c = F.bid; T.A = (const char*)(ws + WS_UE); T.Bt = (const char*)(ws + WS_W2E); T.tsa = (size_t)256 * DFE; T.tsb = (size_t)256 * DFE; T.kq_bytes = DFE / 4;
#pragma unroll
        for (int e = 0; e < 9; ++e) { T.cumP[e] = S.cumP[e]; S.cumP[e] = S.cumP[e] < 64 ? S.cumP[e] : 64; }
        (void)Ptot;
        S.nNl = 8; S.A = (const char*)(ws + WS_UE); S.Bt = (const char*)(ws + WS_W2E); S.tsa = (size_t)256 * DFE; S.tsb = (size_t)256 * DFE;
        { Dims g{DFE / 2, DFE / 2, DFE / 2}; EpiY E{(bf16*)(ws + WS_Y), (const float*)(ws + WS_SLOTGATE), 1.0f / WS8};
          gemm_phase<EpiY, MoeOrder, true, true, true>(ring, g, S, E); }
        { Dims g{DFE / 2, DFE / 2, DFE / 8}; EpiYp E{(bf16*)(ws + WS_YP), (const float*)(ws + WS_SLOTGATE), 1.0f / WS8};
          gemm_phase<EpiYp, SplitOrder, true, true, true>(ring, g, T, E); } }
    }
    GRID_BAR();
    final_phase(F, args);
#endif
}

extern "C" void kernel_launch(void* const* d_in, const int* in_sizes, int n_in, void* d_out, int out_size, void* d_ws, size_t ws_size, hipStream_t stream) {
    static int grid = 0;
    if (grid == 0) {
        if (n_in != 24 || out_size != NTOK * DM || ws_size < WS_END) { fprintf(stderr, "kernel_launch: unexpected shapes (n_in %d, out %d, ws %zu < %zu); nothing launched\n", n_in, out_size, ws_size, (size_t)WS_END); grid = -1; return; }
        int dev = 0, cus = 0, per_cu = 0;
        if (hipGetDevice(&dev) != hipSuccess || hipDeviceGetAttribute(&cus, hipDeviceAttributeMultiprocessorCount, dev) != hipSuccess) { grid = -1; return; }
        if (hipFuncSetAttribute((const void*)hybrid_fwd, hipFuncAttributeMaxDynamicSharedMemorySize, LDS_BYTES) != hipSuccess) { fprintf(stderr, "kernel_launch: hipFuncSetAttribute failed\n"); grid = -1; return; }
        if (hipOccupancyMaxActiveBlocksPerMultiprocessor(&per_cu, (const void*)hybrid_fwd, NWAVES * 64, LDS_BYTES) != hipSuccess || per_cu < 1)
            fprintf(stderr, "kernel_launch: note: occupancy query reports %d workgroups per CU\n", per_cu);
        (void)hipGetLastError();
        grid = cus;
    }
    if (grid < 0) return;
    if (hipMemsetAsync((char*)d_ws + WS_CTL, 0, CTL_ZERO_BYTES, stream) != hipSuccess) return;
    Args a{};
    for (int i = 0; i < 24; ++i) a.in[i] = (const float*)d_in[i];
    a.out = (float*)d_out; a.ws = (unsigned char*)d_ws;
    hipLaunchKernelGGL(hybrid_fwd, dim3(grid), dim3(NWAVES * 64), LDS_BYTES, stream, a);
    const hipError_t le = hipPeekAtLastError();
    if (le != hipSuccess) fprintf(stderr, "kernel_launch: launch failed: %s\n", hipGetErrorName(le));
}
```

```cpp
#include <hip/hip_runtime.h>
#include <cstdio>
#include <cstdint>

#ifndef SKELETON
#define SKELETON 0
#endif

namespace pg8 {
#define PG8_LAS __attribute__((address_space(3)))
typedef unsigned short bf16_t;
typedef short bf16x8 __attribute__((ext_vector_type(8)));
typedef float f32x4 __attribute__((ext_vector_type(4)));
typedef unsigned u32x4 __attribute__((ext_vector_type(4)));
constexpr int BM = 256, BK = 64, HALF = 128, HTB = HALF * BK * 2  , STAGE_BYTES = 8 * HTB, NXCD = 8, WGM = 4;

__host__ __device__ __forceinline__ int lds_byte(int r, int c) { const int st = (r >> 4) * 2 + (c >> 5), rr = r & 15, cc = c & 31, ob = rr * 64 + cc * 2; return st * 1024 + (ob ^ (((ob >> 9) & 1) << 5)); }
__host__ __device__ __forceinline__ void stage_rc(int b, int& R, int& C) { const int st = b / 1024, sb = b % 1024, swz = sb ^ (((sb >> 9) & 1) << 5); R = (st >> 1) * 16 + swz / 64; C = (st & 1) * 32 + (swz % 64) / 2; }
__host__ __device__ __forceinline__ int perm32(int rho) { const int n = rho >> 4, i = rho & 15; return 8 * (i >> 2) + 4 * n + (i & 3); }

struct Unit { int pm, pn; const char* a; const char* b; };
struct Dims { int lda, ldb, K; };

__device__ __forceinline__ unsigned cvt_pk_bf16(float lo, float hi) { unsigned r; asm volatile("v_cvt_pk_bf16_f32 %0, %1, %2" : "=v"(r) : "v"(lo), "v"(hi)); return r; }

__device__ __forceinline__ int xcd_remap(int wgid, int nwg) { const int q = nwg / NXCD, r = nwg % NXCD, xcd = wgid % NXCD, off = wgid / NXCD; return (xcd < r ? xcd * (q + 1) : r * (q + 1) + (xcd - r) * q) + off; }

struct DenseOrder {
    int nM, nN, nwg, G, c; const char* A; const char* Bt; size_t tsa, tsb;
    __device__ __forceinline__ void init(int M, int N, int G_, int c_, const void* A_, const void* Bt_, int lda, int ldb) { nM = M / BM; nN = N / BM; nwg = nM * nN; G = G_; c = c_; A = (const char*)A_; Bt = (const char*)Bt_; tsa = (size_t)BM * lda * 2; tsb = (size_t)BM * ldb * 2; }
    __device__ __forceinline__ bool next(int i, Unit& u) const {
        const long L = (long)i * G + c; if (L >= nwg) return false;
        const int wgid = xcd_remap((int)L, nwg);
        const int nig = WGM * nN, gid = wgid / nig, fm = gid * WGM, gsz = (nM - fm) < WGM ? (nM - fm) : WGM;
        u.pm = fm + ((wgid % nig) % gsz); u.pn = (wgid % nig) / gsz; u.a = A + (size_t)u.pm * tsa; u.b = Bt + (size_t)u.pn * tsb; return true;
    }
    __device__ __forceinline__ void a_ready(const Unit&) const {}
    __device__ __forceinline__ void done(const Unit&) const {}
};
struct BatchOrder {
    int n, G, c; const char* A; const char* Bt; size_t tsa, tsb;
    __device__ __forceinline__ bool next(int i, Unit& u) const { const long L = (long)i * G + c; if (c < 0 || L >= n) return false; u.pm = (int)L; u.pn = (int)L; u.a = A + (size_t)L * tsa; u.b = Bt + (size_t)L * tsb; return true; }
    __device__ __forceinline__ void a_ready(const Unit&) const {}
    __device__ __forceinline__ void done(const Unit&) const {}
};
struct PoolOrder {
    int G, c; const char* A; const char* Bt;
    __device__ __forceinline__ bool next(int i, Unit& u) const { const long L = (long)i * G + c; if (c < 0 || L >= 128) return false; u.pm = (int)L & 31; u.pn = (int)L >> 5; u.a = A + (size_t)u.pm * (256 * 1024 * 2) + (size_t)u.pn * 512; u.b = Bt + (size_t)u.pn * (256 * 256 * 2); return true; }
    __device__ __forceinline__ void a_ready(const Unit&) const {}
    __device__ __forceinline__ void done(const Unit&) const {}
};
struct MoeOrder {
    int G, c, nNl; int cumP[9]; const char* A; const char* Bt; size_t tsa, tsb;
    __device__ __forceinline__ bool next(int i, Unit& u) const {
        const int nwg = cumP[8] * nNl; const long L = (long)i * G + c; if (L >= nwg) return false;
        const int wgid = xcd_remap((int)L, nwg);
        int e = 0;
#pragma unroll
        for (int k = 1; k < 8; ++k) e += (wgid >= cumP[k] * nNl) ? 1 : 0;
        int p0 = cumP[0], p1 = cumP[1];
#pragma unroll
        for (int k = 1; k < 8; ++k) { p0 = (e == k) ? cumP[k] : p0; p1 = (e == k) ? cumP[k + 1] : p1; }
        const int local = wgid - p0 * nNl, Pe = p1 - p0;
        u.pm = p0 + local % Pe; u.pn = e * nNl + local / Pe; u.a = A + (size_t)u.pm * tsa; u.b = Bt + (size_t)u.pn * tsb; return true;
    }
    __device__ __forceinline__ void a_ready(const Unit&) const {}
    __device__ __forceinline__ void done(const Unit&) const {}
};

struct SplitOrder {
    int G, c; int cumP[9]; const char* A; const char* Bt; size_t tsa, tsb; int kq_bytes;
    __device__ __forceinline__ bool next(int i, Unit& u) const {
        const long L = (long)i * G + c; const int n = (cumP[8] - 64) * 32; if (L >= n) return false;
        const int p = 64 + (int)L / 32, rem = (int)L & 31, pnl = rem >> 2, kq = rem & 3;
        int e = 0;
#pragma unroll
        for (int k = 1; k < 8; ++k) e += (p >= cumP[k]) ? 1 : 0;
        u.pm = p; u.pn = pnl + 64 * kq; u.a = A + (size_t)p * tsa + (size_t)kq * kq_bytes; u.b = Bt + (size_t)(e * 8 + pnl) * tsb + (size_t)kq * kq_bytes; return true;
    }
    __device__ __forceinline__ void a_ready(const Unit&) const {}
    __device__ __forceinline__ void done(const Unit&) const {}
};

__device__ __forceinline__ float silu_f(float x) { return x * __builtin_amdgcn_rcpf(1.0f + __expf(-x)); }
typedef float f32x2p __attribute__((ext_vector_type(2)));
__device__ __forceinline__ f32x2p swiglu2(f32x2p a, f32x2p b, float c1, float c2) {
    const f32x2p z = a * c1; f32x2p t; t.x = __builtin_amdgcn_exp2f(z.x); t.y = __builtin_amdgcn_exp2f(z.y);
    const f32x2p d = t + 1.0f; f32x2p s; s.x = __builtin_amdgcn_rcpf(d.x); s.y = __builtin_amdgcn_rcpf(d.y);
    return (a * b) * (s * c2);
}
__device__ __forceinline__ f32x2p sigm2(unsigned w) {
    f32x2p x; x.x = __uint_as_float(w << 16); x.y = __uint_as_float(w & 0xffff0000u);
    const f32x2p z = x * -1.4426950408889634f; f32x2p t; t.x = __builtin_amdgcn_exp2f(z.x); t.y = __builtin_amdgcn_exp2f(z.y);
    const f32x2p d = t + 1.0f; f32x2p s; s.x = __builtin_amdgcn_rcpf(d.x); s.y = __builtin_amdgcn_rcpf(d.y); return s;
}

struct EpiBf16 {
    static constexpr bool PERM = true;
    bf16_t* O; int ldc;
    __device__ __forceinline__ void operator()(const f32x4 (&acc)[2][2][4][2], const Unit& u, int wr, int wc, int fr_, int fq_) const {
        int z_; asm volatile("v_mov_b32 %0, 0" : "=v"(z_)); const int fr = fr_ + z_, fq = fq_ + z_;
        const int row0 = u.pm * BM + wr * 64 + fr, col0 = u.pn * BM + wc * 32 + 8 * fq;
#pragma unroll
        for (int ai = 0; ai < 2; ++ai)
#pragma unroll
            for (int m = 0; m < 4; ++m) { bf16_t* rowp = O + (size_t)(row0 + ai * HALF + m * 16) * ldc + col0;
#pragma unroll
                for (int bj = 0; bj < 2; ++bj) { const f32x4 v0 = acc[ai][bj][m][0], v1 = acc[ai][bj][m][1];
                    u32x4 w; w.x = cvt_pk_bf16(v0[0], v0[1]); w.y = cvt_pk_bf16(v0[2], v0[3]); w.z = cvt_pk_bf16(v1[0], v1[1]); w.w = cvt_pk_bf16(v1[2], v1[3]);
                    *(u32x4*)(rowp + bj * HALF) = w; } }
    }
};
struct EpiQKblk {
    static constexpr bool PERM = true;
    bf16_t* Q; bf16_t* K; float qs;
    __device__ __forceinline__ void operator()(const f32x4 (&acc)[2][2][4][2], const Unit& u, int wr, int wc, int fr_, int fq_) const {
        int z_; asm volatile("v_mov_b32 %0, 0" : "=v"(z_)); const int fr = fr_ + z_, fq = fq_ + z_;
#pragma unroll
        for (int bj = 0; bj < 2; ++bj) { const int c0 = u.pn * BM + bj * HALF + wc * 32 + 8 * fq; bf16_t* base = (c0 >= 2048) ? K : Q; const float sc = (c0 >= 2048) ? 1.0f : qs;
            const int hh = (c0 & 2047) >> 7, d0 = c0 & 127; const size_t cofs = (size_t)hh * (128 * 4096) + (d0 >> 4) * 512 + ((d0 >> 3) & 1) * 8;
#pragma unroll
            for (int ai = 0; ai < 2; ++ai)
#pragma unroll
                for (int m = 0; m < 4; ++m) { const int t = u.pm * BM + ai * HALF + wr * 64 + m * 16 + fr, b = t >> 12, pos = t & 4095;
                    bf16_t* dst = base + (size_t)b * (16 * 128 * 4096) + cofs + (size_t)(pos >> 5) * 4096 + (pos & 31) * 16;
                    const f32x4 v0 = acc[ai][bj][m][0] * sc, v1 = acc[ai][bj][m][1] * sc;
                    u32x4 w; w.x = cvt_pk_bf16(v0[0], v0[1]); w.y = cvt_pk_bf16(v0[2], v0[3]); w.z = cvt_pk_bf16(v1[0], v1[1]); w.w = cvt_pk_bf16(v1[2], v1[3]);
                    *(u32x4*)dst = w; } }
    }
};
struct EpiVblk {
    static constexpr bool PERM = true;
    bf16_t* V;
    __device__ __forceinline__ void operator()(const f32x4 (&acc)[2][2][4][2], const Unit& u, int wr, int wc, int fr_, int fq_) const {
        int z_; asm volatile("v_mov_b32 %0, 0" : "=v"(z_)); const int fr = fr_ + z_, fq = fq_ + z_;
        typedef unsigned u32x2v __attribute__((ext_vector_type(2)));
#pragma unroll
        for (int bj = 0; bj < 2; ++bj) { const int tok0 = u.pn * BM + bj * HALF + wc * 32 + 8 * fq, b = tok0 >> 12, pos0 = tok0 & 4095, k0 = pos0 & 31;
            const size_t cofs = (size_t)b * (16 * 128 * 4096) + (size_t)(pos0 >> 5) * 4096 + (k0 >> 4) * 2048 + ((k0 >> 3) & 1) * 4;
#pragma unroll
            for (int ai = 0; ai < 2; ++ai)
#pragma unroll
                for (int m = 0; m < 4; ++m) { const int f = u.pm * BM + ai * HALF + wr * 64 + m * 16 + fr, hh = f >> 7, e = f & 127;
                    bf16_t* dst = V + cofs + (size_t)hh * (128 * 4096) + (e >> 5) * 512 + (e & 31) * 16;
                    const f32x4 v0 = acc[ai][bj][m][0], v1 = acc[ai][bj][m][1];
                    u32x2v w0, w1; w0.x = cvt_pk_bf16(v0[0], v0[1]); w0.y = cvt_pk_bf16(v0[2], v0[3]); w1.x = cvt_pk_bf16(v1[0], v1[1]); w1.y = cvt_pk_bf16(v1[2], v1[3]);
                    *(u32x2v*)dst = w0; *(u32x2v*)(dst + 8) = w1; } }
    }
};
template <bool BASE16> struct EpiResid {
    static constexpr bool PERM = true;
    const void* base; bf16_t* out; const float* gate; float gs;
    __device__ __forceinline__ void operator()(const f32x4 (&acc)[2][2][4][2], const Unit& u, int wr, int wc, int fr_, int fq_) const {
        int z_; asm volatile("v_mov_b32 %0, 0" : "=v"(z_)); const int fr = fr_ + z_, fq = fq_ + z_;
        const int row0 = u.pm * BM + wr * 64 + fr, col0 = u.pn * BM + wc * 32 + 8 * fq;
        const float* gp = gate + (size_t)((u.pm * BM) >> 12) * 12288 + col0;
        f32x4 gv[2][2];
#pragma unroll
        for (int bj = 0; bj < 2; ++bj)
#pragma unroll
            for (int n = 0; n < 2; ++n) gv[bj][n] = *(const f32x4*)(gp + bj * HALF + 4 * n) * gs;
#pragma unroll
        for (int ai = 0; ai < 2; ++ai)
#pragma unroll
            for (int m = 0; m < 4; ++m) { const size_t off = (size_t)(row0 + ai * HALF + m * 16) * 2048 + col0;
#pragma unroll
                for (int bj = 0; bj < 2; ++bj) { f32x4 b0, b1;
                    if (BASE16) { const u32x4 w = *(const u32x4*)((const bf16_t*)base + off + bj * HALF);
                        b0 = (f32x4){__uint_as_float(w.x << 16), __uint_as_float(w.x & 0xffff0000u), __uint_as_float(w.y << 16), __uint_as_float(w.y & 0xffff0000u)};
                        b1 = (f32x4){__uint_as_float(w.z << 16), __uint_as_float(w.z & 0xffff0000u), __uint_as_float(w.w << 16), __uint_as_float(w.w & 0xffff0000u)}; }
                    else { b0 = *(const f32x4*)((const float*)base + off + bj * HALF); b1 = *(const f32x4*)((const float*)base + off + bj * HALF + 4); }
                    const f32x4 v0 = b0 + gv[bj][0] * acc[ai][bj][m][0], v1 = b1 + gv[bj][1] * acc[ai][bj][m][1];
                    u32x4 o; o.x = cvt_pk_bf16(v0[0], v0[1]); o.y = cvt_pk_bf16(v0[2], v0[3]); o.z = cvt_pk_bf16(v1[0], v1[1]); o.w = cvt_pk_bf16(v1[2], v1[3]);
                    *(u32x4*)(out + off + bj * HALF) = o; }
                asm volatile("" ::: "memory"); }
    }
};
struct EpiSwiglu {
    static constexpr bool PERM = true;
    bf16_t* O; int ldo; int nNl;
    __device__ __forceinline__ void operator()(const f32x4 (&acc)[2][2][4][2], const Unit& u, int wr, int wc, int fr_, int fq_) const {
        int z_; asm volatile("v_mov_b32 %0, 0" : "=v"(z_)); const int fr = fr_ + z_, fq = fq_ + z_;
        const int row0 = u.pm * BM + wr * 64 + fr, col0 = (u.pn % nNl) * HALF + wc * 32 + 8 * fq;
#pragma unroll
        for (int ai = 0; ai < 2; ++ai)
#pragma unroll
            for (int m = 0; m < 4; ++m) { bf16_t* rowp = O + (size_t)(row0 + ai * HALF + m * 16) * ldo + col0;
                const f32x4 a0 = acc[ai][0][m][0], a1 = acc[ai][0][m][1], b0 = acc[ai][1][m][0], b1 = acc[ai][1][m][1];
                const f32x2p r0 = swiglu2((f32x2p){a0[0], a0[1]}, (f32x2p){b0[0], b0[1]}, -1.4426950408889634f, 1.0f), r1 = swiglu2((f32x2p){a0[2], a0[3]}, (f32x2p){b0[2], b0[3]}, -1.4426950408889634f, 1.0f);
                const f32x2p r2 = swiglu2((f32x2p){a1[0], a1[1]}, (f32x2p){b1[0], b1[1]}, -1.4426950408889634f, 1.0f), r3 = swiglu2((f32x2p){a1[2], a1[3]}, (f32x2p){b1[2], b1[3]}, -1.4426950408889634f, 1.0f);
                u32x4 w; w.x = cvt_pk_bf16(r0.x, r0.y); w.y = cvt_pk_bf16(r1.x, r1.y); w.z = cvt_pk_bf16(r2.x, r2.y); w.w = cvt_pk_bf16(r3.x, r3.y);
                *(u32x4*)rowp = w; }
    }
};
__device__ __forceinline__ unsigned pk4_fp8(float a, float b, float c, float d) { int w = 0; w = __builtin_amdgcn_cvt_pk_fp8_f32(a, b, w, false); w = __builtin_amdgcn_cvt_pk_fp8_f32(c, d, w, true); return (unsigned)w; }
struct EpiSwiglu8 {
    static constexpr bool PERM = true;
    unsigned char* O; int ldo; int nNl; float inv;
    __device__ __forceinline__ void operator()(const f32x4 (&acc)[2][2][4][2], const Unit& u, int wr, int wc, int fr, int fq) const {
        const int row0 = u.pm * BM + wr * 64 + fr, col0 = (u.pn % nNl) * HALF + wc * 32 + 8 * fq;
#pragma unroll
        for (int ai = 0; ai < 2; ++ai)
#pragma unroll
            for (int m = 0; m < 4; ++m) { unsigned char* rowp = O + (size_t)(row0 + ai * HALF + m * 16) * ldo + col0;
                const f32x4 a0 = acc[ai][0][m][0], a1 = acc[ai][0][m][1], b0 = acc[ai][1][m][0], b1 = acc[ai][1][m][1];
                const float c1 = -1.4426950408889634f * inv, c2 = inv * inv;
                const f32x2p r0 = swiglu2((f32x2p){a0[0], a0[1]}, (f32x2p){b0[0], b0[1]}, c1, c2), r1 = swiglu2((f32x2p){a0[2], a0[3]}, (f32x2p){b0[2], b0[3]}, c1, c2);
                const f32x2p r2 = swiglu2((f32x2p){a1[0], a1[1]}, (f32x2p){b1[0], b1[1]}, c1, c2), r3 = swiglu2((f32x2p){a1[2], a1[3]}, (f32x2p){b1[2], b1[3]}, c1, c2);
                typedef unsigned u32x2v __attribute__((ext_vector_type(2)));
                u32x2v w; w.x = pk4_fp8(r0.x, r0.y, r1.x, r1.y); w.y = pk4_fp8(r2.x, r2.y, r3.x, r3.y);
                *(u32x2v*)rowp = w; }
    }
};
struct EpiY {
    static constexpr bool PERM = true;
    bf16_t* Y; const float* sg; float inv;
    __device__ __forceinline__ void operator()(const f32x4 (&acc)[2][2][4][2], const Unit& u, int wr, int wc, int fr_, int fq_) const {
        int z_; asm volatile("v_mov_b32 %0, 0" : "=v"(z_)); const int fr = fr_ + z_, fq = fq_ + z_;
        const int row0 = u.pm * BM + wr * 64 + fr, col0 = (u.pn & 7) * BM + wc * 32 + 8 * fq;
#pragma unroll
        for (int ai = 0; ai < 2; ++ai)
#pragma unroll
            for (int m = 0; m < 4; ++m) { const int row = row0 + ai * HALF + m * 16; const float g = sg[row] * inv; bf16_t* rowp = Y + (size_t)row * 2048 + col0;
#pragma unroll
                for (int bj = 0; bj < 2; ++bj) { const f32x4 v0 = acc[ai][bj][m][0] * g, v1 = acc[ai][bj][m][1] * g;
                    u32x4 w; w.x = cvt_pk_bf16(v0[0], v0[1]); w.y = cvt_pk_bf16(v0[2], v0[3]); w.z = cvt_pk_bf16(v1[0], v1[1]); w.w = cvt_pk_bf16(v1[2], v1[3]);
                    *(u32x4*)(rowp + bj * HALF) = w; } }
    }
};
struct EpiYp {
    static constexpr bool PERM = true;
    bf16_t* YP; const float* sg; float inv;
    __device__ __forceinline__ void operator()(const f32x4 (&acc)[2][2][4][2], const Unit& u, int wr, int wc, int fr_, int fq_) const {
        int z_; asm volatile("v_mov_b32 %0, 0" : "=v"(z_)); const int fr = fr_ + z_, fq = fq_ + z_;
        const int row0 = u.pm * BM + wr * 64 + fr, col0 = (u.pn & 7) * BM + wc * 32 + 8 * fq; bf16_t* base = YP + (size_t)(u.pn >> 6) * (1792 * 2048);
#pragma unroll
        for (int ai = 0; ai < 2; ++ai)
#pragma unroll
            for (int m = 0; m < 4; ++m) { const int row = row0 + ai * HALF + m * 16; const float g = sg[row] * inv; bf16_t* rowp = base + (size_t)(row - 16384) * 2048 + col0;
#pragma unroll
                for (int bj = 0; bj < 2; ++bj) { const f32x4 v0 = acc[ai][bj][m][0] * g, v1 = acc[ai][bj][m][1] * g;
                    u32x4 w; w.x = cvt_pk_bf16(v0[0], v0[1]); w.y = cvt_pk_bf16(v0[2], v0[3]); w.z = cvt_pk_bf16(v1[0], v1[1]); w.w = cvt_pk_bf16(v1[2], v1[3]);
                    *(u32x4*)(rowp + bj * HALF) = w; } }
    }
};
struct EpiW {
    static constexpr bool PERM = true;
    bf16_t* AP; const float* bcum; const float* ig;
    __device__ __forceinline__ void operator()(const f32x4 (&acc)[2][2][4][2], const Unit& u, int wr, int wc, int fr_, int fq_) const {
        int z_; asm volatile("v_mov_b32 %0, 0" : "=v"(z_)); const int fr = fr_ + z_, fq = fq_ + z_;
        const float* bc = bcum + u.pm * 256; const float* ii = ig + u.pm * 256;
#pragma unroll
        for (int bj = 0; bj < 2; ++bj) { const int s0 = bj * HALF + wc * 32 + 8 * fq;
            const f32x4 b0 = *(const f32x4*)(bc + s0), b1 = *(const f32x4*)(bc + s0 + 4), i0 = *(const f32x4*)(ii + s0), i1 = *(const f32x4*)(ii + s0 + 4);
            const f32x4 c0 = i0 - b0, c1 = i1 - b1;
#pragma unroll
            for (int ai = 0; ai < 2; ++ai)
#pragma unroll
                for (int m = 0; m < 4; ++m) { const int t = ai * HALF + wr * 64 + m * 16 + fr; const float bt = bc[t]; bf16_t* rowp = AP + ((size_t)u.pm * 256 + t) * 512 + 256;
                    const f32x4 v0 = acc[ai][bj][m][0], v1 = acc[ai][bj][m][1]; float r[8];
                    const int dts = t - s0;
#pragma unroll
                    for (int j = 0; j < 4; ++j) { const float m0 = (float)min(max(dts - j + 1, 0), 1), m1 = (float)min(max(dts - j - 3, 0), 1);
                        r[j] = v0[j] * __expf(fminf(bt + c0[j], 80.f)) * m0; r[4 + j] = v1[j] * __expf(fminf(bt + c1[j], 80.f)) * m1; }
                    u32x4 w; w.x = cvt_pk_bf16(r[0], r[1]); w.y = cvt_pk_bf16(r[2], r[3]); w.z = cvt_pk_bf16(r[4], r[5]); w.w = cvt_pk_bf16(r[6], r[7]);
                    *(u32x4*)(rowp + s0) = w; asm volatile("" ::: "memory"); } }
    }
};
struct EpiDC {
    static constexpr bool PERM = false;
    float* D;
    __device__ __forceinline__ void operator()(const f32x4 (&acc)[2][2][4][2], const Unit& u, int wr, int wc, int fr_, int fq_) const {
        int z_; asm volatile("v_mov_b32 %0, 0" : "=v"(z_)); const int fr = fr_ + z_, fq = fq_ + z_;
        const int row0 = wr * 64 + fr, col0 = wc * 32 + 4 * fq;
#pragma unroll
        for (int ai = 0; ai < 2; ++ai)
#pragma unroll
            for (int m = 0; m < 4; ++m) { float* rowp = D + ((size_t)u.pm * 256 + row0 + ai * HALF + m * 16) * 256 + col0;
#pragma unroll
                for (int bj = 0; bj < 2; ++bj)
#pragma unroll
                    for (int n = 0; n < 2; ++n) *(f32x4*)(rowp + bj * HALF + n * 16) = acc[ai][bj][m][n]; }
    }
};
struct EpiNum {
    static constexpr bool PERM = false;
    float* HR;
    __device__ __forceinline__ void operator()(const f32x4 (&acc)[2][2][4][2], const Unit& u, int wr, int wc, int fr_, int fq_) const {
        int z_; asm volatile("v_mov_b32 %0, 0" : "=v"(z_)); const int fr = fr_ + z_, fq = fq_ + z_;
        const int b = u.pm >> 6, h = (u.pm >> 4) & 3, c = u.pm & 15;
        const int row0 = b * 4096 + c * 256 + wr * 64 + fr, col0 = h * 256 + wc * 32 + 4 * fq;
#pragma unroll
        for (int ai = 0; ai < 2; ++ai)
#pragma unroll
            for (int m = 0; m < 4; ++m) { float* rowp = HR + (size_t)(row0 + ai * HALF + m * 16) * 1024 + col0;
#pragma unroll
                for (int bj = 0; bj < 2; ++bj)
#pragma unroll
                    for (int n = 0; n < 2; ++n) *(f32x4*)(rowp + bj * HALF + n * 16) = acc[ai][bj][m][n]; }
    }
};
struct EpiFin {
    static constexpr bool PERM = true;
    bf16_t* O; const bf16_t* PROJ; int ldp; const float* headg; PG8_LAS float* sDen; PG8_LAS float* sSS; float eps;
    __device__ __forceinline__ void operator()(const f32x4 (&acc)[2][2][4][2], const Unit& u, int wr, int wc, int fr_, int fq_) const {
        int z_; asm volatile("v_mov_b32 %0, 0" : "=v"(z_)); const int fr = fr_ + z_, fq = fq_ + z_;
        const int b = u.pm >> 6, h = (u.pm >> 4) & 3, c = u.pm & 15;
        const int rl0 = wr * 64 + fr, col0 = wc * 32 + 8 * fq;
#pragma unroll
        for (int ai = 0; ai < 2; ++ai)
#pragma unroll
            for (int m = 0; m < 4; ++m) { float p = 0.f;
#pragma unroll
                for (int bj = 0; bj < 2; ++bj)
#pragma unroll
                    for (int n = 0; n < 2; ++n) { const f32x4 v = acc[ai][bj][m][n]; p += v[0] * v[0] + v[1] * v[1] + v[2] * v[2] + v[3] * v[3]; }
                p += __shfl_xor(p, 16); p += __shfl_xor(p, 32);
                if (fq == 0) sSS[wc * 256 + rl0 + ai * HALF + m * 16] = p; }
        asm volatile("s_waitcnt lgkmcnt(0)" ::: "memory"); __builtin_amdgcn_s_barrier();
        f32x4 hv[2][2];
#pragma unroll
        for (int bj = 0; bj < 2; ++bj)
#pragma unroll
            for (int n = 0; n < 2; ++n) hv[bj][n] = *(const f32x4*)(headg + h * 256 + col0 + bj * HALF + 4 * n);
#pragma unroll
        for (int ai = 0; ai < 2; ++ai) {
            const size_t t0 = (size_t)b * 4096 + c * 256 + rl0 + ai * HALF;
            u32x4 ow[4][2];
#pragma unroll
            for (int m = 0; m < 4; ++m)
#pragma unroll
                for (int bj = 0; bj < 2; ++bj) ow[m][bj] = *(const u32x4*)(PROJ + (t0 + m * 16) * ldp + 3072 + h * 256 + col0 + bj * HALF);
#pragma unroll
            for (int m = 0; m < 4; ++m) { const int rl = rl0 + ai * HALF + m * 16;
                const float P = (sSS[rl] + sSS[256 + rl]) + (sSS[512 + rl] + sSS[768 + rl]), idd = sDen[rl];
                const float f = idd * (1.0f / sqrtf(P * idd * idd * (1.0f / 256.0f) + eps));
                bf16_t* rowp = O + (t0 + m * 16) * 2048 + h * 256 + col0;
#pragma unroll
                for (int bj = 0; bj < 2; ++bj) { const f32x4 v0 = acc[ai][bj][m][0] * f * hv[bj][0], v1 = acc[ai][bj][m][1] * f * hv[bj][1]; const u32x4 o = ow[m][bj];
                    const f32x2p s0 = sigm2(o.x), s1 = sigm2(o.y), s2 = sigm2(o.z), s3 = sigm2(o.w);
                    u32x4 w; w.x = cvt_pk_bf16(v0[0] * s0.x, v0[1] * s0.y); w.y = cvt_pk_bf16(v0[2] * s1.x, v0[3] * s1.y); w.z = cvt_pk_bf16(v1[0] * s2.x, v1[1] * s2.y); w.w = cvt_pk_bf16(v1[2] * s3.x, v1[3] * s3.y);
                    *(u32x4*)(rowp + bj * HALF) = w; } } }
    }
};
struct EpiPool {
    static constexpr bool PERM = true;
    bf16_t* O; const float* scale;
    __device__ __forceinline__ void operator()(const f32x4 (&acc)[2][2][4][2], const Unit& u, int wr, int wc, int fr_, int fq_) const {
        int z_; asm volatile("v_mov_b32 %0, 0" : "=v"(z_)); const int fr = fr_ + z_, fq = fq_ + z_;
        const int row0 = u.pm * BM + wr * 64 + fr, col0 = u.pn * 256 + wc * 32 + 8 * fq;
        f32x4 sv[2][2];
#pragma unroll
        for (int bj = 0; bj < 2; ++bj)
#pragma unroll
            for (int n = 0; n < 2; ++n) sv[bj][n] = *(const f32x4*)(scale + col0 + bj * HALF + 4 * n);
#pragma unroll
        for (int ai = 0; ai < 2; ++ai)
#pragma unroll
            for (int m = 0; m < 4; ++m) { bf16_t* rowp = O + (size_t)(row0 + ai * HALF + m * 16) * 2048 + 1024 + col0;
#pragma unroll
                for (int bj = 0; bj < 2; ++bj) { const f32x4 v0 = acc[ai][bj][m][0] * sv[bj][0], v1 = acc[ai][bj][m][1] * sv[bj][1];
                    u32x4 w; w.x = cvt_pk_bf16(v0[0], v0[1]); w.y = cvt_pk_bf16(v0[2], v0[3]); w.z = cvt_pk_bf16(v1[0], v1[1]); w.w = cvt_pk_bf16(v1[2], v1[3]);
                    *(u32x4*)(rowp + bj * HALF) = w; } }
    }
};

typedef int v8i_t __attribute__((ext_vector_type(8)));
typedef int v4i_t __attribute__((ext_vector_type(4)));
__device__ __forceinline__ v8i_t cat8(bf16x8 lo, bf16x8 hi) { return __builtin_shufflevector(__builtin_bit_cast(v4i_t, lo), __builtin_bit_cast(v4i_t, hi), 0, 1, 2, 3, 4, 5, 6, 7); }
template <class Epi, class Sched, bool ALIGN_EPI = false, bool SP2 = false, bool F8 = false>
__device__ __forceinline__ void gemm_phase(PG8_LAS unsigned char* lds, const Dims g, const Sched& S, const Epi& E) {
    int tid_ = threadIdx.x; asm volatile("" : "+v"(tid_));
    const int tid = tid_, wid = __builtin_amdgcn_readfirstlane(tid >> 6), lane = tid & 63, wr = wid >> 2, wc = wid & 3, fr = lane & 15, fq = lane >> 4;
    const int K = g.K, nt = K / BK;
    unsigned voffA[2], voffB[2];
#pragma unroll
    for (int i = 0; i < 2; ++i) { int R, C; stage_rc(tid * 16 + i * 8192, R, C); const int Rb = Epi::PERM ? ((R & ~31) + perm32(R & 31)) : R;
        voffA[i] = (unsigned)(R * g.lda + C) * 2u; voffB[i] = (unsigned)(Rb * g.ldb + C) * 2u; }
    const size_t kstep = (size_t)(BK * 2);
    const size_t hstepA = (size_t)HALF * g.lda * 2, hstepB = (size_t)HALF * g.ldb * 2;
    const unsigned ldsw = (unsigned)wid * 1024u;
    const int aoff = lds_byte(wr * 64 + fr, fq * 8), boff = lds_byte(wc * 32 + fr, fq * 8);
#define PG8_SA(b, h) (((b) * 2 + (h)) * HTB)
#define PG8_SB(b, h) ((4 + (b) * 2 + (h)) * HTB)
#define PG8_STAGE(bufoff, gbase, voff) do { _Pragma("unroll") for (int _i = 0; _i < 2; ++_i) \
        __builtin_amdgcn_global_load_lds((const unsigned*)((const char*)(gbase) + (voff)[_i]), (PG8_LAS unsigned*)(lds + (bufoff) + ldsw + _i * 8192), 16, 0, 0); } while (0)
#define PG8_LDA(dst, b, h) do { if constexpr (F8) { _Pragma("unroll") for (int m = 0; m < 4; ++m) { const v4i_t lo_ = *(const PG8_LAS v4i_t*)(lds + PG8_SA(b, h) + aoff + m * 2048), hi_ = *(const PG8_LAS v4i_t*)(lds + PG8_SA(b, h) + aoff + m * 2048 + 1024); dst##8[m] = __builtin_shufflevector(lo_, hi_, 0, 1, 2, 3, 4, 5, 6, 7); } } else { \
        _Pragma("unroll") for (int m = 0; m < 4; ++m) _Pragma("unroll") for (int k = 0; k < 2; ++k) dst[m][k] = *(const PG8_LAS bf16x8*)(lds + PG8_SA(b, h) + aoff + m * 2048 + k * 1024); } } while (0)
#define PG8_LDB(dst, b, h) do { if constexpr (F8) { _Pragma("unroll") for (int n = 0; n < 2; ++n) { const v4i_t lo_ = *(const PG8_LAS v4i_t*)(lds + PG8_SB(b, h) + boff + n * 2048), hi_ = *(const PG8_LAS v4i_t*)(lds + PG8_SB(b, h) + boff + n * 2048 + 1024); dst##8[n] = __builtin_shufflevector(lo_, hi_, 0, 1, 2, 3, 4, 5, 6, 7); } } else { \
        _Pragma("unroll") for (int n = 0; n < 2; ++n) _Pragma("unroll") for (int k = 0; k < 2; ++k) dst[n][k] = *(const PG8_LAS bf16x8*)(lds + PG8_SB(b, h) + boff + n * 2048 + k * 1024); } } while (0)
#define PG8_MMA(ai, bj, At, Bt) do { __builtin_amdgcn_s_setprio(1); if constexpr (F8) { _Pragma("unroll") for (int m = 0; m < 4; ++m) _Pragma("unroll") for (int n = 0; n < 2; ++n) \
        asm volatile("v_mfma_scale_f32_16x16x128_f8f6f4 %0, %1, %2, %0, %3, %3 op_sel_hi:[0,0,0]" : "+v"(acc[ai][bj][m][n]) : "v"(Bt##8[n]), "v"(At##8[m]), "v"(sc8)); } else { \
        _Pragma("unroll") for (int m = 0; m < 4; ++m) _Pragma("unroll") for (int n = 0; n < 2; ++n) _Pragma("unroll") for (int k = 0; k < 2; ++k) \
        acc[ai][bj][m][n] = __builtin_amdgcn_mfma_f32_16x16x32_bf16(Bt[n][k], At[m][k], acc[ai][bj][m][n], 0, 0, 0); } __builtin_amdgcn_s_setprio(0); } while (0)
#define PG8_WAIT_V(n) asm volatile("s_waitcnt vmcnt(" #n ")" ::: "memory")
#define PG8_WAIT_L(n) asm volatile("s_waitcnt lgkmcnt(" #n ")" ::: "memory")
#define PG8_BAR __builtin_amdgcn_s_barrier()
#define PG8_SCHED __builtin_amdgcn_sched_barrier(0)
    Unit cur, nxt; int ui = 0;
    if (!S.next(0, cur)) return;
    f32x4 acc[2][2][4][2];
#pragma unroll
    for (int a = 0; a < 2; ++a)
#pragma unroll
        for (int b = 0; b < 2; ++b)
#pragma unroll
            for (int m = 0; m < 4; ++m)
#pragma unroll
                for (int n = 0; n < 2; ++n) acc[a][b][m][n] = (f32x4){0.f, 0.f, 0.f, 0.f};
    int sc8 = 0x7f7f7f7f; asm volatile("" : "+v"(sc8));
    bf16x8 At[4][2], B0[2][2], B1[2][2]; v8i_t At8[4], B08[2], B18[2]; (void)At; (void)B0; (void)B1; (void)At8; (void)B08; (void)B18;
    const char* cA = cur.a; const char* cB = cur.b;
    S.a_ready(cur);
    if constexpr (SP2) {
        PG8_STAGE(PG8_SB(0, 0), cB, voffB); PG8_STAGE(PG8_SB(0, 1), cB + hstepB, voffB); PG8_STAGE(PG8_SA(0, 0), cA, voffA); PG8_STAGE(PG8_SA(0, 1), cA + hstepA, voffA);
        if (wr == 1) PG8_BAR;
        PG8_WAIT_V(2); PG8_BAR;
        PG8_STAGE(PG8_SB(1, 0), cB + kstep, voffB); PG8_STAGE(PG8_SA(1, 0), cA + kstep, voffA); PG8_STAGE(PG8_SB(1, 1), cB + hstepB + kstep, voffB);
        PG8_WAIT_V(6); PG8_BAR;
    } else {
        PG8_STAGE(PG8_SB(0, 0), cB, voffB); PG8_STAGE(PG8_SA(0, 0), cA, voffA); PG8_STAGE(PG8_SB(0, 1), cB + hstepB, voffB); PG8_STAGE(PG8_SA(0, 1), cA + hstepA, voffA);
        if (wr == 1) PG8_BAR;
        PG8_WAIT_V(4); PG8_BAR;
        PG8_STAGE(PG8_SB(1, 0), cB + kstep, voffB); PG8_STAGE(PG8_SA(1, 0), cA + kstep, voffA); PG8_STAGE(PG8_SB(1, 1), cB + hstepB + kstep, voffB);
        PG8_WAIT_V(6); PG8_BAR;
    }
    for (;;) {
        const bool has_next = S.next(ui + 1, nxt);
        const char* nA = has_next ? nxt.a : cA; const char* nB = has_next ? nxt.b : cB;
#pragma nounroll
        for (int t = 0; t < nt; t += 2) {
            const bool last = (t == nt - 2);
            const char* a1 = cA + (size_t)(t + 1) * kstep;
            const char* a2 = last ? nA : cA + (size_t)(t + 2) * kstep; const char* b2 = last ? nB : cB + (size_t)(t + 2) * kstep;
            const char* a3 = a2 + kstep; const char* b3 = b2 + kstep;
            if (last && has_next) S.a_ready(nxt);
            if constexpr (SP2) {
            PG8_LDB(B0, 0, 0); PG8_LDB(B1, 0, 1); PG8_SCHED; PG8_LDA(At, 0, 0); PG8_STAGE(PG8_SA(1, 1), a1 + hstepA, voffA);
            PG8_WAIT_V(8); PG8_WAIT_L(0); PG8_BAR; PG8_MMA(0, 0, At, B0); PG8_MMA(0, 1, At, B1); PG8_BAR; PG8_SCHED;
            PG8_LDA(At, 0, 1); PG8_STAGE(PG8_SB(0, 0), b2, voffB); PG8_STAGE(PG8_SB(0, 1), b2 + hstepB, voffB); PG8_STAGE(PG8_SA(0, 0), a2, voffA);
            PG8_WAIT_V(8); PG8_WAIT_L(0); PG8_BAR; PG8_MMA(1, 0, At, B0); PG8_MMA(1, 1, At, B1); PG8_BAR; PG8_SCHED;
            PG8_LDB(B0, 1, 0); PG8_LDB(B1, 1, 1); PG8_SCHED; PG8_LDA(At, 1, 0); PG8_STAGE(PG8_SA(0, 1), a2 + hstepA, voffA);
            PG8_WAIT_V(8); PG8_WAIT_L(0); PG8_BAR; PG8_MMA(0, 0, At, B0); PG8_MMA(0, 1, At, B1); PG8_BAR; PG8_SCHED;
            PG8_LDA(At, 1, 1); PG8_STAGE(PG8_SB(1, 0), b3, voffB); PG8_STAGE(PG8_SB(1, 1), b3 + hstepB, voffB); PG8_STAGE(PG8_SA(1, 0), a3, voffA);
            PG8_WAIT_V(8); PG8_WAIT_L(0); PG8_BAR; PG8_MMA(1, 0, At, B0); PG8_MMA(1, 1, At, B1); PG8_BAR; PG8_SCHED;
            } else {
            PG8_LDB(B0, 0, 0); PG8_SCHED; PG8_LDA(At, 0, 0); PG8_STAGE(PG8_SA(1, 1), a1 + hstepA, voffA);
            PG8_WAIT_L(8); PG8_BAR; PG8_WAIT_L(0); PG8_MMA(0, 0, At, B0); PG8_BAR; PG8_SCHED;
            PG8_LDB(B1, 0, 1); PG8_STAGE(PG8_SB(0, 0), b2, voffB);
            PG8_BAR; PG8_WAIT_L(0); PG8_MMA(0, 1, At, B1); PG8_BAR;
            PG8_LDA(At, 0, 1); PG8_STAGE(PG8_SA(0, 0), a2, voffA);
            PG8_BAR; PG8_WAIT_L(0); PG8_MMA(1, 0, At, B0); PG8_BAR; PG8_SCHED;
            PG8_STAGE(PG8_SB(0, 1), b2 + hstepB, voffB);
            PG8_WAIT_V(6); PG8_BAR; PG8_MMA(1, 1, At, B1); PG8_BAR;
            PG8_LDB(B0, 1, 0); PG8_SCHED; PG8_LDA(At, 1, 0); PG8_STAGE(PG8_SA(0, 1), a2 + hstepA, voffA);
            PG8_WAIT_L(8); PG8_BAR; PG8_WAIT_L(0); PG8_MMA(0, 0, At, B0); PG8_BAR; PG8_SCHED;
            PG8_LDB(B1, 1, 1); PG8_STAGE(PG8_SB(1, 0), b3, voffB);
            PG8_BAR; PG8_WAIT_L(0); PG8_MMA(0, 1, At, B1); PG8_BAR;
            PG8_LDA(At, 1, 1); PG8_STAGE(PG8_SA(1, 0), a3, voffA);
            PG8_BAR; PG8_WAIT_L(0); PG8_MMA(1, 0, At, B0); PG8_BAR; PG8_SCHED;
            PG8_STAGE(PG8_SB(1, 1), b3 + hstepB, voffB);
            PG8_WAIT_V(6); PG8_BAR; PG8_MMA(1, 1, At, B1); PG8_BAR;
            }
        }
        if constexpr (F8) {
#pragma unroll
            for (int a = 0; a < 2; ++a)
#pragma unroll
                for (int b = 0; b < 2; ++b)
                    asm volatile("s_nop 15\n\ts_nop 15" : "+v"(acc[a][b][0][0]), "+v"(acc[a][b][0][1]), "+v"(acc[a][b][1][0]), "+v"(acc[a][b][1][1]), "+v"(acc[a][b][2][0]), "+v"(acc[a][b][2][1]), "+v"(acc[a][b][3][0]), "+v"(acc[a][b][3][1]));
        }
        if constexpr (ALIGN_EPI) { if (wr == 0) PG8_BAR; }
        E(acc, cur, wr, wc, fr, fq); S.done(cur);
        if (!has_next) break;
#pragma unroll
        for (int a = 0; a < 2; ++a)
#pragma unroll
            for (int b = 0; b < 2; ++b)
#pragma unroll
                for (int m = 0; m < 4; ++m)
#pragma unroll
                    for (int n = 0; n < 2; ++n) acc[a][b][m][n] = (f32x4){0.f, 0.f, 0.f, 0.f};
        cur = nxt; cA = nA; cB = nB; ++ui;
        if constexpr (ALIGN_EPI) { if (wr == 1) PG8_BAR; }
    }
    PG8_WAIT_V(0);
    if constexpr (!ALIGN_EPI) { if (wr == 0) PG8_BAR; }
    PG8_BAR;
#undef PG8_SA
#undef PG8_SB
#undef PG8_STAGE
#undef PG8_LDA
#undef PG8_LDB
#undef PG8_MMA
#undef PG8_WAIT_V
#undef PG8_WAIT_L
#undef PG8_BAR
#undef PG8_SCHED
}
}

constexpr int NWAVES = 8;
constexpr int DM = 2048, NTOK = 8192, SEQ = 4096;
constexpr int DINS = 5128, DINP = 5120;
constexpr int DFF = 5632, NE = 8, DFE = 7168;
constexpr int NUNIT = 128;
constexpr int MAXSLOT = 18432;
constexpr float EPS = 1e-6f;

constexpr size_t MiB = 1u << 20;
constexpr size_t WS_CTL = 0, CTL_ZERO_BYTES = 1 * MiB;
constexpr size_t WS_MOD = 1 * MiB;
constexpr size_t WS_GWT = WS_MOD + 256 * 1024;
constexpr size_t WS_RWT = WS_GWT + 64 * 1024;
constexpr size_t WS_GATES = WS_RWT + 64 * 1024;
constexpr size_t WS_BCUM = WS_GATES + 256 * 1024;
constexpr size_t WS_IG = WS_BCUM + 128 * 1024;
constexpr size_t WS_GTOT = WS_IG + 128 * 1024;
constexpr size_t WS_DN = WS_GTOT + 4 * 1024;
constexpr size_t WS_NVEC = WS_DN + 128 * 1024;
constexpr size_t WS_TOKINFO = WS_NVEC + 128 * 1024;
constexpr size_t WS_TOKSLOT = WS_TOKINFO + 256 * 1024;
constexpr size_t WS_SLOTGATE = WS_TOKSLOT + 64 * 1024;
static_assert(WS_SLOTGATE + 128 * 1024 <= 4 * MiB, "small arrays");
constexpr size_t WS_WIN = 4 * MiB, WS_WOUT = 24 * MiB, WS_W13 = 32 * MiB, WS_W2 = 76 * MiB, WS_WQKV = 98 * MiB, WS_WO = 122 * MiB, WS_POOLW = 130 * MiB;
constexpr size_t WS_W13E = 132 * MiB, WS_W2E = 580 * MiB;
constexpr size_t WS_XR = 804 * MiB, WS_HN = 868 * MiB;
constexpr size_t WS_L = 900 * MiB;
constexpr size_t WS_PROJ = WS_L, WS_QB = WS_L + 80 * MiB, WS_KB = WS_L + 96 * MiB, WS_KWT = WS_L + 112 * MiB, WS_AP = WS_L + 128 * MiB, WS_BP = WS_L + 160 * MiB,
                 WS_DCT = WS_L + 192 * MiB, WS_HR = WS_L + 224 * MiB, WS_POOLED = WS_L + 256 * MiB, WS_MIXCAT = WS_L + 272 * MiB, WS_U = WS_L + 304 * MiB;
constexpr size_t WS_QB2 = WS_L, WS_KB2 = WS_L + 32 * MiB, WS_VT = WS_L + 64 * MiB, WS_ATTO = WS_L + 96 * MiB, WS_HPERM = WS_L + 128 * MiB, WS_UE = WS_L + 200 * MiB, WS_Y = WS_L + 452 * MiB;
constexpr size_t WS_YP = WS_L + 528 * MiB;
constexpr size_t WS_END = WS_L + 596 * MiB;

constexpr int CW_TMO = 0, CW_CODE = 1;
constexpr int CW_BAR = 4096;
constexpr int CW_P0PUB = 10752;
constexpr int CW_QCVT = 10496;
constexpr int CW_RDONE = 10240;
constexpr int CW_CNT = 8192;

constexpr int RING_OFF = 0, RING_BYTES = 131072;
constexpr int LDS_BYTES = 147456;
constexpr int LDSCTL_OFF = LDS_BYTES - 512, MISC_OFF = LDSCTL_OFF;

#define GAS __attribute__((address_space(1)))
#define LAS __attribute__((address_space(3)))
typedef unsigned short bf16;
typedef unsigned v4u __attribute__((ext_vector_type(4)));
typedef unsigned v2u __attribute__((ext_vector_type(2)));
typedef float f32x4 __attribute__((ext_vector_type(4)));
typedef GAS unsigned gu32;
#define RLX_AGENT __ATOMIC_RELAXED, __HIP_MEMORY_SCOPE_AGENT
#define LDS_WAIT() asm volatile("s_waitcnt lgkmcnt(0)" ::: "memory")
#define VM_WAIT() asm volatile("s_waitcnt vmcnt(0)" ::: "memory")
__device__ __forceinline__ unsigned pk2(float lo, float hi) { return pg8::cvt_pk_bf16(lo, hi); }
__device__ __forceinline__ float bflo(unsigned w) { return __uint_as_float(w << 16); }
__device__ __forceinline__ float bfhi(unsigned w) { return __uint_as_float(w & 0xffff0000u); }
__device__ __forceinline__ float logsig(float x) { return fminf(x, 0.f) - log1pf(expf(-fabsf(x))); }
__device__ __forceinline__ float dot4(f32x4 a, f32x4 b) { return (a.x * b.x + a.y * b.y) + (a.z * b.z + a.w * b.w); }

#define XB_TMO      128
#define XB_XCNT(j)  (256  + 64 * (j))
#define XB_XSUB(j)  (1280 + 64 * (j))
#define XB_XGEN(j)  (2304 + 64 * (j))
#define XB_TOP      3328
#define XB_TOPGEN   3392
#define XCD_BAR_WORDS 3456
#define XB_SPIN_CAP (1u << 20)

__device__ __forceinline__ unsigned xb_ld(unsigned* p)              { return __hip_atomic_load(p, __ATOMIC_RELAXED, __HIP_MEMORY_SCOPE_AGENT); }
__device__ __forceinline__ unsigned xb_add(unsigned* p, unsigned v) { return __hip_atomic_fetch_add(p, v, __ATOMIC_RELAXED, __HIP_MEMORY_SCOPE_AGENT); }
__device__ __forceinline__ unsigned xb_xcc_id() { return (unsigned)__builtin_amdgcn_s_getreg((3 << 11) | 20) & 0xFu; }
#define XB_SPIN(cond, bar) do { unsigned _sp = 0; while (cond) { __builtin_amdgcn_s_sleep(1); \
    if ((++_sp & 255u) == 0u) { if (xb_ld(&(bar)[XB_TMO])) break; if (_sp > XB_SPIN_CAP) { atomicAdd(&(bar)[XB_TMO], 1u); break; } } } } while (0)

struct XcdBarrier { unsigned* bar; unsigned x; volatile LAS unsigned* st; };

__device__ __forceinline__ XcdBarrier xcd_barrier_post(unsigned* bar, volatile LAS unsigned* st) {
    XcdBarrier b; b.bar = bar; b.x = xb_xcc_id(); b.st = st;
    if (threadIdx.x == 0) (void)xb_add(&bar[XB_XCNT(b.x)], 1u);
    return b;
}
__device__ __forceinline__ void xcd_barrier_complete(unsigned* bar, unsigned x, unsigned& nloc, unsigned& nx) {
    const unsigned G = gridDim.x * gridDim.y * gridDim.z;
    unsigned sum, cnt, mine, sp = 0u;
    for (;;) {
        sum = 0u; cnt = 0u; mine = 0u;
#pragma unroll
        for (unsigned j = 0; j < 16; ++j) { const unsigned c = xb_ld(&bar[XB_XCNT(j)]); sum += c; cnt += (c > 0u) ? 1u : 0u; mine = (j == x) ? c : mine; }
        if (sum == G) break;
        __builtin_amdgcn_s_sleep(1);
        if ((++sp & 255u) == 0u) { if (xb_ld(&bar[XB_TMO])) break; if (sp > XB_SPIN_CAP) { atomicAdd(&bar[XB_TMO], 1u); break; } }
    }
    nloc = mine > 0u ? mine : 1u; nx = cnt > 0u ? cnt : 1u;
}
__device__ __forceinline__ void xcd_barrier(const XcdBarrier& b) {
    asm volatile("s_waitcnt vmcnt(0)" ::: "memory");
    __syncthreads();
    int tid0 = threadIdx.x; asm volatile("" : "+v"(tid0));
    if (tid0 == 0) {
        unsigned* bar = b.bar;
        __builtin_amdgcn_s_waitcnt(0);
        unsigned nloc = b.st[0], nx = b.st[1];
        if (nloc == 0u) { xcd_barrier_complete(bar, b.x, nloc, nx); b.st[0] = nloc; b.st[1] = nx; }
        const unsigned old = xb_add(&bar[XB_XSUB(b.x)], 1u);
        const unsigned gen = old / nloc;
        if (old + 1u == (gen + 1u) * nloc) {
            __builtin_amdgcn_fence(__ATOMIC_RELEASE, "agent");
            asm volatile("s_waitcnt vmcnt(0)" ::: "memory");
            const unsigned og = xb_add(&bar[XB_TOP], 1u);
            const unsigned tg = og / nx;
            if (og + 1u == (tg + 1u) * nx) xb_add(&bar[XB_TOPGEN], 1u);
            else XB_SPIN(xb_ld(&bar[XB_TOPGEN]) == tg, bar);
            __builtin_amdgcn_fence(__ATOMIC_ACQUIRE, "agent");
            xb_add(&bar[XB_XGEN(b.x)], 1u);
            asm volatile("s_waitcnt vmcnt(0)" ::: "memory");
        } else {
            XB_SPIN(xb_ld(&bar[XB_XGEN(b.x)]) == gen, bar);
            __builtin_amdgcn_fence(__ATOMIC_ACQUIRE, "agent");
            asm volatile("s_waitcnt vmcnt(0)" ::: "memory");
        }
    }
    __syncthreads();
}

struct Args { const float* in[24]; float* out; unsigned char* ws; };
struct Frame {
    LAS unsigned char* lds; volatile LAS unsigned* MISC; gu32* ctl;
    int G, bid;
    unsigned char* ws;
};
__device__ __forceinline__ float wave_sum(float v) {
#pragma unroll
    for (int o = 1; o < 64; o <<= 1) v += __shfl_xor(v, o);
    return v;
}

__device__ __forceinline__ void transpose_item(const float* src, int spitch, int k0, int n0s, bf16* dst, int dpitch, int n0d, LAS unsigned* T, int lane) {
    const int kr = lane & 3, nq = lane >> 2;
#pragma unroll
    for (int i = 0; i < 8; ++i) {
        const int k = k0 + 8 * i + 2 * kr;
        const f32x4 a = *(const f32x4*)(src + (size_t)k * spitch + n0s + 4 * nq);
        const f32x4 b = *(const f32x4*)(src + (size_t)(k + 1) * spitch + n0s + 4 * nq);
#pragma unroll
        for (int j = 0; j < 4; ++j) T[(4 * nq + j) * 33 + 4 * i + kr] = pk2(a[j], b[j]);
    }
    LDS_WAIT();
#pragma unroll
    for (int it = 0; it < 8; ++it) {
        const int n = (lane >> 3) + 8 * it, c = lane & 7;
        v4u o; o.x = T[n * 33 + 4 * c]; o.y = T[n * 33 + 4 * c + 1]; o.z = T[n * 33 + 4 * c + 2]; o.w = T[n * 33 + 4 * c + 3];
        *(v4u*)(dst + (size_t)(n0d + n) * dpitch + k0 + 8 * c) = o;
    }
    LDS_WAIT();
}
__device__ __forceinline__ void transpose_item8(const float* src, int spitch, int k0, int n0s, unsigned char* dst, int dpitch, int n0d, float scale, LAS unsigned* T, int lane) {
    const int kr = lane & 3, nq = lane >> 2;
    f32x4 a[8][4];
#pragma unroll
    for (int i = 0; i < 8; ++i) { const float* p = src + (size_t)(k0 + 16 * i + 4 * kr) * spitch + n0s + 4 * nq;
#pragma unroll
        for (int q = 0; q < 4; ++q) a[i][q] = *(const f32x4*)(p + (size_t)q * spitch); }
#pragma unroll
    for (int i = 0; i < 8; ++i)
#pragma unroll
        for (int j = 0; j < 4; ++j) T[(4 * nq + j) * 33 + 4 * i + kr] = pg8::pk4_fp8(a[i][0][j] * scale, a[i][1][j] * scale, a[i][2][j] * scale, a[i][3][j] * scale);
    LDS_WAIT();
#pragma unroll
    for (int it = 0; it < 8; ++it) {
        const int n = (lane >> 3) + 8 * it, c = lane & 7;
        v4u o; o.x = T[n * 33 + 4 * c]; o.y = T[n * 33 + 4 * c + 1]; o.z = T[n * 33 + 4 * c + 2]; o.w = T[n * 33 + 4 * c + 3];
        *(v4u*)(dst + (size_t)(n0d + n) * dpitch + k0 + 16 * c) = o;
    }
    LDS_WAIT();
}
constexpr float WS8 = 64.0f;
constexpr int I_W13E = 8 * 16 * 224, I_W2E = 8 * 56 * 32, I_WIN = 32 * 80, I_WOUT = 32 * 32, I_W13 = 32 * 176, I_W2 = 88 * 32, I_WQKV = 32 * 96, I_WO = 32 * 32, I_POOL = 4 * 16;
constexpr int N_ITEMS = I_W13E + I_W2E + I_WIN + I_WOUT + I_W13 + I_W2 + I_WQKV + I_WO + I_POOL;
constexpr int NT_W13E = 8 * 8 * 56, NT_W2E = 8 * 28 * 8, NT_WIN = 16 * 20, NT_WOUT = 16 * 8, NT_W13 = 0, NT_W2 = 0  , NT_WQKV = 16 * 24, NT_WO = 16 * 8, NT_POOL = 8;
constexpr int NT_W13F = 8 * 44, NT_W2F = 22 * 8;
constexpr int NT_ALL = NT_W13E + NT_W2E + NT_W13F + NT_W2F + NT_WIN + NT_WOUT + NT_W13 + NT_W2 + NT_WQKV + NT_WO + NT_POOL;
constexpr int TAILQ2 = 7, TAILQ10 = 5, TAILQ6 = 1, TAILQ4 = 1;
constexpr int P0_TILE0 = 128 * (TAILQ2 + TAILQ10 + TAILQ6 + TAILQ4);
constexpr int QCVT_N = 1024, QCVT_LO = NT_W13E + NT_W2E - QCVT_N;

template <bool DYN = false>
__device__ __forceinline__ void convert_tiles(Frame& F, const Args& args, int first, int last, int stride, gu32* q = nullptr) {
    int tid = threadIdx.x; asm volatile("" : "+v"(tid)); const int lane = tid & 63, wave = __builtin_amdgcn_readfirstlane(tid >> 6);
    unsigned char* ws = F.ws;
    {
        const int nl = 4 * lane;
        struct Tile { const float* s; int spitch; unsigned char* d; size_t dpitch; bool f8; };
        auto decode = [&](int it) -> Tile {
            Tile t; int r = it; if (!DYN && r >= QCVT_LO) r += QCVT_N;
            if (r < NT_W13E) { const int e = r / (8 * 56), rr = r % (8 * 56), kb = rr / 56, nb = rr % 56; t.f8 = true; t.spitch = DFE;
                t.s = (nl < 128 ? args.in[21] + nb * 128 + nl : args.in[22] + nb * 128 + nl - 128) + (size_t)e * 2048 * DFE + (size_t)(kb * 256 + wave * 32) * DFE;
                t.d = ws + WS_W13E + ((size_t)e * 14336 + nb * 256) * 2048 + kb * 256; t.dpitch = 2048; }
            else if ((r -= NT_W13E) < NT_W2E) { const int e = r / (28 * 8), rr = r % (28 * 8), kb = rr / 8, nb = rr % 8; t.f8 = true; t.spitch = 2048;
                t.s = args.in[23] + (size_t)e * DFE * 2048 + (size_t)(kb * 256 + wave * 32) * 2048 + nb * 256 + nl;
                t.d = ws + WS_W2E + ((size_t)e * 2048 + nb * 256) * DFE + kb * 256; t.dpitch = DFE; }
            else if ((r -= NT_W2E) < NT_W13F) { const int kb = r / 44, nb = r % 44; t.f8 = true; t.spitch = DFF;
                t.s = (nl < 128 ? args.in[15] + nb * 128 + nl : args.in[16] + nb * 128 + nl - 128) + (size_t)(kb * 256 + wave * 32) * DFF;
                t.d = ws + WS_W13 + ((size_t)nb * 256) * 2048 + kb * 256; t.dpitch = 2048; }
            else if ((r -= NT_W13F) < NT_W2F) { const int kb = r / 8, nb = r % 8; t.f8 = true; t.spitch = 2048;
                t.s = args.in[17] + (size_t)(kb * 256 + wave * 32) * 2048 + nb * 256 + nl;
                t.d = ws + WS_W2 + ((size_t)nb * 256) * DFF + kb * 256; t.dpitch = DFF; }
            else { t.f8 = false; r -= NT_W2F; int kb, nb, K; const float* base; unsigned char* db; int scol;
                if (r < NT_WIN) { kb = r / 20; nb = r % 20; K = 2048; t.spitch = DINS; base = args.in[7]; db = ws + WS_WIN; scol = nb * 256 + nl + (nb >= 16 ? 8 : 0); }
                else if ((r -= NT_WIN) < NT_WOUT) { kb = r / 8; nb = r % 8; K = 2048; t.spitch = 2048; base = args.in[14]; db = ws + WS_WOUT; scol = nb * 256 + nl; }
                else if ((r -= NT_WOUT) < NT_W13) { kb = r / 44; nb = r % 44; K = 2048; t.spitch = DFF; base = (nl < 128 ? args.in[15] : args.in[16] - 128); db = ws + WS_W13; scol = nb * 128 + nl; }
                else if ((r -= NT_W13) < NT_W2) { kb = r / 8; nb = r % 8; K = DFF; t.spitch = 2048; base = args.in[17]; db = ws + WS_W2; scol = nb * 256 + nl; }
                else if ((r -= NT_W2) < NT_WQKV) { kb = r / 24; nb = r % 24; K = 2048; t.spitch = 6144; base = args.in[18]; db = ws + WS_WQKV; scol = nb * 256 + nl; }
                else if ((r -= NT_WQKV) < NT_WO) { kb = r / 8; nb = r % 8; K = 2048; t.spitch = 2048; base = args.in[19]; db = ws + WS_WO; scol = nb * 256 + nl; }
                else { r -= NT_WO; kb = r & 1; nb = 0; K = 256; t.spitch = 256; base = args.in[12] + (size_t)(r >> 1) * 65536; db = ws + WS_POOLW + (size_t)(r >> 1) * 131072; scol = nl; }
                t.s = base + (size_t)(kb * 128 + wave * 16) * t.spitch + scol; t.d = db + ((size_t)nb * 256 * K + kb * 128) * 2; t.dpitch = (size_t)K * 2; }
            return t; };
        int buf = 0;
        f32x4 a[32];
        LAS int* slot = (LAS int*)(F.lds + RING_OFF + RING_BYTES + 8192);
        int it = first, nxt = 0, kq = 0;
        if (DYN) { if (tid == 0) { slot[0] = first + (int)__hip_atomic_fetch_add(q, 1u, __ATOMIC_RELAXED, __HIP_MEMORY_SCOPE_AGENT); slot[1] = first + (int)__hip_atomic_fetch_add(q, 1u, __ATOMIC_RELAXED, __HIP_MEMORY_SCOPE_AGENT); }
            __syncthreads(); it = __builtin_amdgcn_readfirstlane(slot[0]); nxt = __builtin_amdgcn_readfirstlane(slot[1]); __syncthreads(); }
        Tile cur = decode(it < last ? it : 0);
        if (it < last) {
#pragma unroll
            for (int kk = 0; kk < 32; ++kk) if (kk < 16 || cur.f8) a[kk] = __builtin_nontemporal_load((const f32x4*)(cur.s + (size_t)kk * cur.spitch));
        }
        for (; it < last; ) {
            LAS unsigned char* T = F.lds + buf * 65536;
            int tk = 0; if (DYN && tid == 0) tk = first + (int)__hip_atomic_fetch_add(q, 1u, __ATOMIC_RELAXED, __HIP_MEMORY_SCOPE_AGENT);
            const int c0 = 2 * wave, sw = lane & 15;
            if (cur.f8) {
#pragma unroll
                for (int j = 0; j < 4; ++j) { v4u o0, o1;
                    o0.x = pg8::pk4_fp8(a[0][j] * WS8, a[1][j] * WS8, a[2][j] * WS8, a[3][j] * WS8);     o0.y = pg8::pk4_fp8(a[4][j] * WS8, a[5][j] * WS8, a[6][j] * WS8, a[7][j] * WS8);
                    o0.z = pg8::pk4_fp8(a[8][j] * WS8, a[9][j] * WS8, a[10][j] * WS8, a[11][j] * WS8);   o0.w = pg8::pk4_fp8(a[12][j] * WS8, a[13][j] * WS8, a[14][j] * WS8, a[15][j] * WS8);
                    o1.x = pg8::pk4_fp8(a[16][j] * WS8, a[17][j] * WS8, a[18][j] * WS8, a[19][j] * WS8); o1.y = pg8::pk4_fp8(a[20][j] * WS8, a[21][j] * WS8, a[22][j] * WS8, a[23][j] * WS8);
                    o1.z = pg8::pk4_fp8(a[24][j] * WS8, a[25][j] * WS8, a[26][j] * WS8, a[27][j] * WS8); o1.w = pg8::pk4_fp8(a[28][j] * WS8, a[29][j] * WS8, a[30][j] * WS8, a[31][j] * WS8);
                    *(LAS v4u*)(T + (nl + j) * 256 + ((c0 ^ sw) << 4)) = o0; *(LAS v4u*)(T + (nl + j) * 256 + (((c0 + 1) ^ sw) << 4)) = o1; }
            } else {
#pragma unroll
                for (int j = 0; j < 4; ++j) { v4u o0, o1;
                    o0.x = pk2(a[0][j], a[1][j]); o0.y = pk2(a[2][j], a[3][j]); o0.z = pk2(a[4][j], a[5][j]); o0.w = pk2(a[6][j], a[7][j]);
                    o1.x = pk2(a[8][j], a[9][j]); o1.y = pk2(a[10][j], a[11][j]); o1.z = pk2(a[12][j], a[13][j]); o1.w = pk2(a[14][j], a[15][j]);
                    *(LAS v4u*)(T + (nl + j) * 256 + ((c0 ^ sw) << 4)) = o0; *(LAS v4u*)(T + (nl + j) * 256 + (((c0 + 1) ^ sw) << 4)) = o1; }
            }
            const Tile done = cur; const int nx = DYN ? nxt : it + stride;
            if (nx < last) { cur = decode(nx);
#pragma unroll
                for (int kk = 0; kk < 32; ++kk) if (kk < 16 || cur.f8) a[kk] = __builtin_nontemporal_load((const f32x4*)(cur.s + (size_t)kk * cur.spitch)); }
            if (DYN && tid == 0) slot[kq & 1] = tk;
            __syncthreads();
#pragma unroll
            for (int i = 0; i < 8; ++i) { const int row = (tid >> 4) + 32 * i, c = tid & 15;
                const v4u o = *(const LAS v4u*)(T + row * 256 + ((c ^ ((row >> 2) & 15)) << 4));
                __builtin_nontemporal_store(o, (v4u*)(done.d + (size_t)row * done.dpitch + 16 * c)); }
            buf ^= 1;
            if (DYN) { it = nxt; nxt = __builtin_amdgcn_readfirstlane(slot[kq & 1]); ++kq; } else it += stride;
        }
    }
    __syncthreads();
}

__device__ __forceinline__ void p0_prologue(Frame& F, const Args& args) {
    int tid = threadIdx.x; asm volatile("" : "+v"(tid)); const int lane = tid & 63, wave = __builtin_amdgcn_readfirstlane(tid >> 6); (void)lane; (void)wave;
    unsigned char* ws = F.ws;
    {
        LAS float* sC = (LAS float*)(F.lds);
        LAS float* sR = sC + 4096;
        const float* c = args.in[1]; const float* adaw = args.in[2]; const float* adab = args.in[3]; float* MOD = (float*)(ws + WS_MOD);
        bool have = false;
        for (int task = F.bid; task < 256; task += F.G) {
            if (!have) { for (int i = tid; i < 4096; i += 512) { const float cv = c[i]; sC[i] = cv / (1.0f + expf(-cv)); } __syncthreads(); have = true; }
            const int l = task >> 7, n0 = (task & 127) * 96, cq = tid % 24, ks = tid / 24;
            if (ks < 21) {
                const int k0 = ks * 98, k1 = (k0 + 98 < 2048) ? k0 + 98 : 2048;
                const float* W = adaw + (size_t)l * 2048 * 12288 + n0 + 4 * cq;
                f32x4 a0 = {0.f, 0.f, 0.f, 0.f}, a1 = {0.f, 0.f, 0.f, 0.f};
#pragma unroll 7
                for (int k = k0; k < k1; ++k) { const f32x4 w = __builtin_nontemporal_load((const f32x4*)(W + (size_t)k * 12288)); a0 += sC[k] * w; a1 += sC[2048 + k] * w; }
#pragma unroll
                for (int j = 0; j < 4; ++j) { sR[(ks * 2 + 0) * 96 + 4 * cq + j] = a0[j]; sR[(ks * 2 + 1) * 96 + 4 * cq + j] = a1[j]; }
            }
            __syncthreads();
            if (tid < 192) { const int b = tid / 96, n = tid % 96; float s = 0.f;
#pragma unroll
                for (int k2 = 0; k2 < 21; ++k2) s += sR[(k2 * 2 + b) * 96 + n];
                __hip_atomic_store((gu32*)(MOD + (size_t)(l * 2 + b) * 12288 + n0 + n), __float_as_uint(s + adab[l * 12288 + n0 + n]), RLX_AGENT); }
            __syncthreads();
        }
        __syncthreads();
    }
    {
        const float* win = args.in[7]; const float* rw = args.in[20]; float* GWT = (float*)(ws + WS_GWT); float* RWT = (float*)(ws + WS_RWT);
        for (int i = F.bid * 512 + tid; i < 16384; i += F.G * 512) { const int g = i >> 11, k = i & 2047; __hip_atomic_store((gu32*)(GWT + i), __float_as_uint(win[(size_t)k * DINS + 4096 + g]), RLX_AGENT); RWT[i] = rw[k * 8 + g]; }
    }
    asm volatile("s_waitcnt vmcnt(0)" ::: "memory");
    __syncthreads();
    if (tid == 0) __hip_atomic_fetch_add(F.ctl + CW_P0PUB, 1u, RLX_AGENT);
    const int cv0 = (F.G == 256 ? P0_TILE0 : 0) + F.bid;
    convert_tiles(F, args, cv0, cv0 + 2 * F.G < NT_ALL - QCVT_N ? cv0 + 2 * F.G : NT_ALL - QCVT_N, F.G);
}

template <int MODE, bool X16, bool OUT8 = false>
__device__ __forceinline__ void norm_phase(Frame& F, const void* xin, const float* gain, const float* modl, int sh_off, int sc_off, bf16* HN,
                                           const float* tab, const float* bias8, float* gates_out, unsigned* tokinfo, gu32* cnt) {
    int tid = threadIdx.x; asm volatile("" : "+v"(tid)); const int lane = tid & 63, wave = __builtin_amdgcn_readfirstlane(tid >> 6); (void)lane; (void)wave;
    LAS float* sT = (LAS float*)(F.lds);
    if (MODE != 1) { for (int i = tid; i < 16384; i += 512) sT[i] = tab[i]; __syncthreads(); }
    const int gw = F.bid * NWAVES + wave, NGW = F.G * NWAVES;
    for (int t0 = gw * 4; t0 < NTOK; t0 += NGW * 4) {
        const int b = t0 >> 12;
        f32x4 ga[8], sb[8];
#pragma unroll
        for (int j = 0; j < 8; ++j) { const int col = 4 * (lane + 64 * j);
            const f32x4 g = *(const f32x4*)(gain + col), sc = *(const f32x4*)(modl + (size_t)b * 12288 + sc_off + col);
            ga[j] = g * (sc + 1.0f); sb[j] = *(const f32x4*)(modl + (size_t)b * 12288 + sh_off + col); }
        v2u xw4[4][8]; (void)xw4;
        if (X16) {
#pragma unroll
            for (int i = 0; i < 4; ++i)
#pragma unroll
                for (int j = 0; j < 8; ++j) xw4[i][j] = *(const v2u*)((const bf16*)xin + (size_t)(t0 + i) * DM + 4 * (lane + 64 * j)); }
#pragma unroll
        for (int i = 0; i < 4; ++i) {
            const int t = t0 + i;
            f32x4 v[8]; float ss = 0.f;
#pragma unroll
            for (int j = 0; j < 8; ++j) {
                if (X16) { const v2u w = xw4[i][j]; v[j] = (f32x4){bflo(w.x), bfhi(w.x), bflo(w.y), bfhi(w.y)}; }
                else v[j] = *(const f32x4*)((const float*)xin + (size_t)t * DM + 4 * (lane + 64 * j));
                ss += dot4(v[j], v[j]); }
            ss = wave_sum(ss);
            const float r = 1.0f / sqrtf(ss * (1.0f / DM) + EPS);
#pragma unroll
            for (int j = 0; j < 8; ++j) { v[j] = v[j] * r * ga[j] + sb[j];
                if (OUT8) *(unsigned*)((unsigned char*)HN + (size_t)t * DM + 4 * (lane + 64 * j)) = pg8::pk4_fp8(v[j].x, v[j].y, v[j].z, v[j].w);
                else { v2u o; o.x = pk2(v[j].x, v[j].y); o.y = pk2(v[j].z, v[j].w);
                *(v2u*)(HN + (size_t)t * DM + 4 * (lane + 64 * j)) = o; } }
            if (MODE != 1) {
                float a8[8];
#pragma unroll
                for (int g = 0; g < 8; ++g) { float s = 0.f;
#pragma unroll
                    for (int j = 0; j < 8; ++j) { const f32x4 tv = *(const LAS f32x4*)(sT + g * 2048 + 4 * (lane + 64 * j)); s += dot4(v[j], tv); }
                    a8[g] = wave_sum(s); }
                if (MODE == 0) {
                    if (lane == 0) {
                        f32x4 o0 = {a8[0] + bias8[0], a8[1] + bias8[1], a8[2] + bias8[2], a8[3] + bias8[3]}, o1 = {a8[4] + bias8[4], a8[5] + bias8[5], a8[6] + bias8[6], a8[7] + bias8[7]};
                        *(f32x4*)(gates_out + (size_t)t * 8) = o0; *(f32x4*)(gates_out + (size_t)t * 8 + 4) = o1; }
                } else {
                    if (lane == 0) {
                        int e0 = 0; float v0 = a8[0];
#pragma unroll
                        for (int g = 1; g < 8; ++g) if (a8[g] > v0) { v0 = a8[g]; e0 = g; }
                        int e1 = -1; float v1 = -3.0e38f;
#pragma unroll
                        for (int g = 0; g < 8; ++g) if (g != e0 && a8[g] > v1) { v1 = a8[g]; e1 = g; }
                        const float ex = expf(v1 - v0), g0 = 1.0f / (1.0f + ex), g1 = ex / (1.0f + ex);
                        const unsigned p0 = __hip_atomic_fetch_add(cnt + 64 * e0, 1u, RLX_AGENT), p1 = __hip_atomic_fetch_add(cnt + 64 * e1, 1u, RLX_AGENT);
                        v4u w0; w0.x = (unsigned)e0; w0.y = (unsigned)e1; w0.z = p0; w0.w = p1;
                        v4u w1; w1.x = __float_as_uint(g0); w1.y = __float_as_uint(g1); w1.z = 0u; w1.w = 0u;
                        *(v4u*)(tokinfo + (size_t)t * 8) = w0; *(v4u*)(tokinfo + (size_t)t * 8 + 4) = w1; }
                }
            }
        }
    }
    if (MODE != 1) __syncthreads();
}

template <int W>
__device__ __forceinline__ void pool_rows(const bf16* __restrict__ PROJ, bf16* __restrict__ POOLED, int tb, int posb, int col) {
    float h0[W - 1], h1[W - 1];
#pragma unroll
    for (int j = 0; j < W - 1; ++j) { const bool in = posb - 1 - j >= 0; const unsigned rr = *(const unsigned*)(PROJ + (size_t)(in ? tb - 1 - j : tb) * DINP + 4096 + col); const unsigned r = in ? rr : 0u; h0[j] = bflo(r); h1[j] = bfhi(r); }
    for (int i8 = 0; i8 < 32; i8 += 8) {
        unsigned r8[8];
#pragma unroll
        for (int ii = 0; ii < 8; ++ii) r8[ii] = *(const unsigned*)(PROJ + (size_t)(tb + i8 + ii) * DINP + 4096 + col);
#pragma unroll
        for (int ii = 0; ii < 8; ++ii) {
            const int t = tb + i8 + ii, pos = posb + i8 + ii, cnt = (pos + 1 < W) ? pos + 1 : W;
            const float x0 = bflo(r8[ii]), x1 = bfhi(r8[ii]);
            float s0 = x0, s1 = x1;
#pragma unroll
            for (int j = 0; j < W - 1; ++j) { s0 += h0[j]; s1 += h1[j]; }
            const float ic = __builtin_amdgcn_rcpf((float)cnt);
            *(unsigned*)(POOLED + (size_t)t * 1024 + col) = pk2(s0 * ic - x0, s1 * ic - x1);
#pragma unroll
            for (int j = W - 2; j > 0; --j) { h0[j] = h0[j - 1]; h1[j] = h1[j - 1]; }
            h0[0] = x0; h1[0] = x1;
        }
    }
}
__device__ __forceinline__ void prep_phase(Frame& F, const Args& args) {
    int tid = threadIdx.x; asm volatile("" : "+v"(tid)); const int lane = tid & 63, wave = __builtin_amdgcn_readfirstlane(tid >> 6);
    unsigned char* ws = F.ws;
    const bf16* __restrict__ PROJ = (const bf16*)(ws + WS_PROJ); const float* __restrict__ GATES = (const float*)(ws + WS_GATES);
    float* __restrict__ BCUM = (float*)(ws + WS_BCUM); float* __restrict__ IG = (float*)(ws + WS_IG); float* __restrict__ GTOT = (float*)(ws + WS_GTOT); float* __restrict__ DN = (float*)(ws + WS_DN);
    bf16* __restrict__ QB = (bf16*)(ws + WS_QB); bf16* __restrict__ KB = (bf16*)(ws + WS_KB); bf16* __restrict__ KWT = (bf16*)(ws + WS_KWT); bf16* __restrict__ AP = (bf16*)(ws + WS_AP); bf16* __restrict__ BP = (bf16*)(ws + WS_BP);
    bf16* __restrict__ POOLED = (bf16*)(ws + WS_POOLED);
    const float* __restrict__ convw = args.in[9]; const float* __restrict__ convb = args.in[10];
    LAS float* sB = (LAS float*)(F.lds); LAS float* sI = sB + 256; LAS float* sW = sI + 256;
    LAS unsigned* TK = (LAS unsigned*)(F.lds + 4096); LAS unsigned* TV = TK + 128 * 129;
    for (int task = F.bid; task < 2 * NUNIT; task += F.G) {
        const int u = task >> 1, half = task & 1, b = u >> 6, h = (u >> 4) & 3, c = u & 15, t0 = b * SEQ + c * 256;
        float sc = 0.f, ir = 0.f;
        if (tid < 256) { const float fr = GATES[(size_t)(t0 + tid) * 8 + 4 + h]; ir = GATES[(size_t)(t0 + tid) * 8 + h]; sc = logsig(fr);
#pragma unroll
            for (int o = 1; o < 64; o <<= 1) { const float y = __shfl_up(sc, o); if (lane >= o) sc += y; }
            sI[tid] = ir; if (lane == 63) sW[wave] = sc; }
        __syncthreads();
        if (tid < 256) { for (int w2 = 0; w2 < wave; ++w2) sc += sW[w2]; sB[tid] = sc; if (half == 0) { BCUM[u * 256 + tid] = sc; IG[u * 256 + tid] = ir; } }
        __syncthreads();
        const float Gt = sB[255];
        if (half == 0 && tid == 0) GTOT[u] = Gt;
        {
            const int cp = tid & 63, tg = tid >> 6, dc = half * 128 + 2 * cp, chq = h * 256 + dc, chk = 1024 + h * 256 + dc, chv = 2048 + h * 256 + dc;
            float wq[4][2], wk[4][2], bq[2], bk[2];
#pragma unroll
            for (int j = 0; j < 4; ++j) { wq[j][0] = convw[j * 2048 + chq]; wq[j][1] = convw[j * 2048 + chq + 1]; wk[j][0] = convw[j * 2048 + chk]; wk[j][1] = convw[j * 2048 + chk + 1]; }
            bq[0] = convb[chq]; bq[1] = convb[chq + 1]; bk[0] = convb[chk]; bk[1] = convb[chk + 1];
            const int tl0 = tg * 32, pos0 = c * 256 + tl0;
            float xq[3][2], xk[3][2];
#pragma unroll
            for (int jj = 0; jj < 3; ++jj) { const int p = pos0 - 3 + jj; unsigned rq = 0u, rk = 0u;
                if (p >= 0) { const bf16* row = PROJ + (size_t)(b * SEQ + p) * DINP; rq = *(const unsigned*)(row + chq); rk = *(const unsigned*)(row + chk); }
                xq[jj][0] = bflo(rq); xq[jj][1] = bfhi(rq); xk[jj][0] = bflo(rk); xk[jj][1] = bfhi(rk); }
            for (int i8 = 0; i8 < 32; i8 += 8) {
                unsigned rq8[8], rk8[8], rv8[8];
#pragma unroll
                for (int ii = 0; ii < 8; ++ii) { const bf16* row = PROJ + (size_t)(t0 + tl0 + i8 + ii) * DINP; rq8[ii] = *(const unsigned*)(row + chq); rk8[ii] = *(const unsigned*)(row + chk); rv8[ii] = *(const unsigned*)(row + chv); }
                float pkw0 = 0.f, pkw1 = 0.f, pv0 = 0.f, pv1 = 0.f;
#pragma unroll
                for (int ii = 0; ii < 8; ++ii) {
                    const int tl = tl0 + i8 + ii; const unsigned rq = rq8[ii], rk = rk8[ii], rv = rv8[ii];
                    const float cq0 = bflo(rq), cq1 = bfhi(rq), ck0 = bflo(rk), ck1 = bfhi(rk);
                    const float yq0 = bq[0] + wq[0][0] * xq[0][0] + wq[1][0] * xq[1][0] + wq[2][0] * xq[2][0] + wq[3][0] * cq0;
                    const float yq1 = bq[1] + wq[0][1] * xq[0][1] + wq[1][1] * xq[1][1] + wq[2][1] * xq[2][1] + wq[3][1] * cq1;
                    const float yk0 = bk[0] + wk[0][0] * xk[0][0] + wk[1][0] * xk[1][0] + wk[2][0] * xk[2][0] + wk[3][0] * ck0;
                    const float yk1 = bk[1] + wk[0][1] * xk[0][1] + wk[1][1] * xk[1][1] + wk[2][1] * xk[2][1] + wk[3][1] * ck1;
                    xq[0][0] = xq[1][0]; xq[1][0] = xq[2][0]; xq[2][0] = cq0; xq[0][1] = xq[1][1]; xq[1][1] = xq[2][1]; xq[2][1] = cq1;
                    xk[0][0] = xk[1][0]; xk[1][0] = xk[2][0]; xk[2][0] = ck0; xk[0][1] = xk[1][1]; xk[1][1] = xk[2][1]; xk[2][1] = ck1;
                    const float q0 = yq0 * __builtin_amdgcn_rcpf(1.0f + __expf(-yq0)) * 0.0625f, q1 = yq1 * __builtin_amdgcn_rcpf(1.0f + __expf(-yq1)) * 0.0625f;
                    const float k0 = yk0 * __builtin_amdgcn_rcpf(1.0f + __expf(-yk0)), k1 = yk1 * __builtin_amdgcn_rcpf(1.0f + __expf(-yk1));
                    const float bt = sB[tl], it = sI[tl], eb = __expf(bt), kwf = __expf(Gt - bt + it);
                    const size_t ro = (size_t)u * 256 + tl;
                    *(unsigned*)(QB + ro * 256 + dc) = pk2(q0, q1);
                    *(unsigned*)(AP + ro * 512 + dc) = pk2(eb * q0, eb * q1);
                    *(unsigned*)(KB + ro * 256 + dc) = pk2(k0, k1);
                    const float kw0 = kwf * k0, kw1 = kwf * k1, v0 = bflo(rv), v1 = bfhi(rv);
                    if (ii & 1) { TK[(2 * cp) * 129 + (tl >> 1)] = pk2(pkw0, kw0); TK[(2 * cp + 1) * 129 + (tl >> 1)] = pk2(pkw1, kw1);
                                  TV[(2 * cp) * 129 + (tl >> 1)] = pk2(pv0, v0);   TV[(2 * cp + 1) * 129 + (tl >> 1)] = pk2(pv1, v1); }
                    else { pkw0 = kw0; pkw1 = kw1; pv0 = v0; pv1 = v1; }
                }
            }
        }
        __syncthreads();
        for (int idx = tid; idx < 128 * 32; idx += 512) { const int dl = idx >> 5, ch = idx & 31;
            v4u o; o.x = TK[dl * 129 + 4 * ch]; o.y = TK[dl * 129 + 4 * ch + 1]; o.z = TK[dl * 129 + 4 * ch + 2]; o.w = TK[dl * 129 + 4 * ch + 3];
            *(v4u*)(KWT + ((size_t)u * 256 + half * 128 + dl) * 256 + 8 * ch) = o;
            o.x = TV[dl * 129 + 4 * ch]; o.y = TV[dl * 129 + 4 * ch + 1]; o.z = TV[dl * 129 + 4 * ch + 2]; o.w = TV[dl * 129 + 4 * ch + 3];
            *(v4u*)(BP + ((size_t)u * 256 + half * 128 + dl) * 512 + 256 + 8 * ch) = o; }
        if (tid < 128) { float s = 0.f; for (int w2 = 0; w2 < 128; ++w2) { const unsigned p = TK[tid * 129 + w2]; s += bflo(p) + bfhi(p); } DN[u * 256 + half * 128 + tid] = s; }
        __syncthreads();
    }
    for (int pb = F.bid; pb < NTOK / 32; pb += F.G) {
        const int col = 2 * tid, g = __builtin_amdgcn_readfirstlane(col >> 8), tb = pb * 32, posb = tb & (SEQ - 1);
        if (g == 0) pool_rows<2>(PROJ, POOLED, tb, posb, col); else if (g == 1) pool_rows<4>(PROJ, POOLED, tb, posb, col);
        else if (g == 2) pool_rows<8>(PROJ, POOLED, tb, posb, col); else pool_rows<16>(PROJ, POOLED, tb, posb, col);
    }
}

__device__ __forceinline__ void scan_phase(Frame& F) {
    int tid = threadIdx.x; asm volatile("" : "+v"(tid)); const int lane = tid & 63, wave = __builtin_amdgcn_readfirstlane(tid >> 6); (void)lane; (void)wave;
    unsigned char* ws = F.ws;
    const float* DCT = (const float*)(ws + WS_DCT); const float* GTOT = (const float*)(ws + WS_GTOT); const float* DN = (const float*)(ws + WS_DN);
    bf16* BP = (bf16*)(ws + WS_BP); float* NVEC = (float*)(ws + WS_NVEC);
    for (int eg = F.bid * 512 + tid; eg < 8 * 16384; eg += F.G * 512) {
        const int bh = eg >> 14, rem = eg & 16383, e = rem >> 6, d4 = (rem & 63) * 4;
        f32x4 C = {0.f, 0.f, 0.f, 0.f};
        for (int c = 0; c < 16; ++c) { const int u = bh * 16 + c;
            v2u o; o.x = pk2(C.x, C.y); o.y = pk2(C.z, C.w);
            *(v2u*)(BP + ((size_t)u * 256 + e) * 512 + d4) = o;
            const f32x4 d = *(const f32x4*)(DCT + ((size_t)u * 256 + e) * 256 + d4);
            C = C * __expf(GTOT[u]) + d; }
    }
    for (int id = F.bid * 512 + tid; id < 2048; id += F.G * 512) {
        const int bh = id >> 8, d = id & 255; float n = 0.f;
        for (int c = 0; c < 16; ++c) { const int u = bh * 16 + c; NVEC[u * 256 + d] = n; n = n * __expf(GTOT[u]) + DN[u * 256 + d]; }
    }
}

typedef float f32x16 __attribute__((ext_vector_type(16)));
typedef short s16x8 __attribute__((ext_vector_type(8)));
typedef float f32x2_t __attribute__((ext_vector_type(2))); typedef __bf16 bf16x2_t __attribute__((ext_vector_type(2)));
__device__ __forceinline__ unsigned cvtpk_s(float lo, float hi) { f32x2_t v = {lo, hi}; bf16x2_t b = __builtin_convertvector(v, bf16x2_t); return __builtin_bit_cast(unsigned, b); }
__device__ __forceinline__ void attn_phase(Frame& F) {
    int tid = threadIdx.x; asm volatile("" : "+v"(tid)); const int lane = tid & 63, wave = __builtin_amdgcn_readfirstlane(tid >> 6);
    unsigned char* ws = F.ws;
    const bf16* QB = (const bf16*)(ws + WS_QB2); const bf16* KB = (const bf16*)(ws + WS_KB2); const bf16* VT = (const bf16*)(ws + WS_VT);
    bf16* ATTO = (bf16*)(ws + WS_ATTO);
    const int gw = F.bid * NWAVES + wave, NGW = F.G * NWAVES;
    const int r = lane & 31, hlf = lane >> 5;
    for (int p = gw; p < 4096; p += NGW) {
        const int qt = p & 127, hh = (p >> 7) & 15, b = p >> 11, t0 = qt * 32;
        const size_t hb = ((size_t)(b * 16 + hh) * 128) * 4096; const int lo16 = r * 16 + hlf * 8;
        const bf16* qrow = QB + hb + (size_t)qt * 4096 + lo16;
        s16x8 qf[8];
#pragma unroll
        for (int kk = 0; kk < 8; ++kk) qf[kk] = *(const s16x8*)(qrow + 512 * kk);
        f32x16 O[4];
#pragma unroll
        for (int et = 0; et < 4; ++et)
#pragma unroll
            for (int i = 0; i < 16; ++i) O[et][i] = 0.f;
        float R = 1.0f;
        s16x8 kf[8];
        { const bf16* krow = KB + hb + (size_t)qt * 4096 + lo16;
#pragma unroll
          for (int kk = 0; kk < 8; ++kk) kf[kk] = *(const s16x8*)(krow + 512 * kk); }
        for (int s0 = t0; ; s0 -= 32) {
            s16x8 vf[8];
            { const bf16* vp = VT + hb + (size_t)(s0 >> 5) * 4096 + lo16;
#pragma unroll
              for (int q = 0; q < 8; ++q) vf[q] = *(const s16x8*)(vp + 512 * q); }
            __builtin_amdgcn_sched_barrier(0);
            f32x16 zt;
#pragma unroll
            for (int i = 0; i < 16; ++i) zt[i] = 0.f;
#pragma unroll
            for (int kk = 0; kk < 8; ++kk) zt = __builtin_amdgcn_mfma_f32_32x32x16_bf16(kf[kk], qf[kk], zt, 0, 0, 0);
            __builtin_amdgcn_sched_barrier(0);
            { const int sn = (s0 >= 32) ? s0 - 32 : s0;
              const bf16* krow = KB + hb + (size_t)(sn >> 5) * 4096 + lo16;
#pragma unroll
              for (int kk = 0; kk < 8; ++kk) kf[kk] = *(const s16x8*)(krow + 512 * kk); }
            __builtin_amdgcn_sched_barrier(0);
            const bool diag = (s0 == t0);
            float sg[16], om[16];
            if (diag) {
#pragma unroll
                for (int i = 0; i < 16; ++i) { const int sl = (i & 3) + 8 * (i >> 2) + 4 * hlf;
                    const float s = __builtin_amdgcn_rcpf(1.0f + __builtin_amdgcn_exp2f(-zt[i]));
                    const bool valid = sl < r;
                    sg[i] = valid ? s : 0.f; om[i] = valid ? 1.0f - s : 1.0f; }
            } else {
#pragma unroll
                for (int i = 0; i < 16; ++i) { const float s = __builtin_amdgcn_rcpf(1.0f + __builtin_amdgcn_exp2f(-zt[i])); sg[i] = s; om[i] = 1.0f - s; }
            }
            float Sg[4], Pg[4], tot[4];
#pragma unroll
            for (int g = 0; g < 4; ++g) { Sg[g] = (om[4 * g] * om[4 * g + 1]) * (om[4 * g + 2] * om[4 * g + 3]); Pg[g] = __shfl_xor(Sg[g], 32); tot[g] = Sg[g] * Pg[g]; }
            float after[4]; after[3] = 1.0f; after[2] = tot[3]; after[1] = tot[3] * tot[2]; after[0] = (tot[3] * tot[2]) * tot[1];
            const float T = ((tot[3] * tot[2]) * tot[1]) * tot[0];
            float A[16];
#pragma unroll
            for (int g = 0; g < 4; ++g) { float run = R * after[g] * (hlf == 0 ? Pg[g] : 1.0f);
#pragma unroll
                for (int w = 3; w >= 0; --w) { const int i = 4 * g + w; A[i] = sg[i] * run; run *= om[i]; } }
            R *= T;
#pragma unroll
            for (int sp = 0; sp < 2; ++sp) {
                v4u xa; xa.x = cvtpk_s(A[8 * sp], A[8 * sp + 1]); xa.y = cvtpk_s(A[8 * sp + 2], A[8 * sp + 3]); xa.z = cvtpk_s(A[8 * sp + 4], A[8 * sp + 5]); xa.w = cvtpk_s(A[8 * sp + 6], A[8 * sp + 7]);
                const s16x8 xf = __builtin_bit_cast(s16x8, xa);
#pragma unroll
                for (int et = 0; et < 4; ++et) {
                    O[et] = __builtin_amdgcn_mfma_f32_32x32x16_bf16(xf, vf[sp * 4 + et], O[et], 0, 0, 0);
                }
            }
            if (s0 == 0 || __all(R == 0.f)) break;
        }
        { LAS unsigned char* ot = F.lds + wave * 8704;
#pragma unroll
          for (int et = 0; et < 4; ++et)
#pragma unroll
              for (int i = 0; i < 16; ++i) { const int tr = (i & 3) + 8 * (i >> 2) + 4 * hlf;
                  *(LAS bf16*)(ot + tr * 272 + (32 * et + r) * 2) = (bf16)(cvtpk_s(O[et][i], 0.f) & 0xffffu); }
          LDS_WAIT();
#pragma unroll
          for (int q = 0; q < 8; ++q) { const int tr = 4 * q + (lane >> 4), ch = lane & 15;
              const v4u o = *(const LAS v4u*)(ot + tr * 272 + 16 * ch);
              *(v4u*)(ATTO + (size_t)(b * SEQ + t0 + tr) * DM + hh * 128 + 8 * ch) = o; }
          LDS_WAIT(); }
    }
}

__device__ __forceinline__ void moe_bases(const gu32* cnt, int (&base)[8], int (&cn)[8]) {
    int acc = 0;
#pragma unroll
    for (int e = 0; e < 8; ++e) { cn[e] = (int)__hip_atomic_load(cnt + 64 * e, RLX_AGENT); base[e] = acc; acc += (cn[e] + 255) & ~255; }
}
__device__ __forceinline__ void gather_phase(Frame& F) {
    int tid = threadIdx.x; asm volatile("" : "+v"(tid)); const int lane = tid & 63, wave = __builtin_amdgcn_readfirstlane(tid >> 6);
    unsigned char* ws = F.ws;
    const unsigned* TOKINFO = (const unsigned*)(ws + WS_TOKINFO); int* TOKSLOT = (int*)(ws + WS_TOKSLOT); float* SLOTGATE = (float*)(ws + WS_SLOTGATE);
    const bf16* HN = (const bf16*)(ws + WS_HN); unsigned char* HPERM = ws + WS_HPERM;
    int base[8], cn[8]; moe_bases(F.ctl + CW_CNT, base, cn);
    const int gw = F.bid * NWAVES + wave, NGW = F.G * NWAVES;
    for (int p0 = gw * 4; p0 < NTOK; p0 += NGW * 4) {
        v4u w0[4], w1[4];
#pragma unroll
        for (int i = 0; i < 4; ++i) { w0[i] = *(const v4u*)(TOKINFO + (size_t)(p0 + i) * 8); w1[i] = *(const v4u*)(TOKINFO + (size_t)(p0 + i) * 8 + 4); }
        v4u v[4][4];
#pragma unroll
        for (int i = 0; i < 4; ++i) { const v4u* src = (const v4u*)(HN + (size_t)(p0 + i) * DM);
#pragma unroll
            for (int j = 0; j < 4; ++j) v[i][j] = src[lane + 64 * j]; }
#pragma unroll
        for (int i = 0; i < 4; ++i) {
            int b0 = 0, b1 = 0;
#pragma unroll
            for (int e = 0; e < 8; ++e) { b0 = ((int)w0[i].x == e) ? base[e] : b0; b1 = ((int)w0[i].y == e) ? base[e] : b1; }
            const int s0 = b0 + (int)w0[i].z, s1 = b1 + (int)w0[i].w;
            v2u* d0 = (v2u*)(HPERM + (size_t)s0 * DM); v2u* d1 = (v2u*)(HPERM + (size_t)s1 * DM);
#pragma unroll
            for (int j = 0; j < 4; ++j) { const v4u x = v[i][j];
                v2u o; o.x = pg8::pk4_fp8(bflo(x.x), bfhi(x.x), bflo(x.y), bfhi(x.y)); o.y = pg8::pk4_fp8(bflo(x.z), bfhi(x.z), bflo(x.w), bfhi(x.w));
                d0[lane + 64 * j] = o; d1[lane + 64 * j] = o; }
            if (lane == 0) { TOKSLOT[(p0 + i) * 2] = s0; TOKSLOT[(p0 + i) * 2 + 1] = s1; SLOTGATE[s0] = __uint_as_float(w1[i].x); SLOTGATE[s1] = __uint_as_float(w1[i].y); }
        }
    }
    for (int q = gw; q < 2048; q += NGW) {
        const int e = q >> 8, r = q & 255;
        int be = 0, ce = 0;
#pragma unroll
        for (int k = 0; k < 8; ++k) { be = (e == k) ? base[k] : be; ce = (e == k) ? cn[k] : ce; }
        if ((ce & 255) != 0 && r >= (ce & 255)) { const int row = be + (ce & ~255) + r; v4u* d = (v4u*)(HPERM + (size_t)row * DM); const v4u z = {0u, 0u, 0u, 0u};
#pragma unroll
            for (int j = 0; j < 2; ++j) d[lane + 64 * j] = z;
            if (lane == 0) SLOTGATE[row] = 0.f; }
    }
}

__device__ __forceinline__ void route_phase(Frame& F, const bf16* xin, const float* gain, const float* modl, int sh_off, int sc_off, const float* tab, gu32* cnt, gu32* donec) {
    int tid = threadIdx.x; asm volatile("" : "+v"(tid)); const int lane = tid & 63, wave = __builtin_amdgcn_readfirstlane(tid >> 6);
    unsigned char* ws = F.ws;
    int* TOKSLOT = (int*)(ws + WS_TOKSLOT); float* SLOTGATE = (float*)(ws + WS_SLOTGATE); unsigned char* HPERM = ws + WS_HPERM;
    LAS float* sT = (LAS float*)(F.lds);
    LAS unsigned* lcnt = (LAS unsigned*)(F.lds + 65536 + 16384);
    for (int i = tid; i < 16384; i += 512) sT[i] = tab[i];
    if (tid < 16) lcnt[tid] = 0u;
    __syncthreads();
    const int gw = F.bid * NWAVES + wave, NGW = F.G * NWAVES, t0 = gw * 4;
    unsigned rowq[4][8]; int e0[4], e1[4]; unsigned p0[4], p1[4]; float g0[4], g1[4];
    if (t0 < NTOK) {
        const int b = t0 >> 12;
        f32x4 ga[8], sb[8];
#pragma unroll
        for (int j = 0; j < 8; ++j) { const int col = 4 * (lane + 64 * j);
            const f32x4 g = *(const f32x4*)(gain + col), sc = *(const f32x4*)(modl + (size_t)b * 12288 + sc_off + col);
            ga[j] = g * (sc + 1.0f); sb[j] = *(const f32x4*)(modl + (size_t)b * 12288 + sh_off + col); }
#pragma unroll
        for (int i = 0; i < 4; ++i) {
            const int t = t0 + i;
            f32x4 v[8]; float ss = 0.f;
#pragma unroll
            for (int j = 0; j < 8; ++j) { const v2u w = *(const v2u*)(xin + (size_t)t * DM + 4 * (lane + 64 * j)); v[j] = (f32x4){bflo(w.x), bfhi(w.x), bflo(w.y), bfhi(w.y)}; ss += dot4(v[j], v[j]); }
            ss = wave_sum(ss);
            const float r = 1.0f / sqrtf(ss * (1.0f / DM) + EPS);
#pragma unroll
            for (int j = 0; j < 8; ++j) { v[j] = v[j] * r * ga[j] + sb[j]; rowq[i][j] = pg8::pk4_fp8(v[j].x, v[j].y, v[j].z, v[j].w); }
            float a8[8]; int zi; asm volatile("v_mov_b32 %0, 0" : "=v"(zi));
#pragma unroll
            for (int g = 0; g < 8; ++g) { float s = 0.f;
#pragma unroll
                for (int j = 0; j < 8; ++j) { const f32x4 tv = *(const LAS f32x4*)(sT + g * 2048 + 4 * (lane + 64 * j) + zi); s += dot4(v[j], tv); }
                a8[g] = wave_sum(s); }
            int ea = 0; float va = a8[0];
#pragma unroll
            for (int g = 1; g < 8; ++g) if (a8[g] > va) { va = a8[g]; ea = g; }
            int eb = -1; float vb = -3.0e38f;
#pragma unroll
            for (int g = 0; g < 8; ++g) if (g != ea && a8[g] > vb) { vb = a8[g]; eb = g; }
            ea = __builtin_amdgcn_readfirstlane(ea); eb = __builtin_amdgcn_readfirstlane(eb);
            const float ex = expf(vb - va); g0[i] = 1.0f / (1.0f + ex); g1[i] = ex / (1.0f + ex);
            unsigned pa = 0u, pb = 0u;
            if (lane == 0) { pa = __hip_atomic_fetch_add((LAS unsigned*)(lcnt + ea), 1u, __ATOMIC_RELAXED, __HIP_MEMORY_SCOPE_WORKGROUP); pb = __hip_atomic_fetch_add((LAS unsigned*)(lcnt + eb), 1u, __ATOMIC_RELAXED, __HIP_MEMORY_SCOPE_WORKGROUP); }
            e0[i] = ea; e1[i] = eb; p0[i] = (unsigned)__builtin_amdgcn_readfirstlane((int)pa); p1[i] = (unsigned)__builtin_amdgcn_readfirstlane((int)pb);
        }
    }
    asm volatile("s_waitcnt vmcnt(0) lgkmcnt(0)" ::: "memory");
    __syncthreads();
    if (tid < 8) { const unsigned n = lcnt[tid]; lcnt[8 + tid] = n ? __hip_atomic_fetch_add(cnt + 64 * tid, n, RLX_AGENT) : 0u; }
    asm volatile("s_waitcnt vmcnt(0) lgkmcnt(0)" ::: "memory");
    __syncthreads();
    if (tid == 0) { __hip_atomic_fetch_add(donec, 1u, RLX_AGENT);
        unsigned sp = 0; while (__hip_atomic_load(donec, RLX_AGENT) < (unsigned)F.G) { __builtin_amdgcn_s_sleep(1); if (++sp > (1u << 22)) break; } }
    __syncthreads();
    int base[8], cn[8]; moe_bases(cnt, base, cn);
    LAS unsigned char* stg = F.lds + 65536 + wave * 2048;
    if (t0 < NTOK) {
#pragma unroll
        for (int i = 0; i < 4; ++i) {
            int b0 = 0, b1 = 0;
#pragma unroll
            for (int e = 0; e < 8; ++e) { b0 = (e0[i] == e) ? base[e] : b0; b1 = (e1[i] == e) ? base[e] : b1; }
            const int s0 = b0 + (int)(lcnt[8 + e0[i]] + p0[i]), s1 = b1 + (int)(lcnt[8 + e1[i]] + p1[i]);
#pragma unroll
            for (int j = 0; j < 8; ++j) *(LAS unsigned*)(stg + 4 * (lane + 64 * j)) = rowq[i][j];
            LDS_WAIT();
            const v4u o0 = *(const LAS v4u*)(stg + 32 * lane), o1 = *(const LAS v4u*)(stg + 32 * lane + 16);
            LDS_WAIT();
            v4u* d0 = (v4u*)(HPERM + (size_t)s0 * DM + 32 * lane); v4u* d1 = (v4u*)(HPERM + (size_t)s1 * DM + 32 * lane);
            d0[0] = o0; d0[1] = o1; d1[0] = o0; d1[1] = o1;
            if (lane == 0) { TOKSLOT[(t0 + i) * 2] = s0; TOKSLOT[(t0 + i) * 2 + 1] = s1; SLOTGATE[s0] = g0[i]; SLOTGATE[s1] = g1[i]; }
        }
    }
    for (int q = gw; q < 2048; q += NGW) {
        const int e = q >> 8, r = q & 255;
        int be = 0, ce = 0;
#pragma unroll
        for (int k = 0; k < 8; ++k) { be = (e == k) ? base[k] : be; ce = (e == k) ? cn[k] : ce; }
        if ((ce & 255) != 0 && r >= (ce & 255)) { const int row = be + (ce & ~255) + r; v4u* d = (v4u*)(HPERM + (size_t)row * DM); const v4u z = {0u, 0u, 0u, 0u};
#pragma unroll
            for (int j = 0; j < 2; ++j) d[lane + 64 * j] = z;
            if (lane == 0) SLOTGATE[row] = 0.f; }
    }
    __syncthreads();
}

__device__ __forceinline__ void final_phase(Frame& F, const Args& args) {
    int tid = threadIdx.x; asm volatile("" : "+v"(tid)); const int lane = tid & 63, wave = __builtin_amdgcn_readfirstlane(tid >> 6); (void)lane; (void)wave;
    unsigned char* ws = F.ws;
    const bf16* XR = (const bf16*)(ws + WS_XR); const bf16* Y = (const bf16*)(ws + WS_Y); const bf16* YP = (const bf16*)(ws + WS_YP); const int* TOKSLOT = (const int*)(ws + WS_TOKSLOT);
    const float* g2 = (const float*)(ws + WS_MOD) + (size_t)2 * 12288 + 10240; const float* gfin = args.in[6]; float* out = args.out;
    const int gw = F.bid * NWAVES + wave, NGW = F.G * NWAVES;
    for (int t = gw; t < NTOK; t += NGW) {
        const int b = t >> 12, s0 = __builtin_amdgcn_readfirstlane(TOKSLOT[t * 2]), s1 = __builtin_amdgcn_readfirstlane(TOKSLOT[t * 2 + 1]);
        f32x4 v[8]; float ss = 0.f;
        if (s0 < 16384 && s1 < 16384) {
            v2u xw[8], y0[8], y1[8]; f32x4 g[8];
#pragma unroll
            for (int j = 0; j < 8; ++j) { const int col = 4 * (lane + 64 * j);
                xw[j] = *(const v2u*)(XR + (size_t)t * DM + col); g[j] = *(const f32x4*)(g2 + (size_t)b * 12288 + col);
                y0[j] = *(const v2u*)(Y + (size_t)s0 * DM + col); y1[j] = *(const v2u*)(Y + (size_t)s1 * DM + col); }
#pragma unroll
            for (int j = 0; j < 8; ++j) { const f32x4 x = {bflo(xw[j].x), bfhi(xw[j].x), bflo(xw[j].y), bfhi(xw[j].y)};
                f32x4 ys = {0.f, 0.f, 0.f, 0.f};
                ys.x += bflo(y0[j].x); ys.y += bfhi(y0[j].x); ys.z += bflo(y0[j].y); ys.w += bfhi(y0[j].y);
                ys.x += bflo(y1[j].x); ys.y += bfhi(y1[j].x); ys.z += bflo(y1[j].y); ys.w += bfhi(y1[j].y);
                v[j] = x + g[j] * ys; ss += dot4(v[j], v[j]); }
        } else {
            const bf16* r0[4]; const bf16* r1[4]; float w0[4], w1[4];
#pragma unroll
            for (int q = 0; q < 4; ++q) {
                r0[q] = (s0 < 16384) ? Y + (size_t)s0 * DM : YP + ((size_t)q * 1792 + (s0 - 16384)) * DM; w0[q] = (s0 < 16384 && q > 0) ? 0.f : 1.f;
                r1[q] = (s1 < 16384) ? Y + (size_t)s1 * DM : YP + ((size_t)q * 1792 + (s1 - 16384)) * DM; w1[q] = (s1 < 16384 && q > 0) ? 0.f : 1.f; }
#pragma unroll
            for (int jh = 0; jh < 8; jh += 4) {
                v2u xw[4], ya[4][4], yb[4][4]; f32x4 g[4];
#pragma unroll
                for (int jj = 0; jj < 4; ++jj) { const int col = 4 * (lane + 64 * (jh + jj));
                    xw[jj] = *(const v2u*)(XR + (size_t)t * DM + col); g[jj] = *(const f32x4*)(g2 + (size_t)b * 12288 + col);
#pragma unroll
                    for (int q = 0; q < 4; ++q) { ya[jj][q] = *(const v2u*)(r0[q] + col); yb[jj][q] = *(const v2u*)(r1[q] + col); } }
#pragma unroll
                for (int jj = 0; jj < 4; ++jj) { const f32x4 x = {bflo(xw[jj].x), bfhi(xw[jj].x), bflo(xw[jj].y), bfhi(xw[jj].y)};
                    f32x4 ys = {0.f, 0.f, 0.f, 0.f};
#pragma unroll
                    for (int q = 0; q < 4; ++q) {
                        ys.x += w0[q] * bflo(ya[jj][q].x) + w1[q] * bflo(yb[jj][q].x); ys.y += w0[q] * bfhi(ya[jj][q].x) + w1[q] * bfhi(yb[jj][q].x);
                        ys.z += w0[q] * bflo(ya[jj][q].y) + w1[q] * bflo(yb[jj][q].y); ys.w += w0[q] * bfhi(ya[jj][q].y) + w1[q] * bfhi(yb[jj][q].y); }
                    v[jh + jj] = x + g[jj] * ys; ss += dot4(v[jh + jj], v[jh + jj]); }
            }
        }
        ss = wave_sum(ss);
        const float r = 1.0f / sqrtf(ss * (1.0f / DM) + EPS);
#pragma unroll
        for (int j = 0; j < 8; ++j) { const int col = 4 * (lane + 64 * j); const f32x4 g = *(const f32x4*)(gfin + col); *(f32x4*)(out + (size_t)t * DM + col) = v[j] * r * g; }
    }
}

__global__ void __launch_bounds__(NWAVES * 64, 2) hybrid_fwd(Args args) {
    extern __shared__ __attribute__((aligned(16))) unsigned char lds[];
    Frame F;
    F.lds = (LAS unsigned char*)lds;
    F.MISC = (volatile LAS unsigned*)(F.lds + MISC_OFF);
    F.G = gridDim.x; F.bid = blockIdx.x;
    unsigned char* ws = args.ws; F.ws = ws;
    F.ctl = (gu32*)(ws + WS_CTL);
    for (int u = threadIdx.x; u < (LDS_BYTES - LDSCTL_OFF) / 4; u += NWAVES * 64) ((LAS unsigned*)(F.lds + LDSCTL_OFF))[u] = 0u;
    __syncthreads();
    XcdBarrier bar = xcd_barrier_post((unsigned*)(F.ctl + CW_BAR), F.MISC + 8);
#define GRID_BAR() xcd_barrier(bar)
    using namespace pg8;
    PG8_LAS unsigned char* ring = F.lds + RING_OFF;
    const float* MOD = (const float*)(ws + WS_MOD);
    bf16* HN = (bf16*)(ws + WS_HN); bf16* XR = (bf16*)(ws + WS_XR);

#if SKELETON
    for (int k = 0; k < 20; ++k) GRID_BAR();
    for (size_t i = (size_t)F.bid * 512 + threadIdx.x; i < (size_t)NTOK * DM / 4; i += (size_t)F.G * 512) ((f32x4*)args.out)[i] = ((const f32x4*)args.in[0])[i];
#else
    p0_prologue(F, args);
    { int tid = threadIdx.x; asm volatile("" : "+v"(tid));
      if (tid == 0) { unsigned sp = 0; while (__hip_atomic_load(F.ctl + CW_P0PUB, RLX_AGENT) < (unsigned)F.G) { __builtin_amdgcn_s_sleep(1); if (++sp > (1u << 22)) break; }
          __builtin_amdgcn_fence(__ATOMIC_ACQUIRE, "agent"); asm volatile("s_waitcnt vmcnt(0)" ::: "memory"); }
      __syncthreads();
      norm_phase<0, false>(F, args.in[0], args.in[4], MOD, 0, 2048, HN, (const float*)(ws + WS_GWT), args.in[8], (float*)(ws + WS_GATES), nullptr, nullptr);
      const int cv0 = (F.G == 256 ? P0_TILE0 : 0) + F.bid;
      convert_tiles(F, args, cv0 + 2 * F.G, NT_ALL - QCVT_N, F.G); }
    GRID_BAR();
    { Dims g{DM, DM, DM}; DenseOrder S; S.init(NTOK, DINP, F.G, F.bid, HN, ws + WS_WIN, DM, DM); EpiBf16 E{(bf16*)(ws + WS_PROJ), DINP};
      gemm_phase<EpiBf16, DenseOrder, true, true>(ring, g, S, E);
      if (TAILQ2 > 0 && F.G == 256 && (long)((S.nwg + F.G - 1) / F.G - 1) * F.G + F.bid >= S.nwg) { const int k = F.bid - (S.nwg % F.G); convert_tiles(F, args, k, 128 * TAILQ2, 128); } }
    GRID_BAR();
    prep_phase(F, args);
    GRID_BAR();
    { const int hg = F.G / 2, lo = (F.bid < hg) ? F.bid : -1, hi = (F.bid >= hg) ? F.bid - hg : -1;
      { Dims g{256, 256, 256}; BatchOrder S{NUNIT, hg, lo, (const char*)(ws + WS_QB), (const char*)(ws + WS_KB), (size_t)256 * 256 * 2, (size_t)256 * 256 * 2};
        EpiW E{(bf16*)(ws + WS_AP), (const float*)(ws + WS_BCUM), (const float*)(ws + WS_IG)};
        gemm_phase<EpiW, BatchOrder, true, true>(ring, g, S, E); }
      { Dims g{512, 256, 256}; BatchOrder S{NUNIT, F.G - hg, hi, (const char*)(ws + WS_BP) + 512, (const char*)(ws + WS_KWT), (size_t)256 * 512 * 2, (size_t)256 * 256 * 2};
        EpiDC E{(float*)(ws + WS_DCT)};
        gemm_phase<EpiDC, BatchOrder, true, true>(ring, g, S, E);
        if (TAILQ4 > 0 && F.G == 256 && hi >= 0) convert_tiles(F, args, 128 * (TAILQ2 + TAILQ10 + TAILQ6) + hi, 128 * (TAILQ2 + TAILQ10 + TAILQ6 + TAILQ4), 128); }
      { Dims g{1024, 256, 256}; PoolOrder S{hg, lo, (const char*)(ws + WS_POOLED), (const char*)(ws + WS_POOLW)};
        EpiPool E{(bf16*)(ws + WS_MIXCAT), args.in[13]};
        gemm_phase<EpiPool, PoolOrder, true, true>(ring, g, S, E); } }
    GRID_BAR();
    scan_phase(F);
    GRID_BAR();
    { LAS float* sDen = (LAS float*)(F.lds + RING_OFF + RING_BYTES); LAS float* sSS = sDen + 256;
      if (F.bid < NUNIT) {
          int tid = threadIdx.x; asm volatile("" : "+v"(tid)); const int lane = tid & 63, wave = __builtin_amdgcn_readfirstlane(tid >> 6);
          const bf16* ap0 = (const bf16*)(ws + WS_AP) + (size_t)F.bid * 256 * 512; const f32x4 nv = *(const f32x4*)((const float*)(ws + WS_NVEC) + F.bid * 256 + 4 * lane);
#pragma nounroll
          for (int r0 = wave * 32; r0 < wave * 32 + 32; r0 += 8) {
              v2u qa[8], wa[8];
#pragma unroll
              for (int i = 0; i < 8; ++i) { const bf16* ap = ap0 + (size_t)(r0 + i) * 512; qa[i] = *(const v2u*)(ap + 4 * lane); wa[i] = *(const v2u*)(ap + 256 + 4 * lane); }
#pragma unroll
              for (int i = 0; i < 8; ++i) {
                  const float part = bflo(qa[i].x) * nv.x + bfhi(qa[i].x) * nv.y + bflo(qa[i].y) * nv.z + bfhi(qa[i].y) * nv.w + (bflo(wa[i].x) + bfhi(wa[i].x)) + (bflo(wa[i].y) + bfhi(wa[i].y));
                  const float den = wave_sum(part);
                  if (lane == 0) sDen[r0 + i] = 1.0f / fmaxf(fabsf(den), 1.0f); } }
      }
      Dims g{512, 512, 512}; BatchOrder S{NUNIT, F.G, F.bid, (const char*)(ws + WS_AP), (const char*)(ws + WS_BP), (size_t)256 * 512 * 2, (size_t)256 * 512 * 2};
      EpiFin E{(bf16*)(ws + WS_MIXCAT), (const bf16*)(ws + WS_PROJ), DINP, args.in[11], sDen, sSS, EPS};
      gemm_phase<EpiFin, BatchOrder, true, true>(ring, g, S, E);
      if (TAILQ6 > 0 && F.G == 256 && F.bid >= NUNIT) convert_tiles(F, args, 128 * (TAILQ2 + TAILQ10) + (F.bid - NUNIT), 128 * (TAILQ2 + TAILQ10 + TAILQ6), 128); }
    GRID_BAR();
    { Dims g{DM, DM, DM}; DenseOrder S; S.init(NTOK, DM, F.G, F.bid, ws + WS_MIXCAT, ws + WS_WOUT, DM, DM); EpiResid<false> E{args.in[0], XR, MOD + 4096, 1.0f};
      gemm_phase<EpiResid<false>, DenseOrder, true, true>(ring, g, S, E); }
    GRID_BAR();
    norm_phase<1, true, true>(F, XR, args.in[5], MOD, 6144, 8192, HN, nullptr, nullptr, nullptr, nullptr, nullptr);
    GRID_BAR();
    { Dims g{DM / 2, DM / 2, DM / 2}; DenseOrder S; S.init(NTOK, 2 * DFF, F.G, F.bid, HN, ws + WS_W13, DM / 2, DM / 2); EpiSwiglu8 E{ws + WS_U, DFF, 1 << 20, 1.0f / WS8};
      gemm_phase<EpiSwiglu8, DenseOrder, true, true, true>(ring, g, S, E);
      if (TAILQ10 > 0 && F.G == 256 && (long)((S.nwg + F.G - 1) / F.G - 1) * F.G + F.bid >= S.nwg) { const int k = F.bid - (S.nwg % F.G); convert_tiles(F, args, 128 * TAILQ2 + k, 128 * (TAILQ2 + TAILQ10), 128); } }
    GRID_BAR();
    { Dims g{DFF / 2, DFF / 2, DFF / 2}; DenseOrder S; S.init(NTOK, DM, F.G, F.bid, ws + WS_U, ws + WS_W2, DFF / 2, DFF / 2); EpiResid<true> E{XR, XR, MOD + 10240, 1.0f / WS8};
      gemm_phase<EpiResid<true>, DenseOrder, true, true, true>(ring, g, S, E); }
    GRID_BAR();
    const float* MOD1 = MOD + 2 * 12288;
    norm_phase<1, true>(F, XR, args.in[4] + DM, MOD1, 0, 2048, HN, nullptr, nullptr, nullptr, nullptr, nullptr);
    GRID_BAR();
    { Dims g{DM, DM, DM}; DenseOrder S; S.init(NTOK, 2 * DM, F.G, F.bid, HN, ws + WS_WQKV, DM, DM); EpiQKblk E{(bf16*)(ws + WS_QB2), (bf16*)(ws + WS_KB2), 0.08838834764831845f * 1.4426950408889634f};
      gemm_phase<EpiQKblk, DenseOrder, true, true>(ring, g, S, E); }
    { Dims g{DM, DM, DM}; DenseOrder S; S.init(DM, NTOK, F.G, F.bid, ws + WS_WQKV + (size_t)2 * DM * DM * 2, HN, DM, DM); EpiVblk E{(bf16*)(ws + WS_VT)};
      gemm_phase<EpiVblk, DenseOrder, true, true>(ring, g, S, E); }
    GRID_BAR();
    attn_phase(F);
    GRID_BAR();
    { Dims g{DM, DM, DM}; DenseOrder S; S.init(NTOK, DM, F.G, F.bid, ws + WS_ATTO, ws + WS_WO, DM, DM); EpiResid<true> E{XR, XR, MOD1 + 4096, 1.0f};
      gemm_phase<EpiResid<true>, DenseOrder, true, true>(ring, g, S, E); }
    GRID_BAR();
    if (F.G * NWAVES * 4 >= NTOK) {
        route_phase(F, XR, args.in[5] + DM, MOD1, 6144, 8192, (const float*)(ws + WS_RWT), F.ctl + CW_CNT, F.ctl + CW_RDONE);
    } else {
        norm_phase<2, true>(F, XR, args.in[5] + DM, MOD1, 6144, 8192, HN, (const float*)(ws + WS_RWT), nullptr, nullptr, (unsigned*)(ws + WS_TOKINFO), F.ctl + CW_CNT);
        GRID_BAR();
        gather_phase(F);
    }
    GRID_BAR();
    { int base[8], cn[8]; moe_bases(F.ctl + CW_CNT, base, cn);
      MoeOrder S; S.G = F.G; S.c = F.bid;
#pragma unroll
      for (int e = 0; e < 8; ++e) S.cumP[e] = base[e] >> 8;
      S.cumP[8] = (base[7] + ((cn[7] + 255) & ~255)) >> 8;
      { S.nNl = 56; S.A = (const char*)(ws + WS_HPERM); S.Bt = (const char*)(ws + WS_W13E); S.tsa = (size_t)256 * DM; S.tsb = (size_t)256 * DM;
        Dims g{DM / 2, DM / 2, DM / 2}; EpiSwiglu8 E{ws + WS_UE, DFE, 56, 1.0f / WS8};
        gemm_phase<EpiSwiglu8, MoeOrder, true, true, true>(ring, g, S, E); }
      convert_tiles<true>(F, args, QCVT_LO, QCVT_LO + QCVT_N, 0, F.ctl + CW_QCVT);
      GRID_BAR();
      { const int Ptot = S.cumP[8];
        SplitOrder T; T.G = F.G; T.c = F.bid; T.A = (const char*)(ws + WS_UE); T.Bt = (const char*)(ws + WS_W2E); T.tsa = (size_t)256 * DFE; T.tsb = (size_t)256 * DFE; T.kq_bytes = DFE / 4;
#pragma unroll
        for (int e = 0; e < 9; ++e) { T.cumP[e] = S.cumP[e]; S.cumP[e] = S.cumP[e] < 64 ? S.cumP[e] : 64; }
        (void)Ptot;
        S.nNl = 8; S.A = (const char*)(ws + WS_UE); S.Bt = (const char*)(ws + WS_W2E); S.tsa = (size_t)256 * DFE; S.tsb = (size_t)256 * DFE;
        { Dims g{DFE / 2, DFE / 2, DFE / 2}; EpiY E{(bf16*)(ws + WS_Y), (const float*)(ws + WS_SLOTGATE), 1.0f / WS8};
          gemm_phase<EpiY, MoeOrder, true, true, true>(ring, g, S, E); }
        { Dims g{DFE / 2, DFE / 2, DFE / 8}; EpiYp E{(bf16*)(ws + WS_YP), (const float*)(ws + WS_SLOTGATE), 1.0f / WS8};
          gemm_phase<EpiYp, SplitOrder, true, true, true>(ring, g, T, E); } }
    }
    GRID_BAR();
    final_phase(F, args);
#endif
}

extern "C" void kernel_launch(void* const* d_in, const int* in_sizes, int n_in, void* d_out, int out_size, void* d_ws, size_t ws_size, hipStream_t stream) {
    static int grid = 0;
    if (grid == 0) {
        if (n_in != 24 || out_size != NTOK * DM || ws_size < WS_END) { fprintf(stderr, "kernel_launch: unexpected shapes (n_in %d, out %d, ws %zu < %zu); nothing launched\n", n_in, out_size, ws_size, (size_t)WS_END); grid = -1; return; }
        int dev = 0, cus = 0, per_cu = 0;
        if (hipGetDevice(&dev) != hipSuccess || hipDeviceGetAttribute(&cus, hipDeviceAttributeMultiprocessorCount, dev) != hipSuccess) { grid = -1; return; }
        if (hipFuncSetAttribute((const void*)hybrid_fwd, hipFuncAttributeMaxDynamicSharedMemorySize, LDS_BYTES) != hipSuccess) { fprintf(stderr, "kernel_launch: hipFuncSetAttribute failed\n"); grid = -1; return; }
        if (hipOccupancyMaxActiveBlocksPerMultiprocessor(&per_cu, (const void*)hybrid_fwd, NWAVES * 64, LDS_BYTES) != hipSuccess || per_cu < 1)
            fprintf(stderr, "kernel_launch: note: occupancy query reports %d workgroups per CU\n", per_cu);
        (void)hipGetLastError();
        grid = cus;
    }
    if (grid < 0) return;
    if (hipMemsetAsync((char*)d_ws + WS_CTL, 0, CTL_ZERO_BYTES, stream) != hipSuccess) return;
    Args a{};
    for (int i = 0; i < 24; ++i) a.in[i] = (const float*)d_in[i];
    a.out = (float*)d_out; a.ws = (unsigned char*)d_ws;
    hipLaunchKernelGGL(hybrid_fwd, dim3(grid), dim3(NWAVES * 64), LDS_BYTES, stream, a);
    const hipError_t le = hipPeekAtLastError();
    if (le != hipSuccess) fprintf(stderr, "kernel_launch: launch failed: %s\n", hipGetErrorName(le));
}
```

```cpp
#include <hip/hip_runtime.h>
#include <cstdio>
#include <cstdint>

#ifndef SKELETON
#define SKELETON 0
#endif

namespace pg8 {
#define PG8_LAS __attribute__((address_space(3)))
typedef unsigned short bf16_t;
typedef short bf16x8 __attribute__((ext_vector_type(8)));
typedef float f32x4 __attribute__((ext_vector_type(4)));
typedef unsigned u32x4 __attribute__((ext_vector_type(4)));
constexpr int BM = 256, BK = 64, HALF = 128, HTB = HALF * BK * 2  , STAGE_BYTES = 8 * HTB, NXCD = 8, WGM = 4;

__host__ __device__ __forceinline__ int lds_byte(int r, int c) { const int st = (r >> 4) * 2 + (c >> 5), rr = r & 15, cc = c & 31, ob = rr * 64 + cc * 2; return st * 1024 + (ob ^ (((ob >> 9) & 1) << 5)); }
__host__ __device__ __forceinline__ void stage_rc(int b, int& R, int& C) { const int st = b / 1024, sb = b % 1024, swz = sb ^ (((sb >> 9) & 1) << 5); R = (st >> 1) * 16 + swz / 64; C = (st & 1) * 32 + (swz % 64) / 2; }
__host__ __device__ __forceinline__ int perm32(int rho) { const int n = rho >> 4, i = rho & 15; return 8 * (i >> 2) + 4 * n + (i & 3); }

struct Unit { int pm, pn; const char* a; const char* b; };
struct Dims { int lda, ldb, K; };

__device__ __forceinline__ unsigned cvt_pk_bf16(float lo, float hi) { unsigned r; asm volatile("v_cvt_pk_bf16_f32 %0, %1, %2" : "=v"(r) : "v"(lo), "v"(hi)); return r; }

__device__ __forceinline__ int xcd_remap(int wgid, int nwg) { const int q = nwg / NXCD, r = nwg % NXCD, xcd = wgid % NXCD, off = wgid / NXCD; return (xcd < r ? xcd * (q + 1) : r * (q + 1) + (xcd - r) * q) + off; }

struct DenseOrder {
    int nM, nN, nwg, G, c; const char* A; const char* Bt; size_t tsa, tsb;
    __device__ __forceinline__ void init(int M, int N, int G_, int c_, const void* A_, const void* Bt_, int lda, int ldb) { nM = M / BM; nN = N / BM; nwg = nM * nN; G = G_; c = c_; A = (const char*)A_; Bt = (const char*)Bt_; tsa = (size_t)BM * lda * 2; tsb = (size_t)BM * ldb * 2; }
    __device__ __forceinline__ bool next(int i, Unit& u) const {
        const long L = (long)i * G + c; if (L >= nwg) return false;
        const int wgid = xcd_remap((int)L, nwg);
        const int nig = WGM * nN, gid = wgid / nig, fm = gid * WGM, gsz = (nM - fm) < WGM ? (nM - fm) : WGM;
        u.pm = fm + ((wgid % nig) % gsz); u.pn = (wgid % nig) / gsz; u.a = A + (size_t)u.pm * tsa; u.b = Bt + (size_t)u.pn * tsb; return true;
    }
    __device__ __forceinline__ void a_ready(const Unit&) const {}
    __device__ __forceinline__ void done(const Unit&) const {}
};
struct BatchOrder {
    int n, G, c; const char* A; const char* Bt; size_t tsa, tsb;
    __device__ __forceinline__ bool next(int i, Unit& u) const { const long L = (long)i * G + c; if (c < 0 || L >= n) return false; u.pm = (int)L; u.pn = (int)L; u.a = A + (size_t)L * tsa; u.b = Bt + (size_t)L * tsb; return true; }
    __device__ __forceinline__ void a_ready(const Unit&) const {}
    __device__ __forceinline__ void done(const Unit&) const {}
};
struct PoolOrder {
    int G, c; const char* A; const char* Bt;
    __device__ __forceinline__ bool next(int i, Unit& u) const { const long L = (long)i * G + c; if (c < 0 || L >= 128) return false; u.pm = (int)L & 31; u.pn = (int)L >> 5; u.a = A + (size_t)u.pm * (256 * 1024 * 2) + (size_t)u.pn * 512; u.b = Bt + (size_t)u.pn * (256 * 256 * 2); return true; }
    __device__ __forceinline__ void a_ready(const Unit&) const {}
    __device__ __forceinline__ void done(const Unit&) const {}
};
struct MoeOrder {
    int G, c, nNl; int cumP[9]; const char* A; const char* Bt; size_t tsa, tsb;
    __device__ __forceinline__ bool next(int i, Unit& u) const {
        const int nwg = cumP[8] * nNl; const long L = (long)i * G + c; if (L >= nwg) return false;
        const int wgid = xcd_remap((int)L, nwg);
        int e = 0;
#pragma unroll
        for (int k = 1; k < 8; ++k) e += (wgid >= cumP[k] * nNl) ? 1 : 0;
        int p0 = cumP[0], p1 = cumP[1];
#pragma unroll
        for (int k = 1; k < 8; ++k) { p0 = (e == k) ? cumP[k] : p0; p1 = (e == k) ? cumP[k + 1] : p1; }
        const int local = wgid - p0 * nNl, Pe = p1 - p0;
        u.pm = p0 + local % Pe; u.pn = e * nNl + local / Pe; u.a = A + (size_t)u.pm * tsa; u.b = Bt + (size_t)u.pn * tsb; return true;
    }
    __device__ __forceinline__ void a_ready(const Unit&) const {}
    __device__ __forceinline__ void done(const Unit&) const {}
};

struct SplitOrder {
    int G, c; int cumP[9]; const char* A; const char* Bt; size_t tsa, tsb; int kq_bytes;
    __device__ __forceinline__ bool next(int i, Unit& u) const {
        const long L = (long)i * G + c; const int n = (cumP[8] - 64) * 32; if (L >= n) return false;
        const int p = 64 + (int)L / 32, rem = (int)L & 31, pnl = rem >> 2, kq = rem & 3;
        int e = 0;
#pragma unroll
        for (int k = 1; k < 8; ++k) e += (p >= cumP[k]) ? 1 : 0;
        u.pm = p; u.pn = pnl + 64 * kq; u.a = A + (size_t)p * tsa + (size_t)kq * kq_bytes; u.b = Bt + (size_t)(e * 8 + pnl) * tsb + (size_t)kq * kq_bytes; return true;
    }
    __device__ __forceinline__ void a_ready(const Unit&) const {}
    __device__ __forceinline__ void done(const Unit&) const {}
};

__device__ __forceinline__ float silu_f(float x) { return x * __builtin_amdgcn_rcpf(1.0f + __expf(-x)); }
typedef float f32x2p __attribute__((ext_vector_type(2)));
__device__ __forceinline__ f32x2p swiglu2(f32x2p a, f32x2p b, float c1, float c2) {
    const f32x2p z = a * c1; f32x2p t; t.x = __builtin_amdgcn_exp2f(z.x); t.y = __builtin_amdgcn_exp2f(z.y);
    const f32x2p d = t + 1.0f; f32x2p s; s.x = __builtin_amdgcn_rcpf(d.x); s.y = __builtin_amdgcn_rcpf(d.y);
    return (a * b) * (s * c2);
}
__device__ __forceinline__ f32x2p sigm2(unsigned w) {
    f32x2p x; x.x = __uint_as_float(w << 16); x.y = __uint_as_float(w & 0xffff0000u);
    const f32x2p z = x * -1.4426950408889634f; f32x2p t; t.x = __builtin_amdgcn_exp2f(z.x); t.y = __builtin_amdgcn_exp2f(z.y);
    const f32x2p d = t + 1.0f; f32x2p s; s.x = __builtin_amdgcn_rcpf(d.x); s.y = __builtin_amdgcn_rcpf(d.y); return s;
}

struct EpiBf16 {
    static constexpr bool PERM = true;
    bf16_t* O; int ldc;
    __device__ __forceinline__ void operator()(const f32x4 (&acc)[2][2][4][2], const Unit& u, int wr, int wc, int fr_, int fq_) const {
        int z_; asm volatile("v_mov_b32 %0, 0" : "=v"(z_)); const int fr = fr_ + z_, fq = fq_ + z_;
        const int row0 = u.pm * BM + wr * 64 + fr, col0 = u.pn * BM + wc * 32 + 8 * fq;
#pragma unroll
        for (int ai = 0; ai < 2; ++ai)
#pragma unroll
            for (int m = 0; m < 4; ++m) { bf16_t* rowp = O + (size_t)(row0 + ai * HALF + m * 16) * ldc + col0;
#pragma unroll
                for (int bj = 0; bj < 2; ++bj) { const f32x4 v0 = acc[ai][bj][m][0], v1 = acc[ai][bj][m][1];
                    u32x4 w; w.x = cvt_pk_bf16(v0[0], v0[1]); w.y = cvt_pk_bf16(v0[2], v0[3]); w.z = cvt_pk_bf16(v1[0], v1[1]); w.w = cvt_pk_bf16(v1[2], v1[3]);
                    *(u32x4*)(rowp + bj * HALF) = w; } }
    }
};
struct EpiQKblk {
    static constexpr bool PERM = true;
    bf16_t* Q; bf16_t* K; float qs;
    __device__ __forceinline__ void operator()(const f32x4 (&acc)[2][2][4][2], const Unit& u, int wr, int wc, int fr_, int fq_) const {
        int z_; asm volatile("v_mov_b32 %0, 0" : "=v"(z_)); const int fr = fr_ + z_, fq = fq_ + z_;
#pragma unroll
        for (int bj = 0; bj < 2; ++bj) { const int c0 = u.pn * BM + bj * HALF + wc * 32 + 8 * fq; bf16_t* base = (c0 >= 2048) ? K : Q; const float sc = (c0 >= 2048) ? 1.0f : qs;
            const int hh = (c0 & 2047) >> 7, d0 = c0 & 127; const size_t cofs = (size_t)hh * (128 * 4096) + (d0 >> 4) * 512 + ((d0 >> 3) & 1) * 8;
#pragma unroll
            for (int ai = 0; ai < 2; ++ai)
#pragma unroll
                for (int m = 0; m < 4; ++m) { const int t = u.pm * BM + ai * HALF + wr * 64 + m * 16 + fr, b = t >> 12, pos = t & 4095;
                    bf16_t* dst = base + (size_t)b * (16 * 128 * 4096) + cofs + (size_t)(pos >> 5) * 4096 + (pos & 31) * 16;
                    const f32x4 v0 = acc[ai][bj][m][0] * sc, v1 = acc[ai][bj][m][1] * sc;
                    u32x4 w; w.x = cvt_pk_bf16(v0[0], v0[1]); w.y = cvt_pk_bf16(v0[2], v0[3]); w.z = cvt_pk_bf16(v1[0], v1[1]); w.w = cvt_pk_bf16(v1[2], v1[3]);
                    *(u32x4*)dst = w; } }
    }
};
struct EpiVblk {
    static constexpr bool PERM = true;
    bf16_t* V;
    __device__ __forceinline__ void operator()(const f32x4 (&acc)[2][2][4][2], const Unit& u, int wr, int wc, int fr_, int fq_) const {
        int z_; asm volatile("v_mov_b32 %0, 0" : "=v"(z_)); const int fr = fr_ + z_, fq = fq_ + z_;
        typedef unsigned u32x2v __attribute__((ext_vector_type(2)));
#pragma unroll
        for (int bj = 0; bj < 2; ++bj) { const int tok0 = u.pn * BM + bj * HALF + wc * 32 + 8 * fq, b = tok0 >> 12, pos0 = tok0 & 4095, k0 = pos0 & 31;
            const size_t cofs = (size_t)b * (16 * 128 * 4096) + (size_t)(pos0 >> 5) * 4096 + (k0 >> 4) * 2048 + ((k0 >> 3) & 1) * 4;
#pragma unroll
            for (int ai = 0; ai < 2; ++ai)
#pragma unroll
                for (int m = 0; m < 4; ++m) { const int f = u.pm * BM + ai * HALF + wr * 64 + m * 16 + fr, hh = f >> 7, e = f & 127;
                    bf16_t* dst = V + cofs + (size_t)hh * (128 * 4096) + (e >> 5) * 512 + (e & 31) * 16;
                    const f32x4 v0 = acc[ai][bj][m][0], v1 = acc[ai][bj][m][1];
                    u32x2v w0, w1; w0.x = cvt_pk_bf16(v0[0], v0[1]); w0.y = cvt_pk_bf16(v0[2], v0[3]); w1.x = cvt_pk_bf16(v1[0], v1[1]); w1.y = cvt_pk_bf16(v1[2], v1[3]);
                    *(u32x2v*)dst = w0; *(u32x2v*)(dst + 8) = w1; } }
    }
};
template <bool BASE16> struct EpiResid {
    static constexpr bool PERM = true;
    const void* base; bf16_t* out; const float* gate; float gs;
    __device__ __forceinline__ void operator()(const f32x4 (&acc)[2][2][4][2], const Unit& u, int wr, int wc, int fr_, int fq_) const {
        int z_; asm volatile("v_mov_b32 %0, 0" : "=v"(z_)); const int fr = fr_ + z_, fq = fq_ + z_;
        const int row0 = u.pm * BM + wr * 64 + fr, col0 = u.pn * BM + wc * 32 + 8 * fq;
        const float* gp = gate + (size_t)((u.pm * BM) >> 12) * 12288 + col0;
        const __amdgpu_buffer_rsrc_t rs = __builtin_amdgcn_make_buffer_rsrc((void*)out, 0, 8192 * 2048 * 2, 0x00020000);
        f32x4 gv[2][2];
#pragma unroll
        for (int bj = 0; bj < 2; ++bj)
#pragma unroll
            for (int n = 0; n < 2; ++n) gv[bj][n] = *(const f32x4*)(gp + bj * HALF + 4 * n) * gs;
#pragma unroll
        for (int ai = 0; ai < 2; ++ai)
#pragma unroll
            for (int m = 0; m < 4; ++m) { const size_t off = (size_t)(row0 + ai * HALF + m * 16) * 2048 + col0;
#pragma unroll
                for (int bj = 0; bj < 2; ++bj) { f32x4 b0, b1;
                    if (BASE16) { const u32x4 w = *(const u32x4*)((const bf16_t*)base + off + bj * HALF);
                        b0 = (f32x4){__uint_as_float(w.x << 16), __uint_as_float(w.x & 0xffff0000u), __uint_as_float(w.y << 16), __uint_as_float(w.y & 0xffff0000u)};
                        b1 = (f32x4){__uint_as_float(w.z << 16), __uint_as_float(w.z & 0xffff0000u), __uint_as_float(w.w << 16), __uint_as_float(w.w & 0xffff0000u)}; }
                    else { b0 = *(const f32x4*)((const float*)base + off + bj * HALF); b1 = *(const f32x4*)((const float*)base + off + bj * HALF + 4); }
                    const f32x4 v0 = b0 + gv[bj][0] * acc[ai][bj][m][0], v1 = b1 + gv[bj][1] * acc[ai][bj][m][1];
                    u32x4 o; o.x = cvt_pk_bf16(v0[0], v0[1]); o.y = cvt_pk_bf16(v0[2], v0[3]); o.z = cvt_pk_bf16(v1[0], v1[1]); o.w = cvt_pk_bf16(v1[2], v1[3]);
                    __builtin_amdgcn_raw_buffer_store_b128(o, rs, (int)((off + bj * HALF) * 2), 0, 16); }
                asm volatile("" ::: "memory"); }
    }
};
struct EpiSwiglu {
    static constexpr bool PERM = true;
    bf16_t* O; int ldo; int nNl;
    __device__ __forceinline__ void operator()(const f32x4 (&acc)[2][2][4][2], const Unit& u, int wr, int wc, int fr_, int fq_) const {
        int z_; asm volatile("v_mov_b32 %0, 0" : "=v"(z_)); const int fr = fr_ + z_, fq = fq_ + z_;
        const int row0 = u.pm * BM + wr * 64 + fr, col0 = (u.pn % nNl) * HALF + wc * 32 + 8 * fq;
#pragma unroll
        for (int ai = 0; ai < 2; ++ai)
#pragma unroll
            for (int m = 0; m < 4; ++m) { bf16_t* rowp = O + (size_t)(row0 + ai * HALF + m * 16) * ldo + col0;
                const f32x4 a0 = acc[ai][0][m][0], a1 = acc[ai][0][m][1], b0 = acc[ai][1][m][0], b1 = acc[ai][1][m][1];
                const f32x2p r0 = swiglu2((f32x2p){a0[0], a0[1]}, (f32x2p){b0[0], b0[1]}, -1.4426950408889634f, 1.0f), r1 = swiglu2((f32x2p){a0[2], a0[3]}, (f32x2p){b0[2], b0[3]}, -1.4426950408889634f, 1.0f);
                const f32x2p r2 = swiglu2((f32x2p){a1[0], a1[1]}, (f32x2p){b1[0], b1[1]}, -1.4426950408889634f, 1.0f), r3 = swiglu2((f32x2p){a1[2], a1[3]}, (f32x2p){b1[2], b1[3]}, -1.4426950408889634f, 1.0f);
                u32x4 w; w.x = cvt_pk_bf16(r0.x, r0.y); w.y = cvt_pk_bf16(r1.x, r1.y); w.z = cvt_pk_bf16(r2.x, r2.y); w.w = cvt_pk_bf16(r3.x, r3.y);
                *(u32x4*)rowp = w; }
    }
};
__device__ __forceinline__ unsigned pk4_fp8(float a, float b, float c, float d) { int w = 0; w = __builtin_amdgcn_cvt_pk_fp8_f32(a, b, w, false); w = __builtin_amdgcn_cvt_pk_fp8_f32(c, d, w, true); return (unsigned)w; }
struct EpiSwiglu8 {
    static constexpr bool PERM = true;
    unsigned char* O; int ldo; int nNl; float inv;
    __device__ __forceinline__ void operator()(const f32x4 (&acc)[2][2][4][2], const Unit& u, int wr, int wc, int fr, int fq) const {
        const int row0 = u.pm * BM + wr * 64 + fr, col0 = (u.pn % nNl) * HALF + wc * 32 + 8 * fq;
#pragma unroll
        for (int ai = 0; ai < 2; ++ai)
#pragma unroll
            for (int m = 0; m < 4; ++m) { unsigned char* rowp = O + (size_t)(row0 + ai * HALF + m * 16) * ldo + col0;
                const f32x4 a0 = acc[ai][0][m][0], a1 = acc[ai][0][m][1], b0 = acc[ai][1][m][0], b1 = acc[ai][1][m][1];
                const float c1 = -1.4426950408889634f * inv, c2 = inv * inv;
                const f32x2p r0 = swiglu2((f32x2p){a0[0], a0[1]}, (f32x2p){b0[0], b0[1]}, c1, c2), r1 = swiglu2((f32x2p){a0[2], a0[3]}, (f32x2p){b0[2], b0[3]}, c1, c2);
                const f32x2p r2 = swiglu2((f32x2p){a1[0], a1[1]}, (f32x2p){b1[0], b1[1]}, c1, c2), r3 = swiglu2((f32x2p){a1[2], a1[3]}, (f32x2p){b1[2], b1[3]}, c1, c2);
                typedef unsigned u32x2v __attribute__((ext_vector_type(2)));
                u32x2v w; w.x = pk4_fp8(r0.x, r0.y, r1.x, r1.y); w.y = pk4_fp8(r2.x, r2.y, r3.x, r3.y);
                *(u32x2v*)rowp = w; }
    }
};
struct EpiY {
    static constexpr bool PERM = true;
    bf16_t* Y; const float* sg; float inv;
    __device__ __forceinline__ void operator()(const f32x4 (&acc)[2][2][4][2], const Unit& u, int wr, int wc, int fr_, int fq_) const {
        int z_; asm volatile("v_mov_b32 %0, 0" : "=v"(z_)); const int fr = fr_ + z_, fq = fq_ + z_;
        const int row0 = u.pm * BM + wr * 64 + fr, col0 = (u.pn & 7) * BM + wc * 32 + 8 * fq;
#pragma unroll
        for (int ai = 0; ai < 2; ++ai)
#pragma unroll
            for (int m = 0; m < 4; ++m) { const int row = row0 + ai * HALF + m * 16; const float g = sg[row] * inv; bf16_t* rowp = Y + (size_t)row * 2048 + col0;
#pragma unroll
                for (int bj = 0; bj < 2; ++bj) { const f32x4 v0 = acc[ai][bj][m][0] * g, v1 = acc[ai][bj][m][1] * g;
                    u32x4 w; w.x = cvt_pk_bf16(v0[0], v0[1]); w.y = cvt_pk_bf16(v0[2], v0[3]); w.z = cvt_pk_bf16(v1[0], v1[1]); w.w = cvt_pk_bf16(v1[2], v1[3]);
                    *(u32x4*)(rowp + bj * HALF) = w; } }
    }
};
struct EpiYp {
    static constexpr bool PERM = true;
    bf16_t* YP; const float* sg; float inv;
    __device__ __forceinline__ void operator()(const f32x4 (&acc)[2][2][4][2], const Unit& u, int wr, int wc, int fr_, int fq_) const {
        int z_; asm volatile("v_mov_b32 %0, 0" : "=v"(z_)); const int fr = fr_ + z_, fq = fq_ + z_;
        const int row0 = u.pm * BM + wr * 64 + fr, col0 = (u.pn & 7) * BM + wc * 32 + 8 * fq; bf16_t* base = YP + (size_t)(u.pn >> 6) * (1792 * 2048);
#pragma unroll
        for (int ai = 0; ai < 2; ++ai)
#pragma unroll
            for (int m = 0; m < 4; ++m) { const int row = row0 + ai * HALF + m * 16; const float g = sg[row] * inv; bf16_t* rowp = base + (size_t)(row - 16384) * 2048 + col0;
#pragma unroll
                for (int bj = 0; bj < 2; ++bj) { const f32x4 v0 = acc[ai][bj][m][0] * g, v1 = acc[ai][bj][m][1] * g;
                    u32x4 w; w.x = cvt_pk_bf16(v0[0], v0[1]); w.y = cvt_pk_bf16(v0[2], v0[3]); w.z = cvt_pk_bf16(v1[0], v1[1]); w.w = cvt_pk_bf16(v1[2], v1[3]);
                    *(u32x4*)(rowp + bj * HALF) = w; } }
    }
};
struct EpiW {
    static constexpr bool PERM = true;
    bf16_t* AP; const float* bcum; const float* ig;
    __device__ __forceinline__ void operator()(const f32x4 (&acc)[2][2][4][2], const Unit& u, int wr, int wc, int fr_, int fq_) const {
        int z_; asm volatile("v_mov_b32 %0, 0" : "=v"(z_)); const int fr = fr_ + z_, fq = fq_ + z_;
        const float* bc = bcum + u.pm * 256; const float* ii = ig + u.pm * 256;
#pragma unroll
        for (int bj = 0; bj < 2; ++bj) { const int s0 = bj * HALF + wc * 32 + 8 * fq;
            const f32x4 b0 = *(const f32x4*)(bc + s0), b1 = *(const f32x4*)(bc + s0 + 4), i0 = *(const f32x4*)(ii + s0), i1 = *(const f32x4*)(ii + s0 + 4);
            const f32x4 c0 = i0 - b0, c1 = i1 - b1;
#pragma unroll
            for (int ai = 0; ai < 2; ++ai)
#pragma unroll
                for (int m = 0; m < 4; ++m) { const int t = ai * HALF + wr * 64 + m * 16 + fr; const float bt = bc[t]; bf16_t* rowp = AP + ((size_t)u.pm * 256 + t) * 512 + 256;
                    const f32x4 v0 = acc[ai][bj][m][0], v1 = acc[ai][bj][m][1]; float r[8];
                    const int dts = t - s0;
#pragma unroll
                    for (int j = 0; j < 4; ++j) { const float m0 = (float)min(max(dts - j + 1, 0), 1), m1 = (float)min(max(dts - j - 3, 0), 1);
                        r[j] = v0[j] * __expf(fminf(bt + c0[j], 80.f)) * m0; r[4 + j] = v1[j] * __expf(fminf(bt + c1[j], 80.f)) * m1; }
                    u32x4 w; w.x = cvt_pk_bf16(r[0], r[1]); w.y = cvt_pk_bf16(r[2], r[3]); w.z = cvt_pk_bf16(r[4], r[5]); w.w = cvt_pk_bf16(r[6], r[7]);
                    *(u32x4*)(rowp + s0) = w; asm volatile("" ::: "memory"); } }
    }
};
struct EpiDC {
    static constexpr bool PERM = false;
    float* D;
    __device__ __forceinline__ void operator()(const f32x4 (&acc)[2][2][4][2], const Unit& u, int wr, int wc, int fr_, int fq_) const {
        int z_; asm volatile("v_mov_b32 %0, 0" : "=v"(z_)); const int fr = fr_ + z_, fq = fq_ + z_;
        const int row0 = wr * 64 + fr, col0 = wc * 32 + 4 * fq;
#pragma unroll
        for (int ai = 0; ai < 2; ++ai)
#pragma unroll
            for (int m = 0; m < 4; ++m) { float* rowp = D + ((size_t)u.pm * 256 + row0 + ai * HALF + m * 16) * 256 + col0;
#pragma unroll
                for (int bj = 0; bj < 2; ++bj)
#pragma unroll
                    for (int n = 0; n < 2; ++n) *(f32x4*)(rowp + bj * HALF + n * 16) = acc[ai][bj][m][n]; }
    }
};
struct EpiNum {
    static constexpr bool PERM = false;
    float* HR;
    __device__ __forceinline__ void operator()(const f32x4 (&acc)[2][2][4][2], const Unit& u, int wr, int wc, int fr_, int fq_) const {
        int z_; asm volatile("v_mov_b32 %0, 0" : "=v"(z_)); const int fr = fr_ + z_, fq = fq_ + z_;
        const int b = u.pm >> 6, h = (u.pm >> 4) & 3, c = u.pm & 15;
        const int row0 = b * 4096 + c * 256 + wr * 64 + fr, col0 = h * 256 + wc * 32 + 4 * fq;
#pragma unroll
        for (int ai = 0; ai < 2; ++ai)
#pragma unroll
            for (int m = 0; m < 4; ++m) { float* rowp = HR + (size_t)(row0 + ai * HALF + m * 16) * 1024 + col0;
#pragma unroll
                for (int bj = 0; bj < 2; ++bj)
#pragma unroll
                    for (int n = 0; n < 2; ++n) *(f32x4*)(rowp + bj * HALF + n * 16) = acc[ai][bj][m][n]; }
    }
};
struct EpiFin {
    static constexpr bool PERM = true;
    bf16_t* O; const bf16_t* PROJ; int ldp; const float* headg; PG8_LAS float* sDen; PG8_LAS float* sSS; float eps;
    __device__ __forceinline__ void operator()(const f32x4 (&acc)[2][2][4][2], const Unit& u, int wr, int wc, int fr_, int fq_) const {
        int z_; asm volatile("v_mov_b32 %0, 0" : "=v"(z_)); const int fr = fr_ + z_, fq = fq_ + z_;
        const int b = u.pm >> 6, h = (u.pm >> 4) & 3, c = u.pm & 15;
        const int rl0 = wr * 64 + fr, col0 = wc * 32 + 8 * fq;
#pragma unroll
        for (int ai = 0; ai < 2; ++ai)
#pragma unroll
            for (int m = 0; m < 4; ++m) { float p = 0.f;
#pragma unroll
                for (int bj = 0; bj < 2; ++bj)
#pragma unroll
                    for (int n = 0; n < 2; ++n) { const f32x4 v = acc[ai][bj][m][n]; p += v[0] * v[0] + v[1] * v[1] + v[2] * v[2] + v[3] * v[3]; }
                p += __shfl_xor(p, 16); p += __shfl_xor(p, 32);
                if (fq == 0) sSS[wc * 256 + rl0 + ai * HALF + m * 16] = p; }
        asm volatile("s_waitcnt lgkmcnt(0)" ::: "memory"); __builtin_amdgcn_s_barrier();
        f32x4 hv[2][2];
#pragma unroll
        for (int bj = 0; bj < 2; ++bj)
#pragma unroll
            for (int n = 0; n < 2; ++n) hv[bj][n] = *(const f32x4*)(headg + h * 256 + col0 + bj * HALF + 4 * n);
#pragma unroll
        for (int ai = 0; ai < 2; ++ai) {
            const size_t t0 = (size_t)b * 4096 + c * 256 + rl0 + ai * HALF;
            u32x4 ow[4][2];
#pragma unroll
            for (int m = 0; m < 4; ++m)
#pragma unroll
                for (int bj = 0; bj < 2; ++bj) ow[m][bj] = *(const u32x4*)(PROJ + (t0 + m * 16) * ldp + 3072 + h * 256 + col0 + bj * HALF);
#pragma unroll
            for (int m = 0; m < 4; ++m) { const int rl = rl0 + ai * HALF + m * 16;
                const float P = (sSS[rl] + sSS[256 + rl]) + (sSS[512 + rl] + sSS[768 + rl]), idd = sDen[rl];
                const float f = idd * (1.0f / sqrtf(P * idd * idd * (1.0f / 256.0f) + eps));
                bf16_t* rowp = O + (t0 + m * 16) * 2048 + h * 256 + col0;
#pragma unroll
                for (int bj = 0; bj < 2; ++bj) { const f32x4 v0 = acc[ai][bj][m][0] * f * hv[bj][0], v1 = acc[ai][bj][m][1] * f * hv[bj][1]; const u32x4 o = ow[m][bj];
                    const f32x2p s0 = sigm2(o.x), s1 = sigm2(o.y), s2 = sigm2(o.z), s3 = sigm2(o.w);
                    u32x4 w; w.x = cvt_pk_bf16(v0[0] * s0.x, v0[1] * s0.y); w.y = cvt_pk_bf16(v0[2] * s1.x, v0[3] * s1.y); w.z = cvt_pk_bf16(v1[0] * s2.x, v1[1] * s2.y); w.w = cvt_pk_bf16(v1[2] * s3.x, v1[3] * s3.y);
                    *(u32x4*)(rowp + bj * HALF) = w; } } }
    }
};
struct EpiPool {
    static constexpr bool PERM = true;
    bf16_t* O; const float* scale;
    __device__ __forceinline__ void operator()(const f32x4 (&acc)[2][2][4][2], const Unit& u, int wr, int wc, int fr_, int fq_) const {
        int z_; asm volatile("v_mov_b32 %0, 0" : "=v"(z_)); const int fr = fr_ + z_, fq = fq_ + z_;
        const int row0 = u.pm * BM + wr * 64 + fr, col0 = u.pn * 256 + wc * 32 + 8 * fq;
        f32x4 sv[2][2];
#pragma unroll
        for (int bj = 0; bj < 2; ++bj)
#pragma unroll
            for (int n = 0; n < 2; ++n) sv[bj][n] = *(const f32x4*)(scale + col0 + bj * HALF + 4 * n);
#pragma unroll
        for (int ai = 0; ai < 2; ++ai)
#pragma unroll
            for (int m = 0; m < 4; ++m) { bf16_t* rowp = O + (size_t)(row0 + ai * HALF + m * 16) * 2048 + 1024 + col0;
#pragma unroll
                for (int bj = 0; bj < 2; ++bj) { const f32x4 v0 = acc[ai][bj][m][0] * sv[bj][0], v1 = acc[ai][bj][m][1] * sv[bj][1];
                    u32x4 w; w.x = cvt_pk_bf16(v0[0], v0[1]); w.y = cvt_pk_bf16(v0[2], v0[3]); w.z = cvt_pk_bf16(v1[0], v1[1]); w.w = cvt_pk_bf16(v1[2], v1[3]);
                    *(u32x4*)(rowp + bj * HALF) = w; } }
    }
};

typedef int v8i_t __attribute__((ext_vector_type(8)));
typedef int v4i_t __attribute__((ext_vector_type(4)));
__device__ __forceinline__ v8i_t cat8(bf16x8 lo, bf16x8 hi) { return __builtin_shufflevector(__builtin_bit_cast(v4i_t, lo), __builtin_bit_cast(v4i_t, hi), 0, 1, 2, 3, 4, 5, 6, 7); }
template <class Epi, class Sched, bool ALIGN_EPI = false, bool SP2 = false, bool F8 = false>
__device__ __forceinline__ void gemm_phase(PG8_LAS unsigned char* lds, const Dims g, const Sched& S, const Epi& E) {
    int tid_ = threadIdx.x; asm volatile("" : "+v"(tid_));
    const int tid = tid_, wid = __builtin_amdgcn_readfirstlane(tid >> 6), lane = tid & 63, wr = wid >> 2, wc = wid & 3, fr = lane & 15, fq = lane >> 4;
    const int K = g.K, nt = K / BK;
    unsigned voffA[2], voffB[2];
#pragma unroll
    for (int i = 0; i < 2; ++i) { int R, C; stage_rc(tid * 16 + i * 8192, R, C); const int Rb = Epi::PERM ? ((R & ~31) + perm32(R & 31)) : R;
        voffA[i] = (unsigned)(R * g.lda + C) * 2u; voffB[i] = (unsigned)(Rb * g.ldb + C) * 2u; }
    const size_t kstep = (size_t)(BK * 2);
    const size_t hstepA = (size_t)HALF * g.lda * 2, hstepB = (size_t)HALF * g.ldb * 2;
    const unsigned ldsw = (unsigned)wid * 1024u;
    const int aoff = lds_byte(wr * 64 + fr, fq * 8), boff = lds_byte(wc * 32 + fr, fq * 8);
#define PG8_SA(b, h) (((b) * 2 + (h)) * HTB)
#define PG8_SB(b, h) ((4 + (b) * 2 + (h)) * HTB)
#define PG8_STAGE(bufoff, gbase, voff) do { _Pragma("unroll") for (int _i = 0; _i < 2; ++_i) \
        __builtin_amdgcn_global_load_lds((const unsigned*)((const char*)(gbase) + (voff)[_i]), (PG8_LAS unsigned*)(lds + (bufoff) + ldsw + _i * 8192), 16, 0, 0); } while (0)
#define PG8_LDA(dst, b, h) do { if constexpr (F8) { _Pragma("unroll") for (int m = 0; m < 4; ++m) { const v4i_t lo_ = *(const PG8_LAS v4i_t*)(lds + PG8_SA(b, h) + aoff + m * 2048), hi_ = *(const PG8_LAS v4i_t*)(lds + PG8_SA(b, h) + aoff + m * 2048 + 1024); dst##8[m] = __builtin_shufflevector(lo_, hi_, 0, 1, 2, 3, 4, 5, 6, 7); } } else { \
        _Pragma("unroll") for (int m = 0; m < 4; ++m) _Pragma("unroll") for (int k = 0; k < 2; ++k) dst[m][k] = *(const PG8_LAS bf16x8*)(lds + PG8_SA(b, h) + aoff + m * 2048 + k * 1024); } } while (0)
#define PG8_LDB(dst, b, h) do { if constexpr (F8) { _Pragma("unroll") for (int n = 0; n < 2; ++n) { const v4i_t lo_ = *(const PG8_LAS v4i_t*)(lds + PG8_SB(b, h) + boff + n * 2048), hi_ = *(const PG8_LAS v4i_t*)(lds + PG8_SB(b, h) + boff + n * 2048 + 1024); dst##8[n] = __builtin_shufflevector(lo_, hi_, 0, 1, 2, 3, 4, 5, 6, 7); } } else { \
        _Pragma("unroll") for (int n = 0; n < 2; ++n) _Pragma("unroll") for (int k = 0; k < 2; ++k) dst[n][k] = *(const PG8_LAS bf16x8*)(lds + PG8_SB(b, h) + boff + n * 2048 + k * 1024); } } while (0)
#define PG8_MMA(ai, bj, At, Bt) do { __builtin_amdgcn_s_setprio(1); if constexpr (F8) { _Pragma("unroll") for (int m = 0; m < 4; ++m) _Pragma("unroll") for (int n = 0; n < 2; ++n) \
        asm volatile("v_mfma_scale_f32_16x16x128_f8f6f4 %0, %1, %2, %0, %3, %3 op_sel_hi:[0,0,0]" : "+v"(acc[ai][bj][m][n]) : "v"(Bt##8[n]), "v"(At##8[m]), "v"(sc8)); } else { \
        _Pragma("unroll") for (int m = 0; m < 4; ++m) _Pragma("unroll") for (int n = 0; n < 2; ++n) _Pragma("unroll") for (int k = 0; k < 2; ++k) \
        acc[ai][bj][m][n] = __builtin_amdgcn_mfma_f32_16x16x32_bf16(Bt[n][k], At[m][k], acc[ai][bj][m][n], 0, 0, 0); } __builtin_amdgcn_s_setprio(0); } while (0)
#define PG8_WAIT_V(n) asm volatile("s_waitcnt vmcnt(" #n ")" ::: "memory")
#define PG8_WAIT_L(n) asm volatile("s_waitcnt lgkmcnt(" #n ")" ::: "memory")
#define PG8_BAR __builtin_amdgcn_s_barrier()
#define PG8_SCHED __builtin_amdgcn_sched_barrier(0)
    Unit cur, nxt; int ui = 0;
    if (!S.next(0, cur)) return;
    f32x4 acc[2][2][4][2];
#pragma unroll
    for (int a = 0; a < 2; ++a)
#pragma unroll
        for (int b = 0; b < 2; ++b)
#pragma unroll
            for (int m = 0; m < 4; ++m)
#pragma unroll
                for (int n = 0; n < 2; ++n) acc[a][b][m][n] = (f32x4){0.f, 0.f, 0.f, 0.f};
    int sc8 = 0x7f7f7f7f; asm volatile("" : "+v"(sc8));
    bf16x8 At[4][2], B0[2][2], B1[2][2]; v8i_t At8[4], B08[2], B18[2]; (void)At; (void)B0; (void)B1; (void)At8; (void)B08; (void)B18;
    const char* cA = cur.a; const char* cB = cur.b;
    S.a_ready(cur);
    if constexpr (SP2) {
        PG8_STAGE(PG8_SB(0, 0), cB, voffB); PG8_STAGE(PG8_SB(0, 1), cB + hstepB, voffB); PG8_STAGE(PG8_SA(0, 0), cA, voffA); PG8_STAGE(PG8_SA(0, 1), cA + hstepA, voffA);
        if (wr == 1) PG8_BAR;
        PG8_WAIT_V(2); PG8_BAR;
        PG8_STAGE(PG8_SB(1, 0), cB + kstep, voffB); PG8_STAGE(PG8_SA(1, 0), cA + kstep, voffA); PG8_STAGE(PG8_SB(1, 1), cB + hstepB + kstep, voffB);
        PG8_WAIT_V(6); PG8_BAR;
    } else {
        PG8_STAGE(PG8_SB(0, 0), cB, voffB); PG8_STAGE(PG8_SA(0, 0), cA, voffA); PG8_STAGE(PG8_SB(0, 1), cB + hstepB, voffB); PG8_STAGE(PG8_SA(0, 1), cA + hstepA, voffA);
        if (wr == 1) PG8_BAR;
        PG8_WAIT_V(4); PG8_BAR;
        PG8_STAGE(PG8_SB(1, 0), cB + kstep, voffB); PG8_STAGE(PG8_SA(1, 0), cA + kstep, voffA); PG8_STAGE(PG8_SB(1, 1), cB + hstepB + kstep, voffB);
        PG8_WAIT_V(6); PG8_BAR;
    }
    for (;;) {
        const bool has_next = S.next(ui + 1, nxt);
        const char* nA = has_next ? nxt.a : cA; const char* nB = has_next ? nxt.b : cB;
#pragma nounroll
        for (int t = 0; t < nt; t += 2) {
            const bool last = (t == nt - 2);
            const char* a1 = cA + (size_t)(t + 1) * kstep;
            const char* a2 = last ? nA : cA + (size_t)(t + 2) * kstep; const char* b2 = last ? nB : cB + (size_t)(t + 2) * kstep;
            const char* a3 = a2 + kstep; const char* b3 = b2 + kstep;
            if (last && has_next) S.a_ready(nxt);
            if constexpr (SP2) {
            PG8_LDB(B0, 0, 0); PG8_LDB(B1, 0, 1); PG8_SCHED; PG8_LDA(At, 0, 0); PG8_STAGE(PG8_SA(1, 1), a1 + hstepA, voffA);
            PG8_WAIT_V(8); PG8_WAIT_L(0); PG8_BAR; PG8_MMA(0, 0, At, B0); PG8_MMA(0, 1, At, B1); PG8_BAR; PG8_SCHED;
            PG8_LDA(At, 0, 1); PG8_STAGE(PG8_SB(0, 0), b2, voffB); PG8_STAGE(PG8_SB(0, 1), b2 + hstepB, voffB); PG8_STAGE(PG8_SA(0, 0), a2, voffA);
            PG8_WAIT_V(8); PG8_WAIT_L(0); PG8_BAR; PG8_MMA(1, 0, At, B0); PG8_MMA(1, 1, At, B1); PG8_BAR; PG8_SCHED;
            PG8_LDB(B0, 1, 0); PG8_LDB(B1, 1, 1); PG8_SCHED; PG8_LDA(At, 1, 0); PG8_STAGE(PG8_SA(0, 1), a2 + hstepA, voffA);
            PG8_WAIT_V(8); PG8_WAIT_L(0); PG8_BAR; PG8_MMA(0, 0, At, B0); PG8_MMA(0, 1, At, B1); PG8_BAR; PG8_SCHED;
            PG8_LDA(At, 1, 1); PG8_STAGE(PG8_SB(1, 0), b3, voffB); PG8_STAGE(PG8_SB(1, 1), b3 + hstepB, voffB); PG8_STAGE(PG8_SA(1, 0), a3, voffA);
            PG8_WAIT_V(8); PG8_WAIT_L(0); PG8_BAR; PG8_MMA(1, 0, At, B0); PG8_MMA(1, 1, At, B1); PG8_BAR; PG8_SCHED;
            } else {
            PG8_LDB(B0, 0, 0); PG8_SCHED; PG8_LDA(At, 0, 0); PG8_STAGE(PG8_SA(1, 1), a1 + hstepA, voffA);
            PG8_WAIT_L(8); PG8_BAR; PG8_WAIT_L(0); PG8_MMA(0, 0, At, B0); PG8_BAR; PG8_SCHED;
            PG8_LDB(B1, 0, 1); PG8_STAGE(PG8_SB(0, 0), b2, voffB);
            PG8_BAR; PG8_WAIT_L(0); PG8_MMA(0, 1, At, B1); PG8_BAR;
            PG8_LDA(At, 0, 1); PG8_STAGE(PG8_SA(0, 0), a2, voffA);
            PG8_BAR; PG8_WAIT_L(0); PG8_MMA(1, 0, At, B0); PG8_BAR; PG8_SCHED;
            PG8_STAGE(PG8_SB(0, 1), b2 + hstepB, voffB);
            PG8_WAIT_V(6); PG8_BAR; PG8_MMA(1, 1, At, B1); PG8_BAR;
            PG8_LDB(B0, 1, 0); PG8_SCHED; PG8_LDA(At, 1, 0); PG8_STAGE(PG8_SA(0, 1), a2 + hstepA, voffA);
            PG8_WAIT_L(8); PG8_BAR; PG8_WAIT_L(0); PG8_MMA(0, 0, At, B0); PG8_BAR; PG8_SCHED;
            PG8_LDB(B1, 1, 1); PG8_STAGE(PG8_SB(1, 0), b3, voffB);
            PG8_BAR; PG8_WAIT_L(0); PG8_MMA(0, 1, At, B1); PG8_BAR;
            PG8_LDA(At, 1, 1); PG8_STAGE(PG8_SA(1, 0), a3, voffA);
            PG8_BAR; PG8_WAIT_L(0); PG8_MMA(1, 0, At, B0); PG8_BAR; PG8_SCHED;
            PG8_STAGE(PG8_SB(1, 1), b3 + hstepB, voffB);
            PG8_WAIT_V(6); PG8_BAR; PG8_MMA(1, 1, At, B1); PG8_BAR;
            }
        }
        if constexpr (F8) {
#pragma unroll
            for (int a = 0; a < 2; ++a)
#pragma unroll
                for (int b = 0; b < 2; ++b)
                    asm volatile("s_nop 15\n\ts_nop 15" : "+v"(acc[a][b][0][0]), "+v"(acc[a][b][0][1]), "+v"(acc[a][b][1][0]), "+v"(acc[a][b][1][1]), "+v"(acc[a][b][2][0]), "+v"(acc[a][b][2][1]), "+v"(acc[a][b][3][0]), "+v"(acc[a][b][3][1]));
        }
        if constexpr (ALIGN_EPI) { if (wr == 0) PG8_BAR; }
        E(acc, cur, wr, wc, fr, fq); S.done(cur);
        if (!has_next) break;
#pragma unroll
        for (int a = 0; a < 2; ++a)
#pragma unroll
            for (int b = 0; b < 2; ++b)
#pragma unroll
                for (int m = 0; m < 4; ++m)
#pragma unroll
                    for (int n = 0; n < 2; ++n) acc[a][b][m][n] = (f32x4){0.f, 0.f, 0.f, 0.f};
        cur = nxt; cA = nA; cB = nB; ++ui;
        if constexpr (ALIGN_EPI) { if (wr == 1) PG8_BAR; }
    }
    PG8_WAIT_V(0);
    if constexpr (!ALIGN_EPI) { if (wr == 0) PG8_BAR; }
    PG8_BAR;
#undef PG8_SA
#undef PG8_SB
#undef PG8_STAGE
#undef PG8_LDA
#undef PG8_LDB
#undef PG8_MMA
#undef PG8_WAIT_V
#undef PG8_WAIT_L
#undef PG8_BAR
#undef PG8_SCHED
}
}

constexpr int NWAVES = 8;
constexpr int DM = 2048, NTOK = 8192, SEQ = 4096;
constexpr int DINS = 5128, DINP = 5120;
constexpr int DFF = 5632, NE = 8, DFE = 7168;
constexpr int NUNIT = 128;
constexpr int MAXSLOT = 18432;
constexpr float EPS = 1e-6f;

constexpr size_t MiB = 1u << 20;
constexpr size_t WS_CTL = 0, CTL_ZERO_BYTES = 1 * MiB;
constexpr size_t WS_MOD = 1 * MiB;
constexpr size_t WS_GWT = WS_MOD + 256 * 1024;
constexpr size_t WS_RWT = WS_GWT + 64 * 1024;
constexpr size_t WS_GATES = WS_RWT + 64 * 1024;
constexpr size_t WS_BCUM = WS_GATES + 256 * 1024;
constexpr size_t WS_IG = WS_BCUM + 128 * 1024;
constexpr size_t WS_GTOT = WS_IG + 128 * 1024;
constexpr size_t WS_DN = WS_GTOT + 4 * 1024;
constexpr size_t WS_NVEC = WS_DN + 128 * 1024;
constexpr size_t WS_TOKINFO = WS_NVEC + 128 * 1024;
constexpr size_t WS_TOKSLOT = WS_TOKINFO + 256 * 1024;
constexpr size_t WS_SLOTGATE = WS_TOKSLOT + 64 * 1024;
static_assert(WS_SLOTGATE + 128 * 1024 <= 4 * MiB, "small arrays");
constexpr size_t WS_WIN = 4 * MiB, WS_WOUT = 24 * MiB, WS_W13 = 32 * MiB, WS_W2 = 76 * MiB, WS_WQKV = 98 * MiB, WS_WO = 122 * MiB, WS_POOLW = 130 * MiB;
constexpr size_t WS_W13E = 132 * MiB, WS_W2E = 580 * MiB;
constexpr size_t WS_XR = 804 * MiB, WS_HN = 868 * MiB;
constexpr size_t WS_L = 900 * MiB;
constexpr size_t WS_PROJ = WS_L, WS_QB = WS_L + 80 * MiB, WS_KB = WS_L + 96 * MiB, WS_KWT = WS_L + 112 * MiB, WS_AP = WS_L + 128 * MiB, WS_BP = WS_L + 160 * MiB,
                 WS_DCT = WS_L + 192 * MiB, WS_HR = WS_L + 224 * MiB, WS_POOLED = WS_L + 256 * MiB, WS_MIXCAT = WS_L + 272 * MiB, WS_U = WS_L + 304 * MiB;
constexpr size_t WS_QB2 = WS_L, WS_KB2 = WS_L + 32 * MiB, WS_VT = WS_L + 64 * MiB, WS_ATTO = WS_L + 96 * MiB, WS_HPERM = WS_L + 128 * MiB, WS_UE = WS_L + 200 * MiB, WS_Y = WS_L + 452 * MiB;
constexpr size_t WS_YP = WS_L + 528 * MiB;
constexpr size_t WS_END = WS_L + 596 * MiB;

constexpr int CW_TMO = 0, CW_CODE = 1;
constexpr int CW_BAR = 4096;
constexpr int CW_PAN8 = 12288, CW_PAN11 = 16384;
constexpr int CW_P0PUB = 10752;
constexpr int CW_QCVT = 10496;
constexpr int CW_RDONE = 10240;
constexpr int CW_CNT = 8192;

constexpr int RING_OFF = 0, RING_BYTES = 131072;
constexpr int LDS_BYTES = 147456;
constexpr int LDSCTL_OFF = LDS_BYTES - 512, MISC_OFF = LDSCTL_OFF;

#define GAS __attribute__((address_space(1)))
#define LAS __attribute__((address_space(3)))
typedef unsigned short bf16;
typedef unsigned v4u __attribute__((ext_vector_type(4)));
typedef unsigned v2u __attribute__((ext_vector_type(2)));
typedef float f32x4 __attribute__((ext_vector_type(4)));
typedef GAS unsigned gu32;
#define RLX_AGENT __ATOMIC_RELAXED, __HIP_MEMORY_SCOPE_AGENT
#define LDS_WAIT() asm volatile("s_waitcnt lgkmcnt(0)" ::: "memory")
#define VM_WAIT() asm volatile("s_waitcnt vmcnt(0)" ::: "memory")
__device__ __forceinline__ unsigned pk2(float lo, float hi) { return pg8::cvt_pk_bf16(lo, hi); }
__device__ __forceinline__ float bflo(unsigned w) { return __uint_as_float(w << 16); }
__device__ __forceinline__ float bfhi(unsigned w) { return __uint_as_float(w & 0xffff0000u); }
__device__ __forceinline__ float logsig(float x) { return fminf(x, 0.f) - log1pf(expf(-fabsf(x))); }
__device__ __forceinline__ float dot4(f32x4 a, f32x4 b) { return (a.x * b.x + a.y * b.y) + (a.z * b.z + a.w * b.w); }

#define XB_TMO      128
#define XB_XCNT(j)  (256  + 64 * (j))
#define XB_XSUB(j)  (1280 + 64 * (j))
#define XB_XGEN(j)  (2304 + 64 * (j))
#define XB_TOP      3328
#define XB_TOPGEN   3392
#define XCD_BAR_WORDS 3456
#define XB_SPIN_CAP (1u << 20)

__device__ __forceinline__ unsigned xb_ld(unsigned* p)              { return __hip_atomic_load(p, __ATOMIC_RELAXED, __HIP_MEMORY_SCOPE_AGENT); }
__device__ __forceinline__ unsigned xb_add(unsigned* p, unsigned v) { return __hip_atomic_fetch_add(p, v, __ATOMIC_RELAXED, __HIP_MEMORY_SCOPE_AGENT); }
__device__ __forceinline__ unsigned xb_xcc_id() { return (unsigned)__builtin_amdgcn_s_getreg((3 << 11) | 20) & 0xFu; }
#define XB_SPIN(cond, bar) do { unsigned _sp = 0; while (cond) { __builtin_amdgcn_s_sleep(1); \
    if ((++_sp & 255u) == 0u) { if (xb_ld(&(bar)[XB_TMO])) break; if (_sp > XB_SPIN_CAP) { atomicAdd(&(bar)[XB_TMO], 1u); break; } } } } while (0)

struct XcdBarrier { unsigned* bar; unsigned x; volatile LAS unsigned* st; };

__device__ __forceinline__ XcdBarrier xcd_barrier_post(unsigned* bar, volatile LAS unsigned* st) {
    XcdBarrier b; b.bar = bar; b.x = xb_xcc_id(); b.st = st;
    if (threadIdx.x == 0) (void)xb_add(&bar[XB_XCNT(b.x)], 1u);
    return b;
}
__device__ __forceinline__ void xcd_barrier_complete(unsigned* bar, unsigned x, unsigned& nloc, unsigned& nx) {
    const unsigned G = gridDim.x * gridDim.y * gridDim.z;
    unsigned sum, cnt, mine, sp = 0u;
    for (;;) {
        sum = 0u; cnt = 0u; mine = 0u;
#pragma unroll
        for (unsigned j = 0; j < 16; ++j) { const unsigned c = xb_ld(&bar[XB_XCNT(j)]); sum += c; cnt += (c > 0u) ? 1u : 0u; mine = (j == x) ? c : mine; }
        if (sum == G) break;
        __builtin_amdgcn_s_sleep(1);
        if ((++sp & 255u) == 0u) { if (xb_ld(&bar[XB_TMO])) break; if (sp > XB_SPIN_CAP) { atomicAdd(&bar[XB_TMO], 1u); break; } }
    }
    nloc = mine > 0u ? mine : 1u; nx = cnt > 0u ? cnt : 1u;
}
__device__ __forceinline__ void xcd_barrier(const XcdBarrier& b) {
    asm volatile("s_waitcnt vmcnt(0)" ::: "memory");
    __syncthreads();
    int tid0 = threadIdx.x; asm volatile("" : "+v"(tid0));
    if (tid0 == 0) {
        unsigned* bar = b.bar;
        __builtin_amdgcn_s_waitcnt(0);
        unsigned nloc = b.st[0], nx = b.st[1];
        if (nloc == 0u) { xcd_barrier_complete(bar, b.x, nloc, nx); b.st[0] = nloc; b.st[1] = nx; }
        const unsigned old = xb_add(&bar[XB_XSUB(b.x)], 1u);
        const unsigned gen = old / nloc;
        if (old + 1u == (gen + 1u) * nloc) {
            __builtin_amdgcn_fence(__ATOMIC_RELEASE, "agent");
            asm volatile("s_waitcnt vmcnt(0)" ::: "memory");
            const unsigned og = xb_add(&bar[XB_TOP], 1u);
            const unsigned tg = og / nx;
            if (og + 1u == (tg + 1u) * nx) xb_add(&bar[XB_TOPGEN], 1u);
            else XB_SPIN(xb_ld(&bar[XB_TOPGEN]) == tg, bar);
            __builtin_amdgcn_fence(__ATOMIC_ACQUIRE, "agent");
            xb_add(&bar[XB_XGEN(b.x)], 1u);
            asm volatile("s_waitcnt vmcnt(0)" ::: "memory");
        } else {
            XB_SPIN(xb_ld(&bar[XB_XGEN(b.x)]) == gen, bar);
            __builtin_amdgcn_fence(__ATOMIC_ACQUIRE, "agent");
            asm volatile("s_waitcnt vmcnt(0)" ::: "memory");
        }
    }
    __syncthreads();
}

struct Args { const float* in[24]; float* out; unsigned char* ws; };
struct Frame {
    LAS unsigned char* lds; volatile LAS unsigned* MISC; gu32* ctl;
    int G, bid;
    unsigned char* ws;
};
__device__ __forceinline__ float wave_sum(float v) {
#pragma unroll
    for (int o = 1; o < 64; o <<= 1) v += __shfl_xor(v, o);
    return v;
}

__device__ __forceinline__ void transpose_item(const float* src, int spitch, int k0, int n0s, bf16* dst, int dpitch, int n0d, LAS unsigned* T, int lane) {
    const int kr = lane & 3, nq = lane >> 2;
#pragma unroll
    for (int i = 0; i < 8; ++i) {
        const int k = k0 + 8 * i + 2 * kr;
        const f32x4 a = *(const f32x4*)(src + (size_t)k * spitch + n0s + 4 * nq);
        const f32x4 b = *(const f32x4*)(src + (size_t)(k + 1) * spitch + n0s + 4 * nq);
#pragma unroll
        for (int j = 0; j < 4; ++j) T[(4 * nq + j) * 33 + 4 * i + kr] = pk2(a[j], b[j]);
    }
    LDS_WAIT();
#pragma unroll
    for (int it = 0; it < 8; ++it) {
        const int n = (lane >> 3) + 8 * it, c = lane & 7;
        v4u o; o.x = T[n * 33 + 4 * c]; o.y = T[n * 33 + 4 * c + 1]; o.z = T[n * 33 + 4 * c + 2]; o.w = T[n * 33 + 4 * c + 3];
        *(v4u*)(dst + (size_t)(n0d + n) * dpitch + k0 + 8 * c) = o;
    }
    LDS_WAIT();
}
__device__ __forceinline__ void transpose_item8(const float* src, int spitch, int k0, int n0s, unsigned char* dst, int dpitch, int n0d, float scale, LAS unsigned* T, int lane) {
    const int kr = lane & 3, nq = lane >> 2;
    f32x4 a[8][4];
#pragma unroll
    for (int i = 0; i < 8; ++i) { const float* p = src + (size_t)(k0 + 16 * i + 4 * kr) * spitch + n0s + 4 * nq;
#pragma unroll
        for (int q = 0; q < 4; ++q) a[i][q] = *(const f32x4*)(p + (size_t)q * spitch); }
#pragma unroll
    for (int i = 0; i < 8; ++i)
#pragma unroll
        for (int j = 0; j < 4; ++j) T[(4 * nq + j) * 33 + 4 * i + kr] = pg8::pk4_fp8(a[i][0][j] * scale, a[i][1][j] * scale, a[i][2][j] * scale, a[i][3][j] * scale);
    LDS_WAIT();
#pragma unroll
    for (int it = 0; it < 8; ++it) {
        const int n = (lane >> 3) + 8 * it, c = lane & 7;
        v4u o; o.x = T[n * 33 + 4 * c]; o.y = T[n * 33 + 4 * c + 1]; o.z = T[n * 33 + 4 * c + 2]; o.w = T[n * 33 + 4 * c + 3];
        *(v4u*)(dst + (size_t)(n0d + n) * dpitch + k0 + 16 * c) = o;
    }
    LDS_WAIT();
}
constexpr float WS8 = 64.0f;
constexpr int I_W13E = 8 * 16 * 224, I_W2E = 8 * 56 * 32, I_WIN = 32 * 80, I_WOUT = 32 * 32, I_W13 = 32 * 176, I_W2 = 88 * 32, I_WQKV = 32 * 96, I_WO = 32 * 32, I_POOL = 4 * 16;
constexpr int N_ITEMS = I_W13E + I_W2E + I_WIN + I_WOUT + I_W13 + I_W2 + I_WQKV + I_WO + I_POOL;
constexpr int NT_W13E = 8 * 8 * 56, NT_W2E = 8 * 28 * 8, NT_WIN = 16 * 20, NT_WOUT = 16 * 8, NT_W13 = 0, NT_W2 = 0  , NT_WQKV = 16 * 24, NT_WO = 16 * 8, NT_POOL = 8;
constexpr int NT_W13F = 8 * 44, NT_W2F = 22 * 8;
constexpr int NT_ALL = NT_W13E + NT_W2E + NT_W13F + NT_W2F + NT_WIN + NT_WOUT + NT_W13 + NT_W2 + NT_WQKV + NT_WO + NT_POOL;
constexpr int TAILQ2 = 7, TAILQ10 = 5, TAILQ6 = 1, TAILQ4 = 1;
constexpr int P0_TILE0 = 128 * (TAILQ2 + TAILQ10 + TAILQ6 + TAILQ4);
constexpr int QCVT_N = 1024, QCVT_LO = NT_W13E + NT_W2E - QCVT_N;

template <bool DYN = false>
__device__ __forceinline__ void convert_tiles(Frame& F, const Args& args, int first, int last, int stride, gu32* q = nullptr) {
    int tid = threadIdx.x; asm volatile("" : "+v"(tid)); const int lane = tid & 63, wave = __builtin_amdgcn_readfirstlane(tid >> 6);
    unsigned char* ws = F.ws;
    {
        const int nl = 4 * lane;
        struct Tile { const float* s; int spitch; unsigned char* d; size_t dpitch; bool f8; };
        auto decode = [&](int it) -> Tile {
            Tile t; int r = it; if (!DYN && r >= QCVT_LO) r += QCVT_N;
            if (r < NT_W13E) { const int e = r / (8 * 56), rr = r % (8 * 56), kb = rr / 56, nb = rr % 56; t.f8 = true; t.spitch = DFE;
                t.s = (nl < 128 ? args.in[21] + nb * 128 + nl : args.in[22] + nb * 128 + nl - 128) + (size_t)e * 2048 * DFE + (size_t)(kb * 256 + wave * 32) * DFE;
                t.d = ws + WS_W13E + ((size_t)e * 14336 + nb * 256) * 2048 + kb * 256; t.dpitch = 2048; }
            else if ((r -= NT_W13E) < NT_W2E) { const int e = r / (28 * 8), rr = r % (28 * 8), kb = rr / 8, nb = rr % 8; t.f8 = true; t.spitch = 2048;
                t.s = args.in[23] + (size_t)e * DFE * 2048 + (size_t)(kb * 256 + wave * 32) * 2048 + nb * 256 + nl;
                t.d = ws + WS_W2E + ((size_t)e * 2048 + nb * 256) * DFE + kb * 256; t.dpitch = DFE; }
            else if ((r -= NT_W2E) < NT_W13F) { const int kb = r / 44, nb = r % 44; t.f8 = true; t.spitch = DFF;
                t.s = (nl < 128 ? args.in[15] + nb * 128 + nl : args.in[16] + nb * 128 + nl - 128) + (size_t)(kb * 256 + wave * 32) * DFF;
                t.d = ws + WS_W13 + ((size_t)nb * 256) * 2048 + kb * 256; t.dpitch = 2048; }
            else if ((r -= NT_W13F) < NT_W2F) { const int kb = r / 8, nb = r % 8; t.f8 = true; t.spitch = 2048;
                t.s = args.in[17] + (size_t)(kb * 256 + wave * 32) * 2048 + nb * 256 + nl;
                t.d = ws + WS_W2 + ((size_t)nb * 256) * DFF + kb * 256; t.dpitch = DFF; }
            else { t.f8 = false; r -= NT_W2F; int kb, nb, K; const float* base; unsigned char* db; int scol;
                if (r < NT_WIN) { kb = r / 20; nb = r % 20; K = 2048; t.spitch = DINS; base = args.in[7]; db = ws + WS_WIN; scol = nb * 256 + nl + (nb >= 16 ? 8 : 0); }
                else if ((r -= NT_WIN) < NT_WOUT) { kb = r / 8; nb = r % 8; K = 2048; t.spitch = 2048; base = args.in[14]; db = ws + WS_WOUT; scol = nb * 256 + nl; }
                else if ((r -= NT_WOUT) < NT_W13) { kb = r / 44; nb = r % 44; K = 2048; t.spitch = DFF; base = (nl < 128 ? args.in[15] : args.in[16] - 128); db = ws + WS_W13; scol = nb * 128 + nl; }
                else if ((r -= NT_W13) < NT_W2) { kb = r / 8; nb = r % 8; K = DFF; t.spitch = 2048; base = args.in[17]; db = ws + WS_W2; scol = nb * 256 + nl; }
                else if ((r -= NT_W2) < NT_WQKV) { kb = r / 24; nb = r % 24; K = 2048; t.spitch = 6144; base = args.in[18]; db = ws + WS_WQKV; scol = nb * 256 + nl; }
                else if ((r -= NT_WQKV) < NT_WO) { kb = r / 8; nb = r % 8; K = 2048; t.spitch = 2048; base = args.in[19]; db = ws + WS_WO; scol = nb * 256 + nl; }
                else { r -= NT_WO; kb = r & 1; nb = 0; K = 256; t.spitch = 256; base = args.in[12] + (size_t)(r >> 1) * 65536; db = ws + WS_POOLW + (size_t)(r >> 1) * 131072; scol = nl; }
                t.s = base + (size_t)(kb * 128 + wave * 16) * t.spitch + scol; t.d = db + ((size_t)nb * 256 * K + kb * 128) * 2; t.dpitch = (size_t)K * 2; }
            return t; };
        int buf = 0;
        f32x4 a[32];
        LAS int* slot = (LAS int*)(F.lds + RING_OFF + RING_BYTES + 8192);
        int it = first, nxt = 0, kq = 0;
        if (DYN) { if (tid == 0) { slot[0] = first + (int)__hip_atomic_fetch_add(q, 1u, __ATOMIC_RELAXED, __HIP_MEMORY_SCOPE_AGENT); slot[1] = first + (int)__hip_atomic_fetch_add(q, 1u, __ATOMIC_RELAXED, __HIP_MEMORY_SCOPE_AGENT); }
            __syncthreads(); it = __builtin_amdgcn_readfirstlane(slot[0]); nxt = __builtin_amdgcn_readfirstlane(slot[1]); __syncthreads(); }
        Tile cur = decode(it < last ? it : 0);
        if (it < last) {
#pragma unroll
            for (int kk = 0; kk < 32; ++kk) if (kk < 16 || cur.f8) a[kk] = __builtin_nontemporal_load((const f32x4*)(cur.s + (size_t)kk * cur.spitch));
        }
        for (; it < last; ) {
            LAS unsigned char* T = F.lds + buf * 65536;
            int tk = 0; if (DYN && tid == 0) tk = first + (int)__hip_atomic_fetch_add(q, 1u, __ATOMIC_RELAXED, __HIP_MEMORY_SCOPE_AGENT);
            const int c0 = 2 * wave, sw = lane & 15;
            if (cur.f8) {
#pragma unroll
                for (int j = 0; j < 4; ++j) { v4u o0, o1;
                    o0.x = pg8::pk4_fp8(a[0][j] * WS8, a[1][j] * WS8, a[2][j] * WS8, a[3][j] * WS8);     o0.y = pg8::pk4_fp8(a[4][j] * WS8, a[5][j] * WS8, a[6][j] * WS8, a[7][j] * WS8);
                    o0.z = pg8::pk4_fp8(a[8][j] * WS8, a[9][j] * WS8, a[10][j] * WS8, a[11][j] * WS8);   o0.w = pg8::pk4_fp8(a[12][j] * WS8, a[13][j] * WS8, a[14][j] * WS8, a[15][j] * WS8);
                    o1.x = pg8::pk4_fp8(a[16][j] * WS8, a[17][j] * WS8, a[18][j] * WS8, a[19][j] * WS8); o1.y = pg8::pk4_fp8(a[20][j] * WS8, a[21][j] * WS8, a[22][j] * WS8, a[23][j] * WS8);
                    o1.z = pg8::pk4_fp8(a[24][j] * WS8, a[25][j] * WS8, a[26][j] * WS8, a[27][j] * WS8); o1.w = pg8::pk4_fp8(a[28][j] * WS8, a[29][j] * WS8, a[30][j] * WS8, a[31][j] * WS8);
                    *(LAS v4u*)(T + (nl + j) * 256 + ((c0 ^ sw) << 4)) = o0; *(LAS v4u*)(T + (nl + j) * 256 + (((c0 + 1) ^ sw) << 4)) = o1; }
            } else {
#pragma unroll
                for (int j = 0; j < 4; ++j) { v4u o0, o1;
                    o0.x = pk2(a[0][j], a[1][j]); o0.y = pk2(a[2][j], a[3][j]); o0.z = pk2(a[4][j], a[5][j]); o0.w = pk2(a[6][j], a[7][j]);
                    o1.x = pk2(a[8][j], a[9][j]); o1.y = pk2(a[10][j], a[11][j]); o1.z = pk2(a[12][j], a[13][j]); o1.w = pk2(a[14][j], a[15][j]);
                    *(LAS v4u*)(T + (nl + j) * 256 + ((c0 ^ sw) << 4)) = o0; *(LAS v4u*)(T + (nl + j) * 256 + (((c0 + 1) ^ sw) << 4)) = o1; }
            }
            const Tile done = cur; const int nx = DYN ? nxt : it + stride;
            if (nx < last) { cur = decode(nx);
#pragma unroll
                for (int kk = 0; kk < 32; ++kk) if (kk < 16 || cur.f8) a[kk] = __builtin_nontemporal_load((const f32x4*)(cur.s + (size_t)kk * cur.spitch)); }
            if (DYN && tid == 0) slot[kq & 1] = tk;
            __syncthreads();
#pragma unroll
            for (int i = 0; i < 8; ++i) { const int row = (tid >> 4) + 32 * i, c = tid & 15;
                const v4u o = *(const LAS v4u*)(T + row * 256 + ((c ^ ((row >> 2) & 15)) << 4));
                __builtin_nontemporal_store(o, (v4u*)(done.d + (size_t)row * done.dpitch + 16 * c)); }
            buf ^= 1;
            if (DYN) { it = nxt; nxt = __builtin_amdgcn_readfirstlane(slot[kq & 1]); ++kq; } else it += stride;
        }
    }
    __syncthreads();
}

__device__ __forceinline__ void p0_prologue(Frame& F, const Args& args) {
    int tid = threadIdx.x; asm volatile("" : "+v"(tid)); const int lane = tid & 63, wave = __builtin_amdgcn_readfirstlane(tid >> 6); (void)lane; (void)wave;
    unsigned char* ws = F.ws;
    {
        LAS float* sC = (LAS float*)(F.lds);
        LAS float* sR = sC + 4096;
        const float* c = args.in[1]; const float* adaw = args.in[2]; const float* adab = args.in[3]; float* MOD = (float*)(ws + WS_MOD);
        bool have = false;
        for (int task = F.bid; task < 256; task += F.G) {
            if (!have) { for (int i = tid; i < 4096; i += 512) { const float cv = c[i]; sC[i] = cv / (1.0f + expf(-cv)); } __syncthreads(); have = true; }
            const int l = task >> 7, n0 = (task & 127) * 96, cq = tid % 24, ks = tid / 24;
            if (ks < 21) {
                const int k0 = ks * 98, k1 = (k0 + 98 < 2048) ? k0 + 98 : 2048;
                const float* W = adaw + (size_t)l * 2048 * 12288 + n0 + 4 * cq;
                f32x4 a0 = {0.f, 0.f, 0.f, 0.f}, a1 = {0.f, 0.f, 0.f, 0.f};
#pragma unroll 7
                for (int k = k0; k < k1; ++k) { const f32x4 w = __builtin_nontemporal_load((const f32x4*)(W + (size_t)k * 12288)); a0 += sC[k] * w; a1 += sC[2048 + k] * w; }
#pragma unroll
                for (int j = 0; j < 4; ++j) { sR[(ks * 2 + 0) * 96 + 4 * cq + j] = a0[j]; sR[(ks * 2 + 1) * 96 + 4 * cq + j] = a1[j]; }
            }
            __syncthreads();
            if (tid < 192) { const int b = tid / 96, n = tid % 96; float s = 0.f;
#pragma unroll
                for (int k2 = 0; k2 < 21; ++k2) s += sR[(k2 * 2 + b) * 96 + n];
                __hip_atomic_store((gu32*)(MOD + (size_t)(l * 2 + b) * 12288 + n0 + n), __float_as_uint(s + adab[l * 12288 + n0 + n]), RLX_AGENT); }
            __syncthreads();
        }
        __syncthreads();
    }
    {
        const float* win = args.in[7]; const float* rw = args.in[20]; float* GWT = (float*)(ws + WS_GWT); float* RWT = (float*)(ws + WS_RWT);
        for (int i = F.bid * 512 + tid; i < 16384; i += F.G * 512) { const int g = i >> 11, k = i & 2047; __hip_atomic_store((gu32*)(GWT + i), __float_as_uint(win[(size_t)k * DINS + 4096 + g]), RLX_AGENT); RWT[i] = rw[k * 8 + g]; }
    }
    asm volatile("s_waitcnt vmcnt(0)" ::: "memory");
    __syncthreads();
    if (tid == 0) __hip_atomic_fetch_add(F.ctl + CW_P0PUB, 1u, RLX_AGENT);
    const int cv0 = (F.G == 256 ? P0_TILE0 : 0) + F.bid;
    convert_tiles(F, args, cv0, cv0 + 2 * F.G < NT_ALL - QCVT_N ? cv0 + 2 * F.G : NT_ALL - QCVT_N, F.G);
}

template <int MODE, bool X16, bool OUT8 = false>
__device__ __forceinline__ void norm_phase(Frame& F, const void* xin, const float* gain, const float* modl, int sh_off, int sc_off, bf16* HN,
                                           const float* tab, const float* bias8, float* gates_out, unsigned* tokinfo, gu32* cnt) {
    int tid = threadIdx.x; asm volatile("" : "+v"(tid)); const int lane = tid & 63, wave = __builtin_amdgcn_readfirstlane(tid >> 6); (void)lane; (void)wave;
    LAS float* sT = (LAS float*)(F.lds);
    if (MODE != 1) { for (int i = tid; i < 16384; i += 512) sT[i] = tab[i]; __syncthreads(); }
    const int gw = F.bid * NWAVES + wave, NGW = F.G * NWAVES;
    for (int t0 = gw * 4; t0 < NTOK; t0 += NGW * 4) {
        const int b = t0 >> 12;
        f32x4 ga[8], sb[8];
#pragma unroll
        for (int j = 0; j < 8; ++j) { const int col = 4 * (lane + 64 * j);
            const f32x4 g = *(const f32x4*)(gain + col), sc = *(const f32x4*)(modl + (size_t)b * 12288 + sc_off + col);
            ga[j] = g * (sc + 1.0f); sb[j] = *(const f32x4*)(modl + (size_t)b * 12288 + sh_off + col); }
        v2u xw4[4][8]; (void)xw4;
        if (X16) {
#pragma unroll
            for (int i = 0; i < 4; ++i)
#pragma unroll
                for (int j = 0; j < 8; ++j) xw4[i][j] = *(const v2u*)((const bf16*)xin + (size_t)(t0 + i) * DM + 4 * (lane + 64 * j)); }
#pragma unroll
        for (int i = 0; i < 4; ++i) {
            const int t = t0 + i;
            f32x4 v[8]; float ss = 0.f;
#pragma unroll
            for (int j = 0; j < 8; ++j) {
                if (X16) { const v2u w = xw4[i][j]; v[j] = (f32x4){bflo(w.x), bfhi(w.x), bflo(w.y), bfhi(w.y)}; }
                else v[j] = *(const f32x4*)((const float*)xin + (size_t)t * DM + 4 * (lane + 64 * j));
                ss += dot4(v[j], v[j]); }
            ss = wave_sum(ss);
            const float r = 1.0f / sqrtf(ss * (1.0f / DM) + EPS);
#pragma unroll
            for (int j = 0; j < 8; ++j) { v[j] = v[j] * r * ga[j] + sb[j];
                if (OUT8) *(unsigned*)((unsigned char*)HN + (size_t)t * DM + 4 * (lane + 64 * j)) = pg8::pk4_fp8(v[j].x, v[j].y, v[j].z, v[j].w);
                else { v2u o; o.x = pk2(v[j].x, v[j].y); o.y = pk2(v[j].z, v[j].w);
                *(v2u*)(HN + (size_t)t * DM + 4 * (lane + 64 * j)) = o; } }
            if (MODE != 1) {
                float a8[8];
#pragma unroll
                for (int g = 0; g < 8; ++g) { float s = 0.f;
#pragma unroll
                    for (int j = 0; j < 8; ++j) { const f32x4 tv = *(const LAS f32x4*)(sT + g * 2048 + 4 * (lane + 64 * j)); s += dot4(v[j], tv); }
                    a8[g] = wave_sum(s); }
                if (MODE == 0) {
                    if (lane == 0) {
                        f32x4 o0 = {a8[0] + bias8[0], a8[1] + bias8[1], a8[2] + bias8[2], a8[3] + bias8[3]}, o1 = {a8[4] + bias8[4], a8[5] + bias8[5], a8[6] + bias8[6], a8[7] + bias8[7]};
                        *(f32x4*)(gates_out + (size_t)t * 8) = o0; *(f32x4*)(gates_out + (size_t)t * 8 + 4) = o1; }
                } else {
                    if (lane == 0) {
                        int e0 = 0; float v0 = a8[0];
#pragma unroll
                        for (int g = 1; g < 8; ++g) if (a8[g] > v0) { v0 = a8[g]; e0 = g; }
                        int e1 = -1; float v1 = -3.0e38f;
#pragma unroll
                        for (int g = 0; g < 8; ++g) if (g != e0 && a8[g] > v1) { v1 = a8[g]; e1 = g; }
                        const float ex = expf(v1 - v0), g0 = 1.0f / (1.0f + ex), g1 = ex / (1.0f + ex);
                        const unsigned p0 = __hip_atomic_fetch_add(cnt + 64 * e0, 1u, RLX_AGENT), p1 = __hip_atomic_fetch_add(cnt + 64 * e1, 1u, RLX_AGENT);
                        v4u w0; w0.x = (unsigned)e0; w0.y = (unsigned)e1; w0.z = p0; w0.w = p1;
                        v4u w1; w1.x = __float_as_uint(g0); w1.y = __float_as_uint(g1); w1.z = 0u; w1.w = 0u;
                        *(v4u*)(tokinfo + (size_t)t * 8) = w0; *(v4u*)(tokinfo + (size_t)t * 8 + 4) = w1; }
                }
            }
        }
    }
    if (MODE != 1) __syncthreads();
}

template <int W>
__device__ __forceinline__ void pool_rows(const bf16* __restrict__ PROJ, bf16* __restrict__ POOLED, int tb, int posb, int col) {
    float h0[W - 1], h1[W - 1];
#pragma unroll
    for (int j = 0; j < W - 1; ++j) { const bool in = posb - 1 - j >= 0; const unsigned rr = *(const unsigned*)(PROJ + (size_t)(in ? tb - 1 - j : tb) * DINP + 4096 + col); const unsigned r = in ? rr : 0u; h0[j] = bflo(r); h1[j] = bfhi(r); }
    for (int i8 = 0; i8 < 32; i8 += 8) {
        unsigned r8[8];
#pragma unroll
        for (int ii = 0; ii < 8; ++ii) r8[ii] = *(const unsigned*)(PROJ + (size_t)(tb + i8 + ii) * DINP + 4096 + col);
#pragma unroll
        for (int ii = 0; ii < 8; ++ii) {
            const int t = tb + i8 + ii, pos = posb + i8 + ii, cnt = (pos + 1 < W) ? pos + 1 : W;
            const float x0 = bflo(r8[ii]), x1 = bfhi(r8[ii]);
            float s0 = x0, s1 = x1;
#pragma unroll
            for (int j = 0; j < W - 1; ++j) { s0 += h0[j]; s1 += h1[j]; }
            const float ic = __builtin_amdgcn_rcpf((float)cnt);
            *(unsigned*)(POOLED + (size_t)t * 1024 + col) = pk2(s0 * ic - x0, s1 * ic - x1);
#pragma unroll
            for (int j = W - 2; j > 0; --j) { h0[j] = h0[j - 1]; h1[j] = h1[j - 1]; }
            h0[0] = x0; h1[0] = x1;
        }
    }
}
__device__ __forceinline__ void prep_phase(Frame& F, const Args& args) {
    int tid = threadIdx.x; asm volatile("" : "+v"(tid)); const int lane = tid & 63, wave = __builtin_amdgcn_readfirstlane(tid >> 6);
    unsigned char* ws = F.ws;
    const bf16* __restrict__ PROJ = (const bf16*)(ws + WS_PROJ); const float* __restrict__ GATES = (const float*)(ws + WS_GATES);
    float* __restrict__ BCUM = (float*)(ws + WS_BCUM); float* __restrict__ IG = (float*)(ws + WS_IG); float* __restrict__ GTOT = (float*)(ws + WS_GTOT); float* __restrict__ DN = (float*)(ws + WS_DN);
    bf16* __restrict__ QB = (bf16*)(ws + WS_QB); bf16* __restrict__ KB = (bf16*)(ws + WS_KB); bf16* __restrict__ KWT = (bf16*)(ws + WS_KWT); bf16* __restrict__ AP = (bf16*)(ws + WS_AP); bf16* __restrict__ BP = (bf16*)(ws + WS_BP);
    bf16* __restrict__ POOLED = (bf16*)(ws + WS_POOLED);
    const float* __restrict__ convw = args.in[9]; const float* __restrict__ convb = args.in[10];
    LAS float* sB = (LAS float*)(F.lds); LAS float* sI = sB + 256; LAS float* sW = sI + 256;
    LAS unsigned* TK = (LAS unsigned*)(F.lds + 4096); LAS unsigned* TV = TK + 128 * 129;
    for (int task = F.bid; task < 2 * NUNIT; task += F.G) {
        const int u = task >> 1, half = task & 1, b = u >> 6, h = (u >> 4) & 3, c = u & 15, t0 = b * SEQ + c * 256;
        float sc = 0.f, ir = 0.f;
        if (tid < 256) { const float fr = GATES[(size_t)(t0 + tid) * 8 + 4 + h]; ir = GATES[(size_t)(t0 + tid) * 8 + h]; sc = logsig(fr);
#pragma unroll
            for (int o = 1; o < 64; o <<= 1) { const float y = __shfl_up(sc, o); if (lane >= o) sc += y; }
            sI[tid] = ir; if (lane == 63) sW[wave] = sc; }
        __syncthreads();
        if (tid < 256) { for (int w2 = 0; w2 < wave; ++w2) sc += sW[w2]; sB[tid] = sc; if (half == 0) { BCUM[u * 256 + tid] = sc; IG[u * 256 + tid] = ir; } }
        __syncthreads();
        const float Gt = sB[255];
        if (half == 0 && tid == 0) GTOT[u] = Gt;
        {
            const int cp = tid & 63, tg = tid >> 6, dc = half * 128 + 2 * cp, chq = h * 256 + dc, chk = 1024 + h * 256 + dc, chv = 2048 + h * 256 + dc;
            float wq[4][2], wk[4][2], bq[2], bk[2];
#pragma unroll
            for (int j = 0; j < 4; ++j) { wq[j][0] = convw[j * 2048 + chq]; wq[j][1] = convw[j * 2048 + chq + 1]; wk[j][0] = convw[j * 2048 + chk]; wk[j][1] = convw[j * 2048 + chk + 1]; }
            bq[0] = convb[chq]; bq[1] = convb[chq + 1]; bk[0] = convb[chk]; bk[1] = convb[chk + 1];
            const int tl0 = tg * 32, pos0 = c * 256 + tl0;
            float xq[3][2], xk[3][2];
#pragma unroll
            for (int jj = 0; jj < 3; ++jj) { const int p = pos0 - 3 + jj; unsigned rq = 0u, rk = 0u;
                if (p >= 0) { const bf16* row = PROJ + (size_t)(b * SEQ + p) * DINP; rq = *(const unsigned*)(row + chq); rk = *(const unsigned*)(row + chk); }
                xq[jj][0] = bflo(rq); xq[jj][1] = bfhi(rq); xk[jj][0] = bflo(rk); xk[jj][1] = bfhi(rk); }
            for (int i8 = 0; i8 < 32; i8 += 8) {
                unsigned rq8[8], rk8[8], rv8[8];
#pragma unroll
                for (int ii = 0; ii < 8; ++ii) { const bf16* row = PROJ + (size_t)(t0 + tl0 + i8 + ii) * DINP; rq8[ii] = *(const unsigned*)(row + chq); rk8[ii] = *(const unsigned*)(row + chk); rv8[ii] = *(const unsigned*)(row + chv); }
                float pkw0 = 0.f, pkw1 = 0.f, pv0 = 0.f, pv1 = 0.f;
#pragma unroll
                for (int ii = 0; ii < 8; ++ii) {
                    const int tl = tl0 + i8 + ii; const unsigned rq = rq8[ii], rk = rk8[ii], rv = rv8[ii];
                    const float cq0 = bflo(rq), cq1 = bfhi(rq), ck0 = bflo(rk), ck1 = bfhi(rk);
                    const float yq0 = bq[0] + wq[0][0] * xq[0][0] + wq[1][0] * xq[1][0] + wq[2][0] * xq[2][0] + wq[3][0] * cq0;
                    const float yq1 = bq[1] + wq[0][1] * xq[0][1] + wq[1][1] * xq[1][1] + wq[2][1] * xq[2][1] + wq[3][1] * cq1;
                    const float yk0 = bk[0] + wk[0][0] * xk[0][0] + wk[1][0] * xk[1][0] + wk[2][0] * xk[2][0] + wk[3][0] * ck0;
                    const float yk1 = bk[1] + wk[0][1] * xk[0][1] + wk[1][1] * xk[1][1] + wk[2][1] * xk[2][1] + wk[3][1] * ck1;
                    xq[0][0] = xq[1][0]; xq[1][0] = xq[2][0]; xq[2][0] = cq0; xq[0][1] = xq[1][1]; xq[1][1] = xq[2][1]; xq[2][1] = cq1;
                    xk[0][0] = xk[1][0]; xk[1][0] = xk[2][0]; xk[2][0] = ck0; xk[0][1] = xk[1][1]; xk[1][1] = xk[2][1]; xk[2][1] = ck1;
                    const float q0 = yq0 * __builtin_amdgcn_rcpf(1.0f + __expf(-yq0)) * 0.0625f, q1 = yq1 * __builtin_amdgcn_rcpf(1.0f + __expf(-yq1)) * 0.0625f;
                    const float k0 = yk0 * __builtin_amdgcn_rcpf(1.0f + __expf(-yk0)), k1 = yk1 * __builtin_amdgcn_rcpf(1.0f + __expf(-yk1));
                    const float bt = sB[tl], it = sI[tl], eb = __expf(bt), kwf = __expf(Gt - bt + it);
                    const size_t ro = (size_t)u * 256 + tl;
                    *(unsigned*)(QB + ro * 256 + dc) = pk2(q0, q1);
                    *(unsigned*)(AP + ro * 512 + dc) = pk2(eb * q0, eb * q1);
                    *(unsigned*)(KB + ro * 256 + dc) = pk2(k0, k1);
                    const float kw0 = kwf * k0, kw1 = kwf * k1, v0 = bflo(rv), v1 = bfhi(rv);
                    if (ii & 1) { TK[(2 * cp) * 129 + (tl >> 1)] = pk2(pkw0, kw0); TK[(2 * cp + 1) * 129 + (tl >> 1)] = pk2(pkw1, kw1);
                                  TV[(2 * cp) * 129 + (tl >> 1)] = pk2(pv0, v0);   TV[(2 * cp + 1) * 129 + (tl >> 1)] = pk2(pv1, v1); }
                    else { pkw0 = kw0; pkw1 = kw1; pv0 = v0; pv1 = v1; }
                }
            }
        }
        __syncthreads();
        for (int idx = tid; idx < 128 * 32; idx += 512) { const int dl = idx >> 5, ch = idx & 31;
            v4u o; o.x = TK[dl * 129 + 4 * ch]; o.y = TK[dl * 129 + 4 * ch + 1]; o.z = TK[dl * 129 + 4 * ch + 2]; o.w = TK[dl * 129 + 4 * ch + 3];
            *(v4u*)(KWT + ((size_t)u * 256 + half * 128 + dl) * 256 + 8 * ch) = o;
            o.x = TV[dl * 129 + 4 * ch]; o.y = TV[dl * 129 + 4 * ch + 1]; o.z = TV[dl * 129 + 4 * ch + 2]; o.w = TV[dl * 129 + 4 * ch + 3];
            *(v4u*)(BP + ((size_t)u * 256 + half * 128 + dl) * 512 + 256 + 8 * ch) = o; }
        if (tid < 128) { float s = 0.f; for (int w2 = 0; w2 < 128; ++w2) { const unsigned p = TK[tid * 129 + w2]; s += bflo(p) + bfhi(p); } DN[u * 256 + half * 128 + tid] = s; }
        __syncthreads();
    }
    for (int pb = F.bid; pb < NTOK / 32; pb += F.G) {
        const int col = 2 * tid, g = __builtin_amdgcn_readfirstlane(col >> 8), tb = pb * 32, posb = tb & (SEQ - 1);
        if (g == 0) pool_rows<2>(PROJ, POOLED, tb, posb, col); else if (g == 1) pool_rows<4>(PROJ, POOLED, tb, posb, col);
        else if (g == 2) pool_rows<8>(PROJ, POOLED, tb, posb, col); else pool_rows<16>(PROJ, POOLED, tb, posb, col);
    }
}

__device__ __forceinline__ void scan_phase(Frame& F) {
    int tid = threadIdx.x; asm volatile("" : "+v"(tid)); const int lane = tid & 63, wave = __builtin_amdgcn_readfirstlane(tid >> 6); (void)lane; (void)wave;
    unsigned char* ws = F.ws;
    const float* DCT = (const float*)(ws + WS_DCT); const float* GTOT = (const float*)(ws + WS_GTOT); const float* DN = (const float*)(ws + WS_DN);
    bf16* BP = (bf16*)(ws + WS_BP); float* NVEC = (float*)(ws + WS_NVEC);
    for (int eg = F.bid * 512 + tid; eg < 8 * 16384; eg += F.G * 512) {
        const int bh = eg >> 14, rem = eg & 16383, e = rem >> 6, d4 = (rem & 63) * 4;
        f32x4 C = {0.f, 0.f, 0.f, 0.f};
        for (int c = 0; c < 16; ++c) { const int u = bh * 16 + c;
            v2u o; o.x = pk2(C.x, C.y); o.y = pk2(C.z, C.w);
            *(v2u*)(BP + ((size_t)u * 256 + e) * 512 + d4) = o;
            const f32x4 d = *(const f32x4*)(DCT + ((size_t)u * 256 + e) * 256 + d4);
            C = C * __expf(GTOT[u]) + d; }
    }
    for (int id = F.bid * 512 + tid; id < 2048; id += F.G * 512) {
        const int bh = id >> 8, d = id & 255; float n = 0.f;
        for (int c = 0; c < 16; ++c) { const int u = bh * 16 + c; NVEC[u * 256 + d] = n; n = n * __expf(GTOT[u]) + DN[u * 256 + d]; }
    }
}

typedef float f32x16 __attribute__((ext_vector_type(16)));
typedef short s16x8 __attribute__((ext_vector_type(8)));
typedef float f32x2_t __attribute__((ext_vector_type(2))); typedef __bf16 bf16x2_t __attribute__((ext_vector_type(2)));
__device__ __forceinline__ unsigned cvtpk_s(float lo, float hi) { f32x2_t v = {lo, hi}; bf16x2_t b = __builtin_convertvector(v, bf16x2_t); return __builtin_bit_cast(unsigned, b); }
__device__ __forceinline__ void attn_phase(Frame& F) {
    int tid = threadIdx.x; asm volatile("" : "+v"(tid)); const int lane = tid & 63, wave = __builtin_amdgcn_readfirstlane(tid >> 6);
    unsigned char* ws = F.ws;
    const bf16* QB = (const bf16*)(ws + WS_QB2); const bf16* KB = (const bf16*)(ws + WS_KB2); const bf16* VT = (const bf16*)(ws + WS_VT);
    bf16* ATTO = (bf16*)(ws + WS_ATTO);
    const int gw = F.bid * NWAVES + wave, NGW = F.G * NWAVES;
    const int r = lane & 31, hlf = lane >> 5;
    for (int p = gw; p < 4096; p += NGW) {
        const int qt = p & 127, hh = (p >> 7) & 15, b = p >> 11, t0 = qt * 32;
        const size_t hb = ((size_t)(b * 16 + hh) * 128) * 4096; const int lo16 = r * 16 + hlf * 8;
        const bf16* qrow = QB + hb + (size_t)qt * 4096 + lo16;
        s16x8 qf[8];
#pragma unroll
        for (int kk = 0; kk < 8; ++kk) qf[kk] = *(const s16x8*)(qrow + 512 * kk);
        f32x16 O[4];
#pragma unroll
        for (int et = 0; et < 4; ++et)
#pragma unroll
            for (int i = 0; i < 16; ++i) O[et][i] = 0.f;
        float R = 1.0f;
        s16x8 kf[8];
        { const bf16* krow = KB + hb + (size_t)qt * 4096 + lo16;
#pragma unroll
          for (int kk = 0; kk < 8; ++kk) kf[kk] = *(const s16x8*)(krow + 512 * kk); }
        for (int s0 = t0; ; s0 -= 32) {
            s16x8 vf[8];
            { const bf16* vp = VT + hb + (size_t)(s0 >> 5) * 4096 + lo16;
#pragma unroll
              for (int q = 0; q < 8; ++q) vf[q] = *(const s16x8*)(vp + 512 * q); }
            __builtin_amdgcn_sched_barrier(0);
            f32x16 zt;
#pragma unroll
            for (int i = 0; i < 16; ++i) zt[i] = 0.f;
#pragma unroll
            for (int kk = 0; kk < 8; ++kk) zt = __builtin_amdgcn_mfma_f32_32x32x16_bf16(kf[kk], qf[kk], zt, 0, 0, 0);
            __builtin_amdgcn_sched_barrier(0);
            { const int sn = (s0 >= 32) ? s0 - 32 : s0;
              const bf16* krow = KB + hb + (size_t)(sn >> 5) * 4096 + lo16;
#pragma unroll
              for (int kk = 0; kk < 8; ++kk) kf[kk] = *(const s16x8*)(krow + 512 * kk); }
            __builtin_amdgcn_sched_barrier(0);
            const bool diag = (s0 == t0);
            float sg[16], om[16];
            if (diag) {
#pragma unroll
                for (int i = 0; i < 16; ++i) { const int sl = (i & 3) + 8 * (i >> 2) + 4 * hlf;
                    const float s = __builtin_amdgcn_rcpf(1.0f + __builtin_amdgcn_exp2f(-zt[i]));
                    const bool valid = sl < r;
                    sg[i] = valid ? s : 0.f; om[i] = valid ? 1.0f - s : 1.0f; }
            } else {
#pragma unroll
                for (int i = 0; i < 16; ++i) { const float s = __builtin_amdgcn_rcpf(1.0f + __builtin_amdgcn_exp2f(-zt[i])); sg[i] = s; om[i] = 1.0f - s; }
            }
            float Sg[4], Pg[4], tot[4];
#pragma unroll
            for (int g = 0; g < 4; ++g) { Sg[g] = (om[4 * g] * om[4 * g + 1]) * (om[4 * g + 2] * om[4 * g + 3]); Pg[g] = __shfl_xor(Sg[g], 32); tot[g] = Sg[g] * Pg[g]; }
            float after[4]; after[3] = 1.0f; after[2] = tot[3]; after[1] = tot[3] * tot[2]; after[0] = (tot[3] * tot[2]) * tot[1];
            const float T = ((tot[3] * tot[2]) * tot[1]) * tot[0];
            float A[16];
#pragma unroll
            for (int g = 0; g < 4; ++g) { float run = R * after[g] * (hlf == 0 ? Pg[g] : 1.0f);
#pragma unroll
                for (int w = 3; w >= 0; --w) { const int i = 4 * g + w; A[i] = sg[i] * run; run *= om[i]; } }
            R *= T;
#pragma unroll
            for (int sp = 0; sp < 2; ++sp) {
                v4u xa; xa.x = cvtpk_s(A[8 * sp], A[8 * sp + 1]); xa.y = cvtpk_s(A[8 * sp + 2], A[8 * sp + 3]); xa.z = cvtpk_s(A[8 * sp + 4], A[8 * sp + 5]); xa.w = cvtpk_s(A[8 * sp + 6], A[8 * sp + 7]);
                const s16x8 xf = __builtin_bit_cast(s16x8, xa);
#pragma unroll
                for (int et = 0; et < 4; ++et) {
                    O[et] = __builtin_amdgcn_mfma_f32_32x32x16_bf16(xf, vf[sp * 4 + et], O[et], 0, 0, 0);
                }
            }
            if (s0 == 0 || __all(R == 0.f)) break;
        }
        { LAS unsigned char* ot = F.lds + wave * 8704;
#pragma unroll
          for (int et = 0; et < 4; ++et)
#pragma unroll
              for (int i = 0; i < 16; ++i) { const int tr = (i & 3) + 8 * (i >> 2) + 4 * hlf;
                  *(LAS bf16*)(ot + tr * 272 + (32 * et + r) * 2) = (bf16)(cvtpk_s(O[et][i], 0.f) & 0xffffu); }
          LDS_WAIT();
#pragma unroll
          for (int q = 0; q < 8; ++q) { const int tr = 4 * q + (lane >> 4), ch = lane & 15;
              const v4u o = *(const LAS v4u*)(ot + tr * 272 + 16 * ch);
              *(v4u*)(ATTO + (size_t)(b * SEQ + t0 + tr) * DM + hh * 128 + 8 * ch) = o; }
          LDS_WAIT(); }
    }
}

__device__ __forceinline__ void moe_bases(const gu32* cnt, int (&base)[8], int (&cn)[8]) {
    int acc = 0;
#pragma unroll
    for (int e = 0; e < 8; ++e) { cn[e] = (int)__hip_atomic_load(cnt + 64 * e, RLX_AGENT); base[e] = acc; acc += (cn[e] + 255) & ~255; }
}
__device__ __forceinline__ void gather_phase(Frame& F) {
    int tid = threadIdx.x; asm volatile("" : "+v"(tid)); const int lane = tid & 63, wave = __builtin_amdgcn_readfirstlane(tid >> 6);
    unsigned char* ws = F.ws;
    const unsigned* TOKINFO = (const unsigned*)(ws + WS_TOKINFO); int* TOKSLOT = (int*)(ws + WS_TOKSLOT); float* SLOTGATE = (float*)(ws + WS_SLOTGATE);
    const bf16* HN = (const bf16*)(ws + WS_HN); unsigned char* HPERM = ws + WS_HPERM;
    int base[8], cn[8]; moe_bases(F.ctl + CW_CNT, base, cn);
    const int gw = F.bid * NWAVES + wave, NGW = F.G * NWAVES;
    for (int p0 = gw * 4; p0 < NTOK; p0 += NGW * 4) {
        v4u w0[4], w1[4];
#pragma unroll
        for (int i = 0; i < 4; ++i) { w0[i] = *(const v4u*)(TOKINFO + (size_t)(p0 + i) * 8); w1[i] = *(const v4u*)(TOKINFO + (size_t)(p0 + i) * 8 + 4); }
        v4u v[4][4];
#pragma unroll
        for (int i = 0; i < 4; ++i) { const v4u* src = (const v4u*)(HN + (size_t)(p0 + i) * DM);
#pragma unroll
            for (int j = 0; j < 4; ++j) v[i][j] = src[lane + 64 * j]; }
#pragma unroll
        for (int i = 0; i < 4; ++i) {
            int b0 = 0, b1 = 0;
#pragma unroll
            for (int e = 0; e < 8; ++e) { b0 = ((int)w0[i].x == e) ? base[e] : b0; b1 = ((int)w0[i].y == e) ? base[e] : b1; }
            const int s0 = b0 + (int)w0[i].z, s1 = b1 + (int)w0[i].w;
            v2u* d0 = (v2u*)(HPERM + (size_t)s0 * DM); v2u* d1 = (v2u*)(HPERM + (size_t)s1 * DM);
#pragma unroll
            for (int j = 0; j < 4; ++j) { const v4u x = v[i][j];
                v2u o; o.x = pg8::pk4_fp8(bflo(x.x), bfhi(x.x), bflo(x.y), bfhi(x.y)); o.y = pg8::pk4_fp8(bflo(x.z), bfhi(x.z), bflo(x.w), bfhi(x.w));
                d0[lane + 64 * j] = o; d1[lane + 64 * j] = o; }
            if (lane == 0) { TOKSLOT[(p0 + i) * 2] = s0; TOKSLOT[(p0 + i) * 2 + 1] = s1; SLOTGATE[s0] = __uint_as_float(w1[i].x); SLOTGATE[s1] = __uint_as_float(w1[i].y); }
        }
    }
    for (int q = gw; q < 2048; q += NGW) {
        const int e = q >> 8, r = q & 255;
        int be = 0, ce = 0;
#pragma unroll
        for (int k = 0; k < 8; ++k) { be = (e == k) ? base[k] : be; ce = (e == k) ? cn[k] : ce; }
        if ((ce & 255) != 0 && r >= (ce & 255)) { const int row = be + (ce & ~255) + r; v4u* d = (v4u*)(HPERM + (size_t)row * DM); const v4u z = {0u, 0u, 0u, 0u};
#pragma unroll
            for (int j = 0; j < 2; ++j) d[lane + 64 * j] = z;
            if (lane == 0) SLOTGATE[row] = 0.f; }
    }
}

__device__ __forceinline__ void route_phase(Frame& F, const bf16* xin, const float* gain, const float* modl, int sh_off, int sc_off, const float* tab, gu32* cnt, gu32* donec) {
    int tid = threadIdx.x; asm volatile("" : "+v"(tid)); const int lane = tid & 63, wave = __builtin_amdgcn_readfirstlane(tid >> 6);
    unsigned char* ws = F.ws;
    int* TOKSLOT = (int*)(ws + WS_TOKSLOT); float* SLOTGATE = (float*)(ws + WS_SLOTGATE); unsigned char* HPERM = ws + WS_HPERM;
    LAS float* sT = (LAS float*)(F.lds);
    LAS unsigned* lcnt = (LAS unsigned*)(F.lds + 65536 + 16384);
    for (int i = tid; i < 16384; i += 512) sT[i] = tab[i];
    if (tid < 16) lcnt[tid] = 0u;
    __syncthreads();
    const int gw = F.bid * NWAVES + wave, NGW = F.G * NWAVES, t0 = gw * 4;
    unsigned rowq[4][8]; int e0[4], e1[4]; unsigned p0[4], p1[4]; float g0[4], g1[4];
    if (t0 < NTOK) {
        const int b = t0 >> 12;
        f32x4 ga[8], sb[8];
#pragma unroll
        for (int j = 0; j < 8; ++j) { const int col = 4 * (lane + 64 * j);
            const f32x4 g = *(const f32x4*)(gain + col), sc = *(const f32x4*)(modl + (size_t)b * 12288 + sc_off + col);
            ga[j] = g * (sc + 1.0f); sb[j] = *(const f32x4*)(modl + (size_t)b * 12288 + sh_off + col); }
#pragma unroll
        for (int i = 0; i < 4; ++i) {
            const int t = t0 + i;
            f32x4 v[8]; float ss = 0.f;
#pragma unroll
            for (int j = 0; j < 8; ++j) { const v2u w = *(const v2u*)(xin + (size_t)t * DM + 4 * (lane + 64 * j)); v[j] = (f32x4){bflo(w.x), bfhi(w.x), bflo(w.y), bfhi(w.y)}; ss += dot4(v[j], v[j]); }
            ss = wave_sum(ss);
            const float r = 1.0f / sqrtf(ss * (1.0f / DM) + EPS);
#pragma unroll
            for (int j = 0; j < 8; ++j) { v[j] = v[j] * r * ga[j] + sb[j]; rowq[i][j] = pg8::pk4_fp8(v[j].x, v[j].y, v[j].z, v[j].w); }
            float a8[8]; int zi; asm volatile("v_mov_b32 %0, 0" : "=v"(zi));
#pragma unroll
            for (int g = 0; g < 8; ++g) { float s = 0.f;
#pragma unroll
                for (int j = 0; j < 8; ++j) { const f32x4 tv = *(const LAS f32x4*)(sT + g * 2048 + 4 * (lane + 64 * j) + zi); s += dot4(v[j], tv); }
                a8[g] = wave_sum(s); }
            int ea = 0; float va = a8[0];
#pragma unroll
            for (int g = 1; g < 8; ++g) if (a8[g] > va) { va = a8[g]; ea = g; }
            int eb = -1; float vb = -3.0e38f;
#pragma unroll
            for (int g = 0; g < 8; ++g) if (g != ea && a8[g] > vb) { vb = a8[g]; eb = g; }
            ea = __builtin_amdgcn_readfirstlane(ea); eb = __builtin_amdgcn_readfirstlane(eb);
            const float ex = expf(vb - va); g0[i] = 1.0f / (1.0f + ex); g1[i] = ex / (1.0f + ex);
            unsigned pa = 0u, pb = 0u;
            if (lane == 0) { pa = __hip_atomic_fetch_add((LAS unsigned*)(lcnt + ea), 1u, __ATOMIC_RELAXED, __HIP_MEMORY_SCOPE_WORKGROUP); pb = __hip_atomic_fetch_add((LAS unsigned*)(lcnt + eb), 1u, __ATOMIC_RELAXED, __HIP_MEMORY_SCOPE_WORKGROUP); }
            e0[i] = ea; e1[i] = eb; p0[i] = (unsigned)__builtin_amdgcn_readfirstlane((int)pa); p1[i] = (unsigned)__builtin_amdgcn_readfirstlane((int)pb);
        }
    }
    asm volatile("s_waitcnt vmcnt(0) lgkmcnt(0)" ::: "memory");
    __syncthreads();
    if (tid < 8) { const unsigned n = lcnt[tid]; lcnt[8 + tid] = n ? __hip_atomic_fetch_add(cnt + 64 * tid, n, RLX_AGENT) : 0u; }
    asm volatile("s_waitcnt vmcnt(0) lgkmcnt(0)" ::: "memory");
    __syncthreads();
    if (tid == 0) { __hip_atomic_fetch_add(donec, 1u, RLX_AGENT);
        unsigned sp = 0; while (__hip_atomic_load(donec, RLX_AGENT) < (unsigned)F.G) { __builtin_amdgcn_s_sleep(1); if (++sp > (1u << 22)) break; } }
    __syncthreads();
    int base[8], cn[8]; moe_bases(cnt, base, cn);
    LAS unsigned char* stg = F.lds + 65536 + wave * 2048;
    if (t0 < NTOK) {
#pragma unroll
        for (int i = 0; i < 4; ++i) {
            int b0 = 0, b1 = 0;
#pragma unroll
            for (int e = 0; e < 8; ++e) { b0 = (e0[i] == e) ? base[e] : b0; b1 = (e1[i] == e) ? base[e] : b1; }
            const int s0 = b0 + (int)(lcnt[8 + e0[i]] + p0[i]), s1 = b1 + (int)(lcnt[8 + e1[i]] + p1[i]);
#pragma unroll
            for (int j = 0; j < 8; ++j) *(LAS unsigned*)(stg + 4 * (lane + 64 * j)) = rowq[i][j];
            LDS_WAIT();
            const v4u o0 = *(const LAS v4u*)(stg + 32 * lane), o1 = *(const LAS v4u*)(stg + 32 * lane + 16);
            LDS_WAIT();
            v4u* d0 = (v4u*)(HPERM + (size_t)s0 * DM + 32 * lane); v4u* d1 = (v4u*)(HPERM + (size_t)s1 * DM + 32 * lane);
            d0[0] = o0; d0[1] = o1; d1[0] = o0; d1[1] = o1;
            if (lane == 0) { TOKSLOT[(t0 + i) * 2] = s0; TOKSLOT[(t0 + i) * 2 + 1] = s1; SLOTGATE[s0] = g0[i]; SLOTGATE[s1] = g1[i]; }
        }
    }
    for (int q = gw; q < 2048; q += NGW) {
        const int e = q >> 8, r = q & 255;
        int be = 0, ce = 0;
#pragma unroll
        for (int k = 0; k < 8; ++k) { be = (e == k) ? base[k] : be; ce = (e == k) ? cn[k] : ce; }
        if ((ce & 255) != 0 && r >= (ce & 255)) { const int row = be + (ce & ~255) + r; v4u* d = (v4u*)(HPERM + (size_t)row * DM); const v4u z = {0u, 0u, 0u, 0u};
#pragma unroll
            for (int j = 0; j < 2; ++j) d[lane + 64 * j] = z;
            if (lane == 0) SLOTGATE[row] = 0.f; }
    }
    __syncthreads();
}

__device__ __forceinline__ void final_phase(Frame& F, const Args& args) {
    int tid = threadIdx.x; asm volatile("" : "+v"(tid)); const int lane = tid & 63, wave = __builtin_amdgcn_readfirstlane(tid >> 6); (void)lane; (void)wave;
    unsigned char* ws = F.ws;
    const bf16* XR = (const bf16*)(ws + WS_XR); const bf16* Y = (const bf16*)(ws + WS_Y); const bf16* YP = (const bf16*)(ws + WS_YP); const int* TOKSLOT = (const int*)(ws + WS_TOKSLOT);
    const float* g2 = (const float*)(ws + WS_MOD) + (size_t)2 * 12288 + 10240; const float* gfin = args.in[6]; float* out = args.out;
    const int gw = F.bid * NWAVES + wave, NGW = F.G * NWAVES;
    for (int t = gw; t < NTOK; t += NGW) {
        const int b = t >> 12, s0 = __builtin_amdgcn_readfirstlane(TOKSLOT[t * 2]), s1 = __builtin_amdgcn_readfirstlane(TOKSLOT[t * 2 + 1]);
        f32x4 v[8]; float ss = 0.f;
        if (s0 < 16384 && s1 < 16384) {
            v2u xw[8], y0[8], y1[8]; f32x4 g[8];
#pragma unroll
            for (int j = 0; j < 8; ++j) { const int col = 4 * (lane + 64 * j);
                xw[j] = *(const v2u*)(XR + (size_t)t * DM + col); g[j] = *(const f32x4*)(g2 + (size_t)b * 12288 + col);
                y0[j] = *(const v2u*)(Y + (size_t)s0 * DM + col); y1[j] = *(const v2u*)(Y + (size_t)s1 * DM + col); }
#pragma unroll
            for (int j = 0; j < 8; ++j) { const f32x4 x = {bflo(xw[j].x), bfhi(xw[j].x), bflo(xw[j].y), bfhi(xw[j].y)};
                f32x4 ys = {0.f, 0.f, 0.f, 0.f};
                ys.x += bflo(y0[j].x); ys.y += bfhi(y0[j].x); ys.z += bflo(y0[j].y); ys.w += bfhi(y0[j].y);
                ys.x += bflo(y1[j].x); ys.y += bfhi(y1[j].x); ys.z += bflo(y1[j].y); ys.w += bfhi(y1[j].y);
                v[j] = x + g[j] * ys; ss += dot4(v[j], v[j]); }
        } else {
            const bf16* r0[4]; const bf16* r1[4]; float w0[4], w1[4];
#pragma unroll
            for (int q = 0; q < 4; ++q) {
                r0[q] = (s0 < 16384) ? Y + (size_t)s0 * DM : YP + ((size_t)q * 1792 + (s0 - 16384)) * DM; w0[q] = (s0 < 16384 && q > 0) ? 0.f : 1.f;
                r1[q] = (s1 < 16384) ? Y + (size_t)s1 * DM : YP + ((size_t)q * 1792 + (s1 - 16384)) * DM; w1[q] = (s1 < 16384 && q > 0) ? 0.f : 1.f; }
#pragma unroll
            for (int jh = 0; jh < 8; jh += 4) {
                v2u xw[4], ya[4][4], yb[4][4]; f32x4 g[4];
#pragma unroll
                for (int jj = 0; jj < 4; ++jj) { const int col = 4 * (lane + 64 * (jh + jj));
                    xw[jj] = *(const v2u*)(XR + (size_t)t * DM + col); g[jj] = *(const f32x4*)(g2 + (size_t)b * 12288 + col);
#pragma unroll
                    for (int q = 0; q < 4; ++q) { ya[jj][q] = *(const v2u*)(r0[q] + col); yb[jj][q] = *(const v2u*)(r1[q] + col); } }
#pragma unroll
                for (int jj = 0; jj < 4; ++jj) { const f32x4 x = {bflo(xw[jj].x), bfhi(xw[jj].x), bflo(xw[jj].y), bfhi(xw[jj].y)};
                    f32x4 ys = {0.f, 0.f, 0.f, 0.f};
#pragma unroll
                    for (int q = 0; q < 4; ++q) {
                        ys.x += w0[q] * bflo(ya[jj][q].x) + w1[q] * bflo(yb[jj][q].x); ys.y += w0[q] * bfhi(ya[jj][q].x) + w1[q] * bfhi(yb[jj][q].x);
                        ys.z += w0[q] * bflo(ya[jj][q].y) + w1[q] * bflo(yb[jj][q].y); ys.w += w0[q] * bfhi(ya[jj][q].y) + w1[q] * bfhi(yb[jj][q].y); }
                    v[jh + jj] = x + g[jj] * ys; ss += dot4(v[jh + jj], v[jh + jj]); }
            }
        }
        ss = wave_sum(ss);
        const float r = 1.0f / sqrtf(ss * (1.0f / DM) + EPS);
#pragma unroll
        for (int j = 0; j < 8; ++j) { const int col = 4 * (lane + 64 * j); const f32x4 g = *(const f32x4*)(gfin + col); *(f32x4*)(out + (size_t)t * DM + col) = v[j] * r * g; }
    }
}

__device__ __forceinline__ void panel_handoff(gu32* cnt, int my_pm, bool has, int need_pm, unsigned need) {
    int tid = threadIdx.x; asm volatile("" : "+v"(tid));
    asm volatile("s_waitcnt vmcnt(0)" ::: "memory");
    __syncthreads();
    if (tid == 0) {
        if (has) __hip_atomic_fetch_add(cnt + 64 * my_pm, 1u, RLX_AGENT);
        unsigned sp = 0; while (__hip_atomic_load(cnt + 64 * need_pm, RLX_AGENT) < need) { __builtin_amdgcn_s_sleep(1); if (++sp > (1u << 22)) break; }
        __builtin_amdgcn_fence(__ATOMIC_ACQUIRE, "agent"); asm volatile("s_waitcnt vmcnt(0)" ::: "memory");
    }
    __syncthreads();
}
__global__ void __launch_bounds__(NWAVES * 64, 2) hybrid_fwd(Args args) {
    extern __shared__ __attribute__((aligned(16))) unsigned char lds[];
    Frame F;
    F.lds = (LAS unsigned char*)lds;
    F.MISC = (volatile LAS unsigned*)(F.lds + MISC_OFF);
    F.G = gridDim.x; F.bid = blockIdx.x;
    unsigned char* ws = args.ws; F.ws = ws;
    F.ctl = (gu32*)(ws + WS_CTL);
    for (int u = threadIdx.x; u < (LDS_BYTES - LDSCTL_OFF) / 4; u += NWAVES * 64) ((LAS unsigned*)(F.lds + LDSCTL_OFF))[u] = 0u;
    __syncthreads();
    XcdBarrier bar = xcd_barrier_post((unsigned*)(F.ctl + CW_BAR), F.MISC + 8);
#define GRID_BAR() xcd_barrier(bar)
    using namespace pg8;
    PG8_LAS unsigned char* ring = F.lds + RING_OFF;
    const float* MOD = (const float*)(ws + WS_MOD);
    bf16* HN = (bf16*)(ws + WS_HN); bf16* XR = (bf16*)(ws + WS_XR);

#if SKELETON
    for (int k = 0; k < 20; ++k) GRID_BAR();
    for (size_t i = (size_t)F.bid * 512 + threadIdx.x; i < (size_t)NTOK * DM / 4; i += (size_t)F.G * 512) ((f32x4*)args.out)[i] = ((const f32x4*)args.in[0])[i];
#else
    p0_prologue(F, args);
    { int tid = threadIdx.x; asm volatile("" : "+v"(tid));
      if (tid == 0) { unsigned sp = 0; while (__hip_atomic_load(F.ctl + CW_P0PUB, RLX_AGENT) < (unsigned)F.G) { __builtin_amdgcn_s_sleep(1); if (++sp > (1u << 22)) break; }
          __builtin_amdgcn_fence(__ATOMIC_ACQUIRE, "agent"); asm volatile("s_waitcnt vmcnt(0)" ::: "memory"); }
      __syncthreads();
      norm_phase<0, false>(F, args.in[0], args.in[4], MOD, 0, 2048, HN, (const float*)(ws + WS_GWT), args.in[8], (float*)(ws + WS_GATES), nullptr, nullptr);
      const int cv0 = (F.G == 256 ? P0_TILE0 : 0) + F.bid;
      convert_tiles(F, args, cv0 + 2 * F.G, NT_ALL - QCVT_N, F.G); }
    GRID_BAR();
    { Dims g{DM, DM, DM}; DenseOrder S; S.init(NTOK, DINP, F.G, F.bid, HN, ws + WS_WIN, DM, DM); EpiBf16 E{(bf16*)(ws + WS_PROJ), DINP};
      gemm_phase<EpiBf16, DenseOrder, true, true>(ring, g, S, E);
      if (TAILQ2 > 0 && F.G == 256 && (long)((S.nwg + F.G - 1) / F.G - 1) * F.G + F.bid >= S.nwg) { const int k = F.bid - (S.nwg % F.G); convert_tiles(F, args, k, 128 * TAILQ2, 128); } }
    GRID_BAR();
    prep_phase(F, args);
    GRID_BAR();
    { const int hg = F.G / 2, lo = (F.bid < hg) ? F.bid : -1, hi = (F.bid >= hg) ? F.bid - hg : -1;
      { Dims g{256, 256, 256}; BatchOrder S{NUNIT, hg, lo, (const char*)(ws + WS_QB), (const char*)(ws + WS_KB), (size_t)256 * 256 * 2, (size_t)256 * 256 * 2};
        EpiW E{(bf16*)(ws + WS_AP), (const float*)(ws + WS_BCUM), (const float*)(ws + WS_IG)};
        gemm_phase<EpiW, BatchOrder, true, true>(ring, g, S, E); }
      { Dims g{512, 256, 256}; BatchOrder S{NUNIT, F.G - hg, hi, (const char*)(ws + WS_BP) + 512, (const char*)(ws + WS_KWT), (size_t)256 * 512 * 2, (size_t)256 * 256 * 2};
        EpiDC E{(float*)(ws + WS_DCT)};
        gemm_phase<EpiDC, BatchOrder, true, true>(ring, g, S, E);
        if (TAILQ4 > 0 && F.G == 256 && hi >= 0) convert_tiles(F, args, 128 * (TAILQ2 + TAILQ10 + TAILQ6) + hi, 128 * (TAILQ2 + TAILQ10 + TAILQ6 + TAILQ4), 128); }
      { Dims g{1024, 256, 256}; PoolOrder S{hg, lo, (const char*)(ws + WS_POOLED), (const char*)(ws + WS_POOLW)};
        EpiPool E{(bf16*)(ws + WS_MIXCAT), args.in[13]};
        gemm_phase<EpiPool, PoolOrder, true, true>(ring, g, S, E); } }
    GRID_BAR();
    scan_phase(F);
    GRID_BAR();
    { LAS float* sDen = (LAS float*)(F.lds + RING_OFF + RING_BYTES); LAS float* sSS = sDen + 256;
      if (F.bid < NUNIT) {
          int tid = threadIdx.x; asm volatile("" : "+v"(tid)); const int lane = tid & 63, wave = __builtin_amdgcn_readfirstlane(tid >> 6);
          const bf16* ap0 = (const bf16*)(ws + WS_AP) + (size_t)F.bid * 256 * 512; const f32x4 nv = *(const f32x4*)((const float*)(ws + WS_NVEC) + F.bid * 256 + 4 * lane);
#pragma nounroll
          for (int r0 = wave * 32; r0 < wave * 32 + 32; r0 += 8) {
              v2u qa[8], wa[8];
#pragma unroll
              for (int i = 0; i < 8; ++i) { const bf16* ap = ap0 + (size_t)(r0 + i) * 512; qa[i] = *(const v2u*)(ap + 4 * lane); wa[i] = *(const v2u*)(ap + 256 + 4 * lane); }
#pragma unroll
              for (int i = 0; i < 8; ++i) {
                  const float part = bflo(qa[i].x) * nv.x + bfhi(qa[i].x) * nv.y + bflo(qa[i].y) * nv.z + bfhi(qa[i].y) * nv.w + (bflo(wa[i].x) + bfhi(wa[i].x)) + (bflo(wa[i].y) + bfhi(wa[i].y));
                  const float den = wave_sum(part);
                  if (lane == 0) sDen[r0 + i] = 1.0f / fmaxf(fabsf(den), 1.0f); } }
      }
      Dims g{512, 512, 512}; BatchOrder S{NUNIT, F.G, F.bid, (const char*)(ws + WS_AP), (const char*)(ws + WS_BP), (size_t)256 * 512 * 2, (size_t)256 * 512 * 2};
      EpiFin E{(bf16*)(ws + WS_MIXCAT), (const bf16*)(ws + WS_PROJ), DINP, args.in[11], sDen, sSS, EPS};
      gemm_phase<EpiFin, BatchOrder, true, true>(ring, g, S, E);
      if (TAILQ6 > 0 && F.G == 256 && F.bid >= NUNIT) convert_tiles(F, args, 128 * (TAILQ2 + TAILQ10) + (F.bid - NUNIT), 128 * (TAILQ2 + TAILQ10 + TAILQ6), 128); }
    GRID_BAR();
    { Dims g{DM, DM, DM}; DenseOrder S; S.init(NTOK, DM, F.G, F.bid, ws + WS_MIXCAT, ws + WS_WOUT, DM, DM); EpiResid<false> E{args.in[0], XR, MOD + 4096, 1.0f};
      gemm_phase<EpiResid<false>, DenseOrder, true, true>(ring, g, S, E);
      Unit u0; const bool has = S.next(0, u0);
      if (F.G == 256 && S.nwg == F.G) panel_handoff(F.ctl + CW_PAN8, u0.pm, has, F.bid >> 3, 8u); else GRID_BAR(); }
    norm_phase<1, true, true>(F, XR, args.in[5], MOD, 6144, 8192, HN, nullptr, nullptr, nullptr, nullptr, nullptr);
    GRID_BAR();
    { Dims g{DM / 2, DM / 2, DM / 2}; DenseOrder S; S.init(NTOK, 2 * DFF, F.G, F.bid, HN, ws + WS_W13, DM / 2, DM / 2); EpiSwiglu8 E{ws + WS_U, DFF, 1 << 20, 1.0f / WS8};
      gemm_phase<EpiSwiglu8, DenseOrder, true, true, true>(ring, g, S, E);
      if (TAILQ10 > 0 && F.G == 256 && (long)((S.nwg + F.G - 1) / F.G - 1) * F.G + F.bid >= S.nwg) { const int k = F.bid - (S.nwg % F.G); convert_tiles(F, args, 128 * TAILQ2 + k, 128 * (TAILQ2 + TAILQ10), 128); } }
    GRID_BAR();
    { Dims g{DFF / 2, DFF / 2, DFF / 2}; DenseOrder S; S.init(NTOK, DM, F.G, F.bid, ws + WS_U, ws + WS_W2, DFF / 2, DFF / 2); EpiResid<true> E{XR, XR, MOD + 10240, 1.0f / WS8};
      gemm_phase<EpiResid<true>, DenseOrder, true, true, true>(ring, g, S, E);
      Unit u0; const bool has = S.next(0, u0);
      if (F.G == 256 && S.nwg == F.G) panel_handoff(F.ctl + CW_PAN11, u0.pm, has, F.bid >> 3, 8u); else GRID_BAR(); }
    const float* MOD1 = MOD + 2 * 12288;
    norm_phase<1, true>(F, XR, args.in[4] + DM, MOD1, 0, 2048, HN, nullptr, nullptr, nullptr, nullptr, nullptr);
    GRID_BAR();
    { Dims g{DM, DM, DM}; DenseOrder S; S.init(NTOK, 2 * DM, F.G, F.bid, HN, ws + WS_WQKV, DM, DM); EpiQKblk E{(bf16*)(ws + WS_QB2), (bf16*)(ws + WS_KB2), 0.08838834764831845f * 1.4426950408889634f};
      gemm_phase<EpiQKblk, DenseOrder, true, true>(ring, g, S, E); }
    { Dims g{DM, DM, DM}; DenseOrder S; S.init(DM, NTOK, F.G, F.bid, ws + WS_WQKV + (size_t)2 * DM * DM * 2, HN, DM, DM); EpiVblk E{(bf16*)(ws + WS_VT)};
      gemm_phase<EpiVblk, DenseOrder, true, true>(ring, g, S, E); }
    GRID_BAR();
    attn_phase(F);
    GRID_BAR();
    { Dims g{DM, DM, DM}; DenseOrder S; S.init(NTOK, DM, F.G, F.bid, ws + WS_ATTO, ws + WS_WO, DM, DM); EpiResid<true> E{XR, XR, MOD1 + 4096, 1.0f};
      gemm_phase<EpiResid<true>, DenseOrder, true, true>(ring, g, S, E); }
    GRID_BAR();
    if (F.G * NWAVES * 4 >= NTOK) {
        route_phase(F, XR, args.in[5] + DM, MOD1, 6144, 8192, (const float*)(ws + WS_RWT), F.ctl + CW_CNT, F.ctl + CW_RDONE);
    } else {
        norm_phase<2, true>(F, XR, args.in[5] + DM, MOD1, 6144, 8192, HN, (const float*)(ws + WS_RWT), nullptr, nullptr, (unsigned*)(ws + WS_TOKINFO), F.ctl + CW_CNT);
        GRID_BAR();
        gather_phase(F);
    }
    GRID_BAR();
    { int base[8], cn[8]; moe_bases(F.ctl + CW_CNT, base, cn);
      MoeOrder S; S.G = F.G; S.c = F.bid;
#pragma unroll
      for (int e = 0; e < 8; ++e) S.cumP[e] = base[e] >> 8;
      S.cumP[8] = (base[7] + ((cn[7] + 255) & ~255)) >> 8;
      { S.nNl = 56; S.A = (const char*)(ws + WS_HPERM); S.Bt = (const char*)(ws + WS_W13E); S.tsa = (size_t)256 * DM; S.tsb = (size_t)256 * DM;
        Dims g{DM / 2, DM / 2, DM / 2}; EpiSwiglu8 E{ws + WS_UE, DFE, 56, 1.0f / WS8};
        gemm_phase<EpiSwiglu8, MoeOrder, true, true, true>(ring, g, S, E); }
      convert_tiles<true>(F, args, QCVT_LO, QCVT_LO + QCVT_N, 0, F.ctl + CW_QCVT);
      GRID_BAR();
      { const int Ptot = S.cumP[8];
        SplitOrder T; T.G = F.G; T.c = F.bid; T.A = (const char*)(ws + WS_UE); T.Bt = (const char*)(ws + WS_W2E); T.tsa = (size_t)256 * DFE; T.tsb = (size_t)256 * DFE; T.kq_bytes = DFE / 4;
#pragma unroll
        for (int e = 0; e < 9; ++e) { T.cumP[e] = S.cumP[e]; S.cumP[e] = S.cumP[e] < 64 ? S.cumP[e] : 64; }
        (void)Ptot;
        S.nNl = 8; S.A = (const char*)(ws + WS_UE); S.Bt = (const char*)(ws + WS_W2E); S.tsa = (size_t)256 * DFE; S.tsb = (size_t)256 * DFE;
        { Dims g{DFE / 2, DFE / 2, DFE / 2}; EpiY E{(bf16*)(ws + WS_Y), (const float*)(ws + WS_SLOTGATE), 1.0f / WS8};
          gemm_phase<EpiY, MoeOrder, true, true, true>(ring, g, S, E); }
        { Dims g{DFE / 2, DFE / 2, DFE / 8}; EpiYp E{(bf16*)(ws + WS_YP), (const float*)(ws + WS_SLOTGATE), 1.0f / WS8};
          gemm_phase<EpiYp, SplitOrder, true, true, true>(ring, g, T, E); } }
    }
    GRID_BAR();
    final_phase(F, args);
#endif
}

extern "C" void kernel_launch(void* const* d_in, const int* in_sizes, int n_in, void* d_out, int out_size, void* d_ws, size_t ws_size, hipStream_t stream) {
    static int grid = 0;
    if (grid == 0) {
        if (n_in != 24 || out_size != NTOK * DM || ws_size < WS_END) { fprintf(stderr, "kernel_launch: unexpected shapes (n_in %d, out %d, ws %zu < %zu); nothing launched\n", n_in, out_size, ws_size, (size_t)WS_END); grid = -1; return; }
        int dev = 0, cus = 0, per_cu = 0;
        if (hipGetDevice(&dev) != hipSuccess || hipDeviceGetAttribute(&cus, hipDeviceAttributeMultiprocessorCount, dev) != hipSuccess) { grid = -1; return; }
        if (hipFuncSetAttribute((const void*)hybrid_fwd, hipFuncAttributeMaxDynamicSharedMemorySize, LDS_BYTES) != hipSuccess) { fprintf(stderr, "kernel_launch: hipFuncSetAttribute failed\n"); grid = -1; return; }
        if (hipOccupancyMaxActiveBlocksPerMultiprocessor(&per_cu, (const void*)hybrid_fwd, NWAVES * 64, LDS_BYTES) != hipSuccess || per_cu < 1)
            fprintf(stderr, "kernel_launch: note: occupancy query reports %d workgroups per CU\n", per_cu);
        (void)hipGetLastError();
        grid = cus;
    }
    if (grid < 0) return;
    if (hipMemsetAsync((char*)d_ws + WS_CTL, 0, CTL_ZERO_BYTES, stream) != hipSuccess) return;
    Args a{};
    for (int i = 0; i < 24; ++i) a.in[i] = (const float*)d_in[i];
    a.out = (float*)d_out; a.ws = (unsigned char*)d_ws;
    hipLaunchKernelGGL(hybrid_fwd, dim3(grid), dim3(NWAVES * 64), LDS_BYTES, stream, a);
    const hipError_t le = hipPeekAtLastError();
    if (le != hipSuccess) fprintf(stderr, "kernel_launch: launch failed: %s\n", hipGetErrorName(le));
}
```

```cpp
#include <hip/hip_runtime.h>
#include <cstdio>
#include <cstdint>

#ifndef SKELETON
#define SKELETON 0
#endif

namespace pg8 {
#define PG8_LAS __attribute__((address_space(3)))
typedef unsigned short bf16_t;
typedef short bf16x8 __attribute__((ext_vector_type(8)));
typedef float f32x4 __attribute__((ext_vector_type(4)));
typedef unsigned u32x4 __attribute__((ext_vector_type(4)));
constexpr int BM = 256, BK = 64, HALF = 128, HTB = HALF * BK * 2  , STAGE_BYTES = 8 * HTB, NXCD = 8, WGM = 4;

__host__ __device__ __forceinline__ int lds_byte(int r, int c) { const int st = (r >> 4) * 2 + (c >> 5), rr = r & 15, cc = c & 31, ob = rr * 64 + cc * 2; return st * 1024 + (ob ^ (((ob >> 9) & 1) << 5)); }
__host__ __device__ __forceinline__ void stage_rc(int b, int& R, int& C) { const int st = b / 1024, sb = b % 1024, swz = sb ^ (((sb >> 9) & 1) << 5); R = (st >> 1) * 16 + swz / 64; C = (st & 1) * 32 + (swz % 64) / 2; }
__host__ __device__ __forceinline__ int perm32(int rho) { const int n = rho >> 4, i = rho & 15; return 8 * (i >> 2) + 4 * n + (i & 3); }

struct Unit { int pm, pn; const char* a; const char* b; };
struct Dims { int lda, ldb, K; };

__device__ __forceinline__ unsigned cvt_pk_bf16(float lo, float hi) { unsigned r; asm volatile("v_cvt_pk_bf16_f32 %0, %1, %2" : "=v"(r) : "v"(lo), "v"(hi)); return r; }

__device__ __forceinline__ int xcd_remap(int wgid, int nwg) { const int q = nwg / NXCD, r = nwg % NXCD, xcd = wgid % NXCD, off = wgid / NXCD; return (xcd < r ? xcd * (q + 1) : r * (q + 1) + (xcd - r) * q) + off; }

struct DenseOrder {
    int nM, nN, nwg, G, c; const char* A; const char* Bt; size_t tsa, tsb;
    __device__ __forceinline__ void init(int M, int N, int G_, int c_, const void* A_, const void* Bt_, int lda, int ldb) { nM = M / BM; nN = N / BM; nwg = nM * nN; G = G_; c = c_; A = (const char*)A_; Bt = (const char*)Bt_; tsa = (size_t)BM * lda * 2; tsb = (size_t)BM * ldb * 2; }
    __device__ __forceinline__ bool next(int i, Unit& u) const {
        const long L = (long)i * G + c; if (L >= nwg) return false;
        const int wgid = xcd_remap((int)L, nwg);
        const int nig = WGM * nN, gid = wgid / nig, fm = gid * WGM, gsz = (nM - fm) < WGM ? (nM - fm) : WGM;
        u.pm = fm + ((wgid % nig) % gsz); u.pn = (wgid % nig) / gsz; u.a = A + (size_t)u.pm * tsa; u.b = Bt + (size_t)u.pn * tsb; return true;
    }
    __device__ __forceinline__ void a_ready(const Unit&) const {}
    __device__ __forceinline__ void done(const Unit&) const {}
};
struct BatchOrder {
    int n, G, c; const char* A; const char* Bt; size_t tsa, tsb;
    __device__ __forceinline__ bool next(int i, Unit& u) const { const long L = (long)i * G + c; if (c < 0 || L >= n) return false; u.pm = (int)L; u.pn = (int)L; u.a = A + (size_t)L * tsa; u.b = Bt + (size_t)L * tsb; return true; }
    __device__ __forceinline__ void a_ready(const Unit&) const {}
    __device__ __forceinline__ void done(const Unit&) const {}
};
struct PoolOrder {
    int G, c; const char* A; const char* Bt;
    __device__ __forceinline__ bool next(int i, Unit& u) const { const long L = (long)i * G + c; if (c < 0 || L >= 128) return false; u.pm = (int)L & 31; u.pn = (int)L >> 5; u.a = A + (size_t)u.pm * (256 * 1024 * 2) + (size_t)u.pn * 512; u.b = Bt + (size_t)u.pn * (256 * 256 * 2); return true; }
    __device__ __forceinline__ void a_ready(const Unit&) const {}
    __device__ __forceinline__ void done(const Unit&) const {}
};
struct MoeOrder {
    int G, c, nNl; int cumP[9]; const char* A; const char* Bt; size_t tsa, tsb;
    __device__ __forceinline__ bool next(int i, Unit& u) const {
        const int nwg = cumP[8] * nNl; const long L = (long)i * G + c; if (L >= nwg) return false;
        const int wgid = xcd_remap((int)L, nwg);
        int e = 0;
#pragma unroll
        for (int k = 1; k < 8; ++k) e += (wgid >= cumP[k] * nNl) ? 1 : 0;
        int p0 = cumP[0], p1 = cumP[1];
#pragma unroll
        for (int k = 1; k < 8; ++k) { p0 = (e == k) ? cumP[k] : p0; p1 = (e == k) ? cumP[k + 1] : p1; }
        const int local = wgid - p0 * nNl, Pe = p1 - p0;
        u.pm = p0 + local % Pe; u.pn = e * nNl + local / Pe; u.a = A + (size_t)u.pm * tsa; u.b = Bt + (size_t)u.pn * tsb; return true;
    }
    __device__ __forceinline__ void a_ready(const Unit&) const {}
    __device__ __forceinline__ void done(const Unit&) const {}
};

struct SplitOrder {
    int G, c; int cumP[9]; const char* A; const char* Bt; size_t tsa, tsb; int kq_bytes;
    __device__ __forceinline__ bool next(int i, Unit& u) const {
        const long L = (long)i * G + c; const int n = (cumP[8] - 64) * 32; if (L >= n) return false;
        const int p = 64 + (int)L / 32, rem = (int)L & 31, pnl = rem >> 2, kq = rem & 3;
        int e = 0;
#pragma unroll
        for (int k = 1; k < 8; ++k) e += (p >= cumP[k]) ? 1 : 0;
        u.pm = p; u.pn = pnl + 64 * kq; u.a = A + (size_t)p * tsa + (size_t)kq * kq_bytes; u.b = Bt + (size_t)(e * 8 + pnl) * tsb + (size_t)kq * kq_bytes; return true;
    }
    __device__ __forceinline__ void a_ready(const Unit&) const {}
    __device__ __forceinline__ void done(const Unit&) const {}
};

__device__ __forceinline__ float silu_f(float x) { return x * __builtin_amdgcn_rcpf(1.0f + __expf(-x)); }
typedef float f32x2p __attribute__((ext_vector_type(2)));
__device__ __forceinline__ f32x2p swiglu2(f32x2p a, f32x2p b, float c1, float c2) {
    const f32x2p z = a * c1; f32x2p t; t.x = __builtin_amdgcn_exp2f(z.x); t.y = __builtin_amdgcn_exp2f(z.y);
    const f32x2p d = t + 1.0f; f32x2p s; s.x = __builtin_amdgcn_rcpf(d.x); s.y = __builtin_amdgcn_rcpf(d.y);
    return (a * b) * (s * c2);
}
__device__ __forceinline__ f32x2p sigm2(unsigned w) {
    f32x2p x; x.x = __uint_as_float(w << 16); x.y = __uint_as_float(w & 0xffff0000u);
    const f32x2p z = x * -1.4426950408889634f; f32x2p t; t.x = __builtin_amdgcn_exp2f(z.x); t.y = __builtin_amdgcn_exp2f(z.y);
    const f32x2p d = t + 1.0f; f32x2p s; s.x = __builtin_amdgcn_rcpf(d.x); s.y = __builtin_amdgcn_rcpf(d.y); return s;
}

struct EpiBf16 {
    static constexpr bool PERM = true;
    bf16_t* O; int ldc;
    __device__ __forceinline__ void operator()(const f32x4 (&acc)[2][2][4][2], const Unit& u, int wr, int wc, int fr_, int fq_) const {
        int z_; asm volatile("v_mov_b32 %0, 0" : "=v"(z_)); const int fr = fr_ + z_, fq = fq_ + z_;
        const int row0 = u.pm * BM + wr * 64 + fr, col0 = u.pn * BM + wc * 32 + 8 * fq;
#pragma unroll
        for (int ai = 0; ai < 2; ++ai)
#pragma unroll
            for (int m = 0; m < 4; ++m) { bf16_t* rowp = O + (size_t)(row0 + ai * HALF + m * 16) * ldc + col0;
#pragma unroll
                for (int bj = 0; bj < 2; ++bj) { const f32x4 v0 = acc[ai][bj][m][0], v1 = acc[ai][bj][m][1];
                    u32x4 w; w.x = cvt_pk_bf16(v0[0], v0[1]); w.y = cvt_pk_bf16(v0[2], v0[3]); w.z = cvt_pk_bf16(v1[0], v1[1]); w.w = cvt_pk_bf16(v1[2], v1[3]);
                    *(u32x4*)(rowp + bj * HALF) = w; } }
    }
};
struct EpiQKblk {
    static constexpr bool PERM = true;
    bf16_t* Q; bf16_t* K; float qs;
    __device__ __forceinline__ void operator()(const f32x4 (&acc)[2][2][4][2], const Unit& u, int wr, int wc, int fr_, int fq_) const {
        int z_; asm volatile("v_mov_b32 %0, 0" : "=v"(z_)); const int fr = fr_ + z_, fq = fq_ + z_;
#pragma unroll
        for (int bj = 0; bj < 2; ++bj) { const int c0 = u.pn * BM + bj * HALF + wc * 32 + 8 * fq; bf16_t* base = (c0 >= 2048) ? K : Q; const float sc = (c0 >= 2048) ? 1.0f : qs;
            const int hh = (c0 & 2047) >> 7, d0 = c0 & 127; const size_t cofs = (size_t)hh * (128 * 4096) + (d0 >> 4) * 512 + ((d0 >> 3) & 1) * 8;
#pragma unroll
            for (int ai = 0; ai < 2; ++ai)
#pragma unroll
                for (int m = 0; m < 4; ++m) { const int t = u.pm * BM + ai * HALF + wr * 64 + m * 16 + fr, b = t >> 12, pos = t & 4095;
                    bf16_t* dst = base + (size_t)b * (16 * 128 * 4096) + cofs + (size_t)(pos >> 5) * 4096 + (pos & 31) * 16;
                    const f32x4 v0 = acc[ai][bj][m][0] * sc, v1 = acc[ai][bj][m][1] * sc;
                    u32x4 w; w.x = cvt_pk_bf16(v0[0], v0[1]); w.y = cvt_pk_bf16(v0[2], v0[3]); w.z = cvt_pk_bf16(v1[0], v1[1]); w.w = cvt_pk_bf16(v1[2], v1[3]);
                    *(u32x4*)dst = w; } }
    }
};
struct EpiVblk {
    static constexpr bool PERM = true;
    bf16_t* V;
    __device__ __forceinline__ void operator()(const f32x4 (&acc)[2][2][4][2], const Unit& u, int wr, int wc, int fr_, int fq_) const {
        int z_; asm volatile("v_mov_b32 %0, 0" : "=v"(z_)); const int fr = fr_ + z_, fq = fq_ + z_;
        typedef unsigned u32x2v __attribute__((ext_vector_type(2)));
#pragma unroll
        for (int bj = 0; bj < 2; ++bj) { const int tok0 = u.pn * BM + bj * HALF + wc * 32 + 8 * fq, b = tok0 >> 12, pos0 = tok0 & 4095, k0 = pos0 & 31;
            const size_t cofs = (size_t)b * (16 * 128 * 4096) + (size_t)(pos0 >> 5) * 4096 + (k0 >> 4) * 2048 + ((k0 >> 3) & 1) * 4;
#pragma unroll
            for (int ai = 0; ai < 2; ++ai)
#pragma unroll
                for (int m = 0; m < 4; ++m) { const int f = u.pm * BM + ai * HALF + wr * 64 + m * 16 + fr, hh = f >> 7, e = f & 127;
                    bf16_t* dst = V + cofs + (size_t)hh * (128 * 4096) + (e >> 5) * 512 + (e & 31) * 16;
                    const f32x4 v0 = acc[ai][bj][m][0], v1 = acc[ai][bj][m][1];
                    u32x2v w0, w1; w0.x = cvt_pk_bf16(v0[0], v0[1]); w0.y = cvt_pk_bf16(v0[2], v0[3]); w1.x = cvt_pk_bf16(v1[0], v1[1]); w1.y = cvt_pk_bf16(v1[2], v1[3]);
                    *(u32x2v*)dst = w0; *(u32x2v*)(dst + 8) = w1; } }
    }
};
template <bool BASE16> struct EpiResid {
    static constexpr bool PERM = true;
    const void* base; bf16_t* out; const float* gate; float gs;
    __device__ __forceinline__ void operator()(const f32x4 (&acc)[2][2][4][2], const Unit& u, int wr, int wc, int fr_, int fq_) const {
        int z_; asm volatile("v_mov_b32 %0, 0" : "=v"(z_)); const int fr = fr_ + z_, fq = fq_ + z_;
        const int row0 = u.pm * BM + wr * 64 + fr, col0 = u.pn * BM + wc * 32 + 8 * fq;
        const float* gp = gate + (size_t)((u.pm * BM) >> 12) * 12288 + col0;
        const __amdgpu_buffer_rsrc_t rs = __builtin_amdgcn_make_buffer_rsrc((void*)out, 0, 8192 * 2048 * 2, 0x00020000);
        f32x4 gv[2][2];
#pragma unroll
        for (int bj = 0; bj < 2; ++bj)
#pragma unroll
            for (int n = 0; n < 2; ++n) gv[bj][n] = *(const f32x4*)(gp + bj * HALF + 4 * n) * gs;
#pragma unroll
        for (int ai = 0; ai < 2; ++ai)
#pragma unroll
            for (int m = 0; m < 4; ++m) { const size_t off = (size_t)(row0 + ai * HALF + m * 16) * 2048 + col0;
#pragma unroll
                for (int bj = 0; bj < 2; ++bj) { f32x4 b0, b1;
                    if (BASE16) { const u32x4 w = *(const u32x4*)((const bf16_t*)base + off + bj * HALF);
                        b0 = (f32x4){__uint_as_float(w.x << 16), __uint_as_float(w.x & 0xffff0000u), __uint_as_float(w.y << 16), __uint_as_float(w.y & 0xffff0000u)};
                        b1 = (f32x4){__uint_as_float(w.z << 16), __uint_as_float(w.z & 0xffff0000u), __uint_as_float(w.w << 16), __uint_as_float(w.w & 0xffff0000u)}; }
                    else { b0 = *(const f32x4*)((const float*)base + off + bj * HALF); b1 = *(const f32x4*)((const float*)base + off + bj * HALF + 4); }
                    const f32x4 v0 = b0 + gv[bj][0] * acc[ai][bj][m][0], v1 = b1 + gv[bj][1] * acc[ai][bj][m][1];
                    u32x4 o; o.x = cvt_pk_bf16(v0[0], v0[1]); o.y = cvt_pk_bf16(v0[2], v0[3]); o.z = cvt_pk_bf16(v1[0], v1[1]); o.w = cvt_pk_bf16(v1[2], v1[3]);
                    __builtin_amdgcn_raw_buffer_store_b128(o, rs, (int)((off + bj * HALF) * 2), 0, 16); }
                asm volatile("" ::: "memory"); }
    }
};
struct EpiSwiglu {
    static constexpr bool PERM = true;
    bf16_t* O; int ldo; int nNl;
    __device__ __forceinline__ void operator()(const f32x4 (&acc)[2][2][4][2], const Unit& u, int wr, int wc, int fr_, int fq_) const {
        int z_; asm volatile("v_mov_b32 %0, 0" : "=v"(z_)); const int fr = fr_ + z_, fq = fq_ + z_;
        const int row0 = u.pm * BM + wr * 64 + fr, col0 = (u.pn % nNl) * HALF + wc * 32 + 8 * fq;
#pragma unroll
        for (int ai = 0; ai < 2; ++ai)
#pragma unroll
            for (int m = 0; m < 4; ++m) { bf16_t* rowp = O + (size_t)(row0 + ai * HALF + m * 16) * ldo + col0;
                const f32x4 a0 = acc[ai][0][m][0], a1 = acc[ai][0][m][1], b0 = acc[ai][1][m][0], b1 = acc[ai][1][m][1];
                const f32x2p r0 = swiglu2((f32x2p){a0[0], a0[1]}, (f32x2p){b0[0], b0[1]}, -1.4426950408889634f, 1.0f), r1 = swiglu2((f32x2p){a0[2], a0[3]}, (f32x2p){b0[2], b0[3]}, -1.4426950408889634f, 1.0f);
                const f32x2p r2 = swiglu2((f32x2p){a1[0], a1[1]}, (f32x2p){b1[0], b1[1]}, -1.4426950408889634f, 1.0f), r3 = swiglu2((f32x2p){a1[2], a1[3]}, (f32x2p){b1[2], b1[3]}, -1.4426950408889634f, 1.0f);
                u32x4 w; w.x = cvt_pk_bf16(r0.x, r0.y); w.y = cvt_pk_bf16(r1.x, r1.y); w.z = cvt_pk_bf16(r2.x, r2.y); w.w = cvt_pk_bf16(r3.x, r3.y);
                *(u32x4*)rowp = w; }
    }
};
__device__ __forceinline__ unsigned pk4_fp8(float a, float b, float c, float d) { int w = 0; w = __builtin_amdgcn_cvt_pk_fp8_f32(a, b, w, false); w = __builtin_amdgcn_cvt_pk_fp8_f32(c, d, w, true); return (unsigned)w; }
struct EpiSwiglu8 {
    static constexpr bool PERM = true;
    unsigned char* O; int ldo; int nNl; float inv;
    __device__ __forceinline__ void operator()(const f32x4 (&acc)[2][2][4][2], const Unit& u, int wr, int wc, int fr, int fq) const {
        const int row0 = u.pm * BM + wr * 64 + fr, col0 = (u.pn % nNl) * HALF + wc * 32 + 8 * fq;
#pragma unroll
        for (int ai = 0; ai < 2; ++ai)
#pragma unroll
            for (int m = 0; m < 4; ++m) { unsigned char* rowp = O + (size_t)(row0 + ai * HALF + m * 16) * ldo + col0;
                const f32x4 a0 = acc[ai][0][m][0], a1 = acc[ai][0][m][1], b0 = acc[ai][1][m][0], b1 = acc[ai][1][m][1];
                const float c1 = -1.4426950408889634f * inv, c2 = inv * inv;
                const f32x2p r0 = swiglu2((f32x2p){a0[0], a0[1]}, (f32x2p){b0[0], b0[1]}, c1, c2), r1 = swiglu2((f32x2p){a0[2], a0[3]}, (f32x2p){b0[2], b0[3]}, c1, c2);
                const f32x2p r2 = swiglu2((f32x2p){a1[0], a1[1]}, (f32x2p){b1[0], b1[1]}, c1, c2), r3 = swiglu2((f32x2p){a1[2], a1[3]}, (f32x2p){b1[2], b1[3]}, c1, c2);
                typedef unsigned u32x2v __attribute__((ext_vector_type(2)));
                u32x2v w; w.x = pk4_fp8(r0.x, r0.y, r1.x, r1.y); w.y = pk4_fp8(r2.x, r2.y, r3.x, r3.y);
                *(u32x2v*)rowp = w; }
    }
};
struct EpiY {
    static constexpr bool PERM = true;
    bf16_t* Y; const float* sg; float inv;
    __device__ __forceinline__ void operator()(const f32x4 (&acc)[2][2][4][2], const Unit& u, int wr, int wc, int fr_, int fq_) const {
        int z_; asm volatile("v_mov_b32 %0, 0" : "=v"(z_)); const int fr = fr_ + z_, fq = fq_ + z_;
        const int row0 = u.pm * BM + wr * 64 + fr, col0 = (u.pn & 7) * BM + wc * 32 + 8 * fq;
#pragma unroll
        for (int ai = 0; ai < 2; ++ai)
#pragma unroll
            for (int m = 0; m < 4; ++m) { const int row = row0 + ai * HALF + m * 16; const float g = sg[row] * inv; bf16_t* rowp = Y + (size_t)row * 2048 + col0;
#pragma unroll
                for (int bj = 0; bj < 2; ++bj) { const f32x4 v0 = acc[ai][bj][m][0] * g, v1 = acc[ai][bj][m][1] * g;
                    u32x4 w; w.x = cvt_pk_bf16(v0[0], v0[1]); w.y = cvt_pk_bf16(v0[2], v0[3]); w.z = cvt_pk_bf16(v1[0], v1[1]); w.w = cvt_pk_bf16(v1[2], v1[3]);
                    *(u32x4*)(rowp + bj * HALF) = w; } }
    }
};
struct EpiYp {
    static constexpr bool PERM = true;
    bf16_t* YP; const float* sg; float inv;
    __device__ __forceinline__ void operator()(const f32x4 (&acc)[2][2][4][2], const Unit& u, int wr, int wc, int fr_, int fq_) const {
        int z_; asm volatile("v_mov_b32 %0, 0" : "=v"(z_)); const int fr = fr_ + z_, fq = fq_ + z_;
        const int row0 = u.pm * BM + wr * 64 + fr, col0 = (u.pn & 7) * BM + wc * 32 + 8 * fq; bf16_t* base = YP + (size_t)(u.pn >> 6) * (1792 * 2048);
#pragma unroll
        for (int ai = 0; ai < 2; ++ai)
#pragma unroll
            for (int m = 0; m < 4; ++m) { const int row = row0 + ai * HALF + m * 16; const float g = sg[row] * inv; bf16_t* rowp = base + (size_t)(row - 16384) * 2048 + col0;
#pragma unroll
                for (int bj = 0; bj < 2; ++bj) { const f32x4 v0 = acc[ai][bj][m][0] * g, v1 = acc[ai][bj][m][1] * g;
                    u32x4 w; w.x = cvt_pk_bf16(v0[0], v0[1]); w.y = cvt_pk_bf16(v0[2], v0[3]); w.z = cvt_pk_bf16(v1[0], v1[1]); w.w = cvt_pk_bf16(v1[2], v1[3]);
                    *(u32x4*)(rowp + bj * HALF) = w; } }
    }
};
struct EpiW {
    static constexpr bool PERM = true;
    bf16_t* AP; const float* bcum; const float* ig;
    __device__ __forceinline__ void operator()(const f32x4 (&acc)[2][2][4][2], const Unit& u, int wr, int wc, int fr_, int fq_) const {
        int z_; asm volatile("v_mov_b32 %0, 0" : "=v"(z_)); const int fr = fr_ + z_, fq = fq_ + z_;
        const float* bc = bcum + u.pm * 256; const float* ii = ig + u.pm * 256;
#pragma unroll
        for (int bj = 0; bj < 2; ++bj) { const int s0 = bj * HALF + wc * 32 + 8 * fq;
            const f32x4 b0 = *(const f32x4*)(bc + s0), b1 = *(const f32x4*)(bc + s0 + 4), i0 = *(const f32x4*)(ii + s0), i1 = *(const f32x4*)(ii + s0 + 4);
            const f32x4 c0 = i0 - b0, c1 = i1 - b1;
#pragma unroll
            for (int ai = 0; ai < 2; ++ai)
#pragma unroll
                for (int m = 0; m < 4; ++m) { const int t = ai * HALF + wr * 64 + m * 16 + fr; const float bt = bc[t]; bf16_t* rowp = AP + ((size_t)u.pm * 256 + t) * 512 + 256;
                    const f32x4 v0 = acc[ai][bj][m][0], v1 = acc[ai][bj][m][1]; float r[8];
                    const int dts = t - s0;
#pragma unroll
                    for (int j = 0; j < 4; ++j) { const float m0 = (float)min(max(dts - j + 1, 0), 1), m1 = (float)min(max(dts - j - 3, 0), 1);
                        r[j] = v0[j] * __expf(fminf(bt + c0[j], 80.f)) * m0; r[4 + j] = v1[j] * __expf(fminf(bt + c1[j], 80.f)) * m1; }
                    u32x4 w; w.x = cvt_pk_bf16(r[0], r[1]); w.y = cvt_pk_bf16(r[2], r[3]); w.z = cvt_pk_bf16(r[4], r[5]); w.w = cvt_pk_bf16(r[6], r[7]);
                    *(u32x4*)(rowp + s0) = w; asm volatile("" ::: "memory"); } }
    }
};
struct EpiDC {
    static constexpr bool PERM = false;
    float* D;
    __device__ __forceinline__ void operator()(const f32x4 (&acc)[2][2][4][2], const Unit& u, int wr, int wc, int fr_, int fq_) const {
        int z_; asm volatile("v_mov_b32 %0, 0" : "=v"(z_)); const int fr = fr_ + z_, fq = fq_ + z_;
        const int row0 = wr * 64 + fr, col0 = wc * 32 + 4 * fq;
#pragma unroll
        for (int ai = 0; ai < 2; ++ai)
#pragma unroll
            for (int m = 0; m < 4; ++m) { float* rowp = D + ((size_t)u.pm * 256 + row0 + ai * HALF + m * 16) * 256 + col0;
#pragma unroll
                for (int bj = 0; bj < 2; ++bj)
#pragma unroll
                    for (int n = 0; n < 2; ++n) *(f32x4*)(rowp + bj * HALF + n * 16) = acc[ai][bj][m][n]; }
    }
};
struct EpiNum {
    static constexpr bool PERM = false;
    float* HR;
    __device__ __forceinline__ void operator()(const f32x4 (&acc)[2][2][4][2], const Unit& u, int wr, int wc, int fr_, int fq_) const {
        int z_; asm volatile("v_mov_b32 %0, 0" : "=v"(z_)); const int fr = fr_ + z_, fq = fq_ + z_;
        const int b = u.pm >> 6, h = (u.pm >> 4) & 3, c = u.pm & 15;
        const int row0 = b * 4096 + c * 256 + wr * 64 + fr, col0 = h * 256 + wc * 32 + 4 * fq;
#pragma unroll
        for (int ai = 0; ai < 2; ++ai)
#pragma unroll
            for (int m = 0; m < 4; ++m) { float* rowp = HR + (size_t)(row0 + ai * HALF + m * 16) * 1024 + col0;
#pragma unroll
                for (int bj = 0; bj < 2; ++bj)
#pragma unroll
                    for (int n = 0; n < 2; ++n) *(f32x4*)(rowp + bj * HALF + n * 16) = acc[ai][bj][m][n]; }
    }
};
struct EpiFin {
    static constexpr bool PERM = true;
    bf16_t* O; const bf16_t* PROJ; int ldp; const float* headg; PG8_LAS float* sDen; PG8_LAS float* sSS; float eps;
    __device__ __forceinline__ void operator()(const f32x4 (&acc)[2][2][4][2], const Unit& u, int wr, int wc, int fr_, int fq_) const {
        int z_; asm volatile("v_mov_b32 %0, 0" : "=v"(z_)); const int fr = fr_ + z_, fq = fq_ + z_;
        const int b = u.pm >> 6, h = (u.pm >> 4) & 3, c = u.pm & 15;
        const int rl0 = wr * 64 + fr, col0 = wc * 32 + 8 * fq;
#pragma unroll
        for (int ai = 0; ai < 2; ++ai)
#pragma unroll
            for (int m = 0; m < 4; ++m) { float p = 0.f;
#pragma unroll
                for (int bj = 0; bj < 2; ++bj)
#pragma unroll
                    for (int n = 0; n < 2; ++n) { const f32x4 v = acc[ai][bj][m][n]; p += v[0] * v[0] + v[1] * v[1] + v[2] * v[2] + v[3] * v[3]; }
                p += __shfl_xor(p, 16); p += __shfl_xor(p, 32);
                if (fq == 0) sSS[wc * 256 + rl0 + ai * HALF + m * 16] = p; }
        asm volatile("s_waitcnt lgkmcnt(0)" ::: "memory"); __builtin_amdgcn_s_barrier();
        f32x4 hv[2][2];
#pragma unroll
        for (int bj = 0; bj < 2; ++bj)
#pragma unroll
            for (int n = 0; n < 2; ++n) hv[bj][n] = *(const f32x4*)(headg + h * 256 + col0 + bj * HALF + 4 * n);
#pragma unroll
        for (int ai = 0; ai < 2; ++ai) {
            const size_t t0 = (size_t)b * 4096 + c * 256 + rl0 + ai * HALF;
            u32x4 ow[4][2];
#pragma unroll
            for (int m = 0; m < 4; ++m)
#pragma unroll
                for (int bj = 0; bj < 2; ++bj) ow[m][bj] = *(const u32x4*)(PROJ + (t0 + m * 16) * ldp + 3072 + h * 256 + col0 + bj * HALF);
#pragma unroll
            for (int m = 0; m < 4; ++m) { const int rl = rl0 + ai * HALF + m * 16;
                const float P = (sSS[rl] + sSS[256 + rl]) + (sSS[512 + rl] + sSS[768 + rl]), idd = sDen[rl];
                const float f = idd * (1.0f / sqrtf(P * idd * idd * (1.0f / 256.0f) + eps));
                bf16_t* rowp = O + (t0 + m * 16) * 2048 + h * 256 + col0;
#pragma unroll
                for (int bj = 0; bj < 2; ++bj) { const f32x4 v0 = acc[ai][bj][m][0] * f * hv[bj][0], v1 = acc[ai][bj][m][1] * f * hv[bj][1]; const u32x4 o = ow[m][bj];
                    const f32x2p s0 = sigm2(o.x), s1 = sigm2(o.y), s2 = sigm2(o.z), s3 = sigm2(o.w);
                    u32x4 w; w.x = cvt_pk_bf16(v0[0] * s0.x, v0[1] * s0.y); w.y = cvt_pk_bf16(v0[2] * s1.x, v0[3] * s1.y); w.z = cvt_pk_bf16(v1[0] * s2.x, v1[1] * s2.y); w.w = cvt_pk_bf16(v1[2] * s3.x, v1[3] * s3.y);
                    *(u32x4*)(rowp + bj * HALF) = w; } } }
    }
};
struct EpiPool {
    static constexpr bool PERM = true;
    bf16_t* O; const float* scale;
    __device__ __forceinline__ void operator()(const f32x4 (&acc)[2][2][4][2], const Unit& u, int wr, int wc, int fr_, int fq_) const {
        int z_; asm volatile("v_mov_b32 %0, 0" : "=v"(z_)); const int fr = fr_ + z_, fq = fq_ + z_;
        const int row0 = u.pm * BM + wr * 64 + fr, col0 = u.pn * 256 + wc * 32 + 8 * fq;
        f32x4 sv[2][2];
#pragma unroll
        for (int bj = 0; bj < 2; ++bj)
#pragma unroll
            for (int n = 0; n < 2; ++n) sv[bj][n] = *(const f32x4*)(scale + col0 + bj * HALF + 4 * n);
#pragma unroll
        for (int ai = 0; ai < 2; ++ai)
#pragma unroll
            for (int m = 0; m < 4; ++m) { bf16_t* rowp = O + (size_t)(row0 + ai * HALF + m * 16) * 2048 + 1024 + col0;
#pragma unroll
                for (int bj = 0; bj < 2; ++bj) { const f32x4 v0 = acc[ai][bj][m][0] * sv[bj][0], v1 = acc[ai][bj][m][1] * sv[bj][1];
                    u32x4 w; w.x = cvt_pk_bf16(v0[0], v0[1]); w.y = cvt_pk_bf16(v0[2], v0[3]); w.z = cvt_pk_bf16(v1[0], v1[1]); w.w = cvt_pk_bf16(v1[2], v1[3]);
                    *(u32x4*)(rowp + bj * HALF) = w; } }
    }
};

typedef int v8i_t __attribute__((ext_vector_type(8)));
typedef int v4i_t __attribute__((ext_vector_type(4)));
__device__ __forceinline__ v8i_t cat8(bf16x8 lo, bf16x8 hi) { return __builtin_shufflevector(__builtin_bit_cast(v4i_t, lo), __builtin_bit_cast(v4i_t, hi), 0, 1, 2, 3, 4, 5, 6, 7); }
template <class Epi, class Sched, bool ALIGN_EPI = false, bool SP2 = false, bool F8 = false>
__device__ __forceinline__ void gemm_phase(PG8_LAS unsigned char* lds, const Dims g, const Sched& S, const Epi& E) {
    int tid_ = threadIdx.x; asm volatile("" : "+v"(tid_));
    const int tid = tid_, wid = __builtin_amdgcn_readfirstlane(tid >> 6), lane = tid & 63, wr = wid >> 2, wc = wid & 3, fr = lane & 15, fq = lane >> 4;
    const int K = g.K, nt = K / BK;
    unsigned voffA[2], voffB[2];
#pragma unroll
    for (int i = 0; i < 2; ++i) { int R, C; stage_rc(tid * 16 + i * 8192, R, C); const int Rb = Epi::PERM ? ((R & ~31) + perm32(R & 31)) : R;
        voffA[i] = (unsigned)(R * g.lda + C) * 2u; voffB[i] = (unsigned)(Rb * g.ldb + C) * 2u; }
    const size_t kstep = (size_t)(BK * 2);
    const size_t hstepA = (size_t)HALF * g.lda * 2, hstepB = (size_t)HALF * g.ldb * 2;
    const unsigned ldsw = (unsigned)wid * 1024u;
    const int aoff = lds_byte(wr * 64 + fr, fq * 8), boff = lds_byte(wc * 32 + fr, fq * 8);
#define PG8_SA(b, h) (((b) * 2 + (h)) * HTB)
#define PG8_SB(b, h) ((4 + (b) * 2 + (h)) * HTB)
#define PG8_STAGE(bufoff, gbase, voff) do { _Pragma("unroll") for (int _i = 0; _i < 2; ++_i) \
        __builtin_amdgcn_global_load_lds((const unsigned*)((const char*)(gbase) + (voff)[_i]), (PG8_LAS unsigned*)(lds + (bufoff) + ldsw + _i * 8192), 16, 0, 0); } while (0)
#define PG8_LDA(dst, b, h) do { if constexpr (F8) { _Pragma("unroll") for (int m = 0; m < 4; ++m) { const v4i_t lo_ = *(const PG8_LAS v4i_t*)(lds + PG8_SA(b, h) + aoff + m * 2048), hi_ = *(const PG8_LAS v4i_t*)(lds + PG8_SA(b, h) + aoff + m * 2048 + 1024); dst##8[m] = __builtin_shufflevector(lo_, hi_, 0, 1, 2, 3, 4, 5, 6, 7); } } else { \
        _Pragma("unroll") for (int m = 0; m < 4; ++m) _Pragma("unroll") for (int k = 0; k < 2; ++k) dst[m][k] = *(const PG8_LAS bf16x8*)(lds + PG8_SA(b, h) + aoff + m * 2048 + k * 1024); } } while (0)
#define PG8_LDB(dst, b, h) do { if constexpr (F8) { _Pragma("unroll") for (int n = 0; n < 2; ++n) { const v4i_t lo_ = *(const PG8_LAS v4i_t*)(lds + PG8_SB(b, h) + boff + n * 2048), hi_ = *(const PG8_LAS v4i_t*)(lds + PG8_SB(b, h) + boff + n * 2048 + 1024); dst##8[n] = __builtin_shufflevector(lo_, hi_, 0, 1, 2, 3, 4, 5, 6, 7); } } else { \
        _Pragma("unroll") for (int n = 0; n < 2; ++n) _Pragma("unroll") for (int k = 0; k < 2; ++k) dst[n][k] = *(const PG8_LAS bf16x8*)(lds + PG8_SB(b, h) + boff + n * 2048 + k * 1024); } } while (0)
#define PG8_MMA(ai, bj, At, Bt) do { __builtin_amdgcn_s_setprio(1); if constexpr (F8) { _Pragma("unroll") for (int m = 0; m < 4; ++m) _Pragma("unroll") for (int n = 0; n < 2; ++n) \
        asm volatile("v_mfma_scale_f32_16x16x128_f8f6f4 %0, %1, %2, %0, %3, %3 op_sel_hi:[0,0,0]" : "+v"(acc[ai][bj][m][n]) : "v"(Bt##8[n]), "v"(At##8[m]), "v"(sc8)); } else { \
        _Pragma("unroll") for (int m = 0; m < 4; ++m) _Pragma("unroll") for (int n = 0; n < 2; ++n) _Pragma("unroll") for (int k = 0; k < 2; ++k) \
        acc[ai][bj][m][n] = __builtin_amdgcn_mfma_f32_16x16x32_bf16(Bt[n][k], At[m][k], acc[ai][bj][m][n], 0, 0, 0); } __builtin_amdgcn_s_setprio(0); } while (0)
#define PG8_WAIT_V(n) asm volatile("s_waitcnt vmcnt(" #n ")" ::: "memory")
#define PG8_WAIT_L(n) asm volatile("s_waitcnt lgkmcnt(" #n ")" ::: "memory")
#define PG8_BAR __builtin_amdgcn_s_barrier()
#define PG8_SCHED __builtin_amdgcn_sched_barrier(0)
    Unit cur, nxt; int ui = 0;
    if (!S.next(0, cur)) return;
    f32x4 acc[2][2][4][2];
#pragma unroll
    for (int a = 0; a < 2; ++a)
#pragma unroll
        for (int b = 0; b < 2; ++b)
#pragma unroll
            for (int m = 0; m < 4; ++m)
#pragma unroll
                for (int n = 0; n < 2; ++n) acc[a][b][m][n] = (f32x4){0.f, 0.f, 0.f, 0.f};
    int sc8 = 0x7f7f7f7f; asm volatile("" : "+v"(sc8));
    bf16x8 At[4][2], B0[2][2], B1[2][2]; v8i_t At8[4], B08[2], B18[2]; (void)At; (void)B0; (void)B1; (void)At8; (void)B08; (void)B18;
    const char* cA = cur.a; const char* cB = cur.b;
    S.a_ready(cur);
    if constexpr (SP2) {
        PG8_STAGE(PG8_SB(0, 0), cB, voffB); PG8_STAGE(PG8_SB(0, 1), cB + hstepB, voffB); PG8_STAGE(PG8_SA(0, 0), cA, voffA); PG8_STAGE(PG8_SA(0, 1), cA + hstepA, voffA);
        if (wr == 1) PG8_BAR;
        PG8_WAIT_V(2); PG8_BAR;
        PG8_STAGE(PG8_SB(1, 0), cB + kstep, voffB); PG8_STAGE(PG8_SA(1, 0), cA + kstep, voffA); PG8_STAGE(PG8_SB(1, 1), cB + hstepB + kstep, voffB);
        PG8_WAIT_V(6); PG8_BAR;
    } else {
        PG8_STAGE(PG8_SB(0, 0), cB, voffB); PG8_STAGE(PG8_SA(0, 0), cA, voffA); PG8_STAGE(PG8_SB(0, 1), cB + hstepB, voffB); PG8_STAGE(PG8_SA(0, 1), cA + hstepA, voffA);
        if (wr == 1) PG8_BAR;
        PG8_WAIT_V(4); PG8_BAR;
        PG8_STAGE(PG8_SB(1, 0), cB + kstep, voffB); PG8_STAGE(PG8_SA(1, 0), cA + kstep, voffA); PG8_STAGE(PG8_SB(1, 1), cB + hstepB + kstep, voffB);
        PG8_WAIT_V(6); PG8_BAR;
    }
    for (;;) {
        const bool has_next = S.next(ui + 1, nxt);
        const char* nA = has_next ? nxt.a : cA; const char* nB = has_next ? nxt.b : cB;
#pragma nounroll
        for (int t = 0; t < nt; t += 2) {
            const bool last = (t == nt - 2);
            const char* a1 = cA + (size_t)(t + 1) * kstep;
            const char* a2 = last ? nA : cA + (size_t)(t + 2) * kstep; const char* b2 = last ? nB : cB + (size_t)(t + 2) * kstep;
            const char* a3 = a2 + kstep; const char* b3 = b2 + kstep;
            if (last && has_next) S.a_ready(nxt);
            if constexpr (SP2) {
            PG8_LDB(B0, 0, 0); PG8_LDB(B1, 0, 1); PG8_SCHED; PG8_LDA(At, 0, 0); PG8_STAGE(PG8_SA(1, 1), a1 + hstepA, voffA);
            PG8_WAIT_V(8); PG8_WAIT_L(0); PG8_BAR; PG8_MMA(0, 0, At, B0); PG8_MMA(0, 1, At, B1); PG8_BAR; PG8_SCHED;
            PG8_LDA(At, 0, 1); PG8_STAGE(PG8_SB(0, 0), b2, voffB); PG8_STAGE(PG8_SB(0, 1), b2 + hstepB, voffB); PG8_STAGE(PG8_SA(0, 0), a2, voffA);
            PG8_WAIT_V(8); PG8_WAIT_L(0); PG8_BAR; PG8_MMA(1, 0, At, B0); PG8_MMA(1, 1, At, B1); PG8_BAR; PG8_SCHED;
            PG8_LDB(B0, 1, 0); PG8_LDB(B1, 1, 1); PG8_SCHED; PG8_LDA(At, 1, 0); PG8_STAGE(PG8_SA(0, 1), a2 + hstepA, voffA);
            PG8_WAIT_V(8); PG8_WAIT_L(0); PG8_BAR; PG8_MMA(0, 0, At, B0); PG8_MMA(0, 1, At, B1); PG8_BAR; PG8_SCHED;
            PG8_LDA(At, 1, 1); PG8_STAGE(PG8_SB(1, 0), b3, voffB); PG8_STAGE(PG8_SB(1, 1), b3 + hstepB, voffB); PG8_STAGE(PG8_SA(1, 0), a3, voffA);
            PG8_WAIT_V(8); PG8_WAIT_L(0); PG8_BAR; PG8_MMA(1, 0, At, B0); PG8_MMA(1, 1, At, B1); PG8_BAR; PG8_SCHED;
            } else {
            PG8_LDB(B0, 0, 0); PG8_SCHED; PG8_LDA(At, 0, 0); PG8_STAGE(PG8_SA(1, 1), a1 + hstepA, voffA);
            PG8_WAIT_L(8); PG8_BAR; PG8_WAIT_L(0); PG8_MMA(0, 0, At, B0); PG8_BAR; PG8_SCHED;
            PG8_LDB(B1, 0, 1); PG8_STAGE(PG8_SB(0, 0), b2, voffB);
            PG8_BAR; PG8_WAIT_L(0); PG8_MMA(0, 1, At, B1); PG8_BAR;
            PG8_LDA(At, 0, 1); PG8_STAGE(PG8_SA(0, 0), a2, voffA);
            PG8_BAR; PG8_WAIT_L(0); PG8_MMA(1, 0, At, B0); PG8_BAR; PG8_SCHED;
            PG8_STAGE(PG8_SB(0, 1), b2 + hstepB, voffB);
            PG8_WAIT_V(6); PG8_BAR; PG8_MMA(1, 1, At, B1); PG8_BAR;
            PG8_LDB(B0, 1, 0); PG8_SCHED; PG8_LDA(At, 1, 0); PG8_STAGE(PG8_SA(0, 1), a2 + hstepA, voffA);
            PG8_WAIT_L(8); PG8_BAR; PG8_WAIT_L(0); PG8_MMA(0, 0, At, B0); PG8_BAR; PG8_SCHED;
            PG8_LDB(B1, 1, 1); PG8_STAGE(PG8_SB(1, 0), b3, voffB);
            PG8_BAR; PG8_WAIT_L(0); PG8_MMA(0, 1, At, B1); PG8_BAR;
            PG8_LDA(At, 1, 1); PG8_STAGE(PG8_SA(1, 0), a3, voffA);
            PG8_BAR; PG8_WAIT_L(0); PG8_MMA(1, 0, At, B0); PG8_BAR; PG8_SCHED;
            PG8_STAGE(PG8_SB(1, 1), b3 + hstepB, voffB);
            PG8_WAIT_V(6); PG8_BAR; PG8_MMA(1, 1, At, B1); PG8_BAR;
            }
        }
        if constexpr (F8) {
#pragma unroll
            for (int a = 0; a < 2; ++a)
#pragma unroll
                for (int b = 0; b < 2; ++b)
                    asm volatile("s_nop 15\n\ts_nop 15" : "+v"(acc[a][b][0][0]), "+v"(acc[a][b][0][1]), "+v"(acc[a][b][1][0]), "+v"(acc[a][b][1][1]), "+v"(acc[a][b][2][0]), "+v"(acc[a][b][2][1]), "+v"(acc[a][b][3][0]), "+v"(acc[a][b][3][1]));
        }
        if constexpr (ALIGN_EPI) { if (wr == 0) PG8_BAR; }
        E(acc, cur, wr, wc, fr, fq); S.done(cur);
        if (!has_next) break;
#pragma unroll
        for (int a = 0; a < 2; ++a)
#pragma unroll
            for (int b = 0; b < 2; ++b)
#pragma unroll
                for (int m = 0; m < 4; ++m)
#pragma unroll
                    for (int n = 0; n < 2; ++n) acc[a][b][m][n] = (f32x4){0.f, 0.f, 0.f, 0.f};
        cur = nxt; cA = nA; cB = nB; ++ui;
        if constexpr (ALIGN_EPI) { if (wr == 1) PG8_BAR; }
    }
    PG8_WAIT_V(0);
    if constexpr (!ALIGN_EPI) { if (wr == 0) PG8_BAR; }
    PG8_BAR;
#undef PG8_SA
#undef PG8_SB
#undef PG8_STAGE
#undef PG8_LDA
#undef PG8_LDB
#undef PG8_MMA
#undef PG8_WAIT_V
#undef PG8_WAIT_L
#undef PG8_BAR
#undef PG8_SCHED
}
}

constexpr int NWAVES = 8;
constexpr int DM = 2048, NTOK = 8192, SEQ = 4096;
constexpr int DINS = 5128, DINP = 5120;
constexpr int DFF = 5632, NE = 8, DFE = 7168;
constexpr int NUNIT = 128;
constexpr int MAXSLOT = 18432;
constexpr float EPS = 1e-6f;

constexpr size_t MiB = 1u << 20;
constexpr size_t WS_CTL = 0, CTL_ZERO_BYTES = 1 * MiB;
constexpr size_t WS_MOD = 1 * MiB;
constexpr size_t WS_GWT = WS_MOD + 256 * 1024;
constexpr size_t WS_RWT = WS_GWT + 64 * 1024;
constexpr size_t WS_GATES = WS_RWT + 64 * 1024;
constexpr size_t WS_BCUM = WS_GATES + 256 * 1024;
constexpr size_t WS_IG = WS_BCUM + 128 * 1024;
constexpr size_t WS_GTOT = WS_IG + 128 * 1024;
constexpr size_t WS_DN = WS_GTOT + 4 * 1024;
constexpr size_t WS_NVEC = WS_DN + 128 * 1024;
constexpr size_t WS_TOKINFO = WS_NVEC + 128 * 1024;
constexpr size_t WS_TOKSLOT = WS_TOKINFO + 256 * 1024;
constexpr size_t WS_SLOTGATE = WS_TOKSLOT + 64 * 1024;
static_assert(WS_SLOTGATE + 128 * 1024 <= 4 * MiB, "small arrays");
constexpr size_t WS_WIN = 4 * MiB, WS_WOUT = 24 * MiB, WS_W13 = 32 * MiB, WS_W2 = 76 * MiB, WS_WQKV = 98 * MiB, WS_WO = 122 * MiB, WS_POOLW = 130 * MiB;
constexpr size_t WS_W13E = 132 * MiB, WS_W2E = 580 * MiB;
constexpr size_t WS_XR = 804 * MiB, WS_HN = 868 * MiB;
constexpr size_t WS_L = 900 * MiB;
constexpr size_t WS_PROJ = WS_L, WS_QB = WS_L + 80 * MiB, WS_KB = WS_L + 96 * MiB, WS_KWT = WS_L + 112 * MiB, WS_AP = WS_L + 128 * MiB, WS_BP = WS_L + 160 * MiB,
                 WS_DCT = WS_L + 192 * MiB, WS_HR = WS_L + 224 * MiB, WS_POOLED = WS_L + 256 * MiB, WS_MIXCAT = WS_L + 272 * MiB, WS_U = WS_L + 304 * MiB;
constexpr size_t WS_QB2 = WS_L, WS_KB2 = WS_L + 32 * MiB, WS_VT = WS_L + 64 * MiB, WS_ATTO = WS_L + 96 * MiB, WS_HPERM = WS_L + 128 * MiB, WS_UE = WS_L + 200 * MiB, WS_Y = WS_L + 452 * MiB;
constexpr size_t WS_YP = WS_L + 528 * MiB;
constexpr size_t WS_END = WS_L + 596 * MiB;

constexpr int CW_TMO = 0, CW_CODE = 1;
constexpr int CW_BAR = 4096;
constexpr int CW_PAN8 = 12288, CW_PAN11 = 16384, CW_PAN15 = 20480;
constexpr int CW_P0PUB = 10752;
constexpr int CW_QCVT = 10496;
constexpr int CW_RDONE = 10240;
constexpr int CW_CNT = 8192;

constexpr int RING_OFF = 0, RING_BYTES = 131072;
constexpr int LDS_BYTES = 147456;
constexpr int LDSCTL_OFF = LDS_BYTES - 512, MISC_OFF = LDSCTL_OFF;

#define GAS __attribute__((address_space(1)))
#define LAS __attribute__((address_space(3)))
typedef unsigned short bf16;
typedef unsigned v4u __attribute__((ext_vector_type(4)));
typedef unsigned v2u __attribute__((ext_vector_type(2)));
typedef float f32x4 __attribute__((ext_vector_type(4)));
typedef GAS unsigned gu32;
#define RLX_AGENT __ATOMIC_RELAXED, __HIP_MEMORY_SCOPE_AGENT
#define LDS_WAIT() asm volatile("s_waitcnt lgkmcnt(0)" ::: "memory")
#define VM_WAIT() asm volatile("s_waitcnt vmcnt(0)" ::: "memory")
__device__ __forceinline__ unsigned pk2(float lo, float hi) { return pg8::cvt_pk_bf16(lo, hi); }
__device__ __forceinline__ float bflo(unsigned w) { return __uint_as_float(w << 16); }
__device__ __forceinline__ float bfhi(unsigned w) { return __uint_as_float(w & 0xffff0000u); }
__device__ __forceinline__ float logsig(float x) { return fminf(x, 0.f) - log1pf(expf(-fabsf(x))); }
__device__ __forceinline__ float dot4(f32x4 a, f32x4 b) { return (a.x * b.x + a.y * b.y) + (a.z * b.z + a.w * b.w); }

#define XB_TMO      128
#define XB_XCNT(j)  (256  + 64 * (j))
#define XB_XSUB(j)  (1280 + 64 * (j))
#define XB_XGEN(j)  (2304 + 64 * (j))
#define XB_TOP      3328
#define XB_TOPGEN   3392
#define XCD_BAR_WORDS 3456
#define XB_SPIN_CAP (1u << 20)

__device__ __forceinline__ unsigned xb_ld(unsigned* p)              { return __hip_atomic_load(p, __ATOMIC_RELAXED, __HIP_MEMORY_SCOPE_AGENT); }
__device__ __forceinline__ unsigned xb_add(unsigned* p, unsigned v) { return __hip_atomic_fetch_add(p, v, __ATOMIC_RELAXED, __HIP_MEMORY_SCOPE_AGENT); }
__device__ __forceinline__ unsigned xb_xcc_id() { return (unsigned)__builtin_amdgcn_s_getreg((3 << 11) | 20) & 0xFu; }
#define XB_SPIN(cond, bar) do { unsigned _sp = 0; while (cond) { __builtin_amdgcn_s_sleep(1); \
    if ((++_sp & 255u) == 0u) { if (xb_ld(&(bar)[XB_TMO])) break; if (_sp > XB_SPIN_CAP) { atomicAdd(&(bar)[XB_TMO], 1u); break; } } } } while (0)

struct XcdBarrier { unsigned* bar; unsigned x; volatile LAS unsigned* st; };

__device__ __forceinline__ XcdBarrier xcd_barrier_post(unsigned* bar, volatile LAS unsigned* st) {
    XcdBarrier b; b.bar = bar; b.x = xb_xcc_id(); b.st = st;
    if (threadIdx.x == 0) (void)xb_add(&bar[XB_XCNT(b.x)], 1u);
    return b;
}
__device__ __forceinline__ void xcd_barrier_complete(unsigned* bar, unsigned x, unsigned& nloc, unsigned& nx) {
    const unsigned G = gridDim.x * gridDim.y * gridDim.z;
    unsigned sum, cnt, mine, sp = 0u;
    for (;;) {
        sum = 0u; cnt = 0u; mine = 0u;
#pragma unroll
        for (unsigned j = 0; j < 16; ++j) { const unsigned c = xb_ld(&bar[XB_XCNT(j)]); sum += c; cnt += (c > 0u) ? 1u : 0u; mine = (j == x) ? c : mine; }
        if (sum == G) break;
        __builtin_amdgcn_s_sleep(1);
        if ((++sp & 255u) == 0u) { if (xb_ld(&bar[XB_TMO])) break; if (sp > XB_SPIN_CAP) { atomicAdd(&bar[XB_TMO], 1u); break; } }
    }
    nloc = mine > 0u ? mine : 1u; nx = cnt > 0u ? cnt : 1u;
}
__device__ __forceinline__ void xcd_barrier(const XcdBarrier& b) {
    asm volatile("s_waitcnt vmcnt(0)" ::: "memory");
    __syncthreads();
    int tid0 = threadIdx.x; asm volatile("" : "+v"(tid0));
    if (tid0 == 0) {
        unsigned* bar = b.bar;
        __builtin_amdgcn_s_waitcnt(0);
        unsigned nloc = b.st[0], nx = b.st[1];
        if (nloc == 0u) { xcd_barrier_complete(bar, b.x, nloc, nx); b.st[0] = nloc; b.st[1] = nx; }
        const unsigned old = xb_add(&bar[XB_XSUB(b.x)], 1u);
        const unsigned gen = old / nloc;
        if (old + 1u == (gen + 1u) * nloc) {
            __builtin_amdgcn_fence(__ATOMIC_RELEASE, "agent");
            asm volatile("s_waitcnt vmcnt(0)" ::: "memory");
            const unsigned og = xb_add(&bar[XB_TOP], 1u);
            const unsigned tg = og / nx;
            if (og + 1u == (tg + 1u) * nx) xb_add(&bar[XB_TOPGEN], 1u);
            else XB_SPIN(xb_ld(&bar[XB_TOPGEN]) == tg, bar);
            __builtin_amdgcn_fence(__ATOMIC_ACQUIRE, "agent");
            xb_add(&bar[XB_XGEN(b.x)], 1u);
            asm volatile("s_waitcnt vmcnt(0)" ::: "memory");
        } else {
            XB_SPIN(xb_ld(&bar[XB_XGEN(b.x)]) == gen, bar);
            __builtin_amdgcn_fence(__ATOMIC_ACQUIRE, "agent");
            asm volatile("s_waitcnt vmcnt(0)" ::: "memory");
        }
    }
    __syncthreads();
}

struct Args { const float* in[24]; float* out; unsigned char* ws; };
struct Frame {
    LAS unsigned char* lds; volatile LAS unsigned* MISC; gu32* ctl;
    int G, bid;
    unsigned char* ws;
};
__device__ __forceinline__ float wave_sum(float v) {
#pragma unroll
    for (int o = 1; o < 64; o <<= 1) v += __shfl_xor(v, o);
    return v;
}

__device__ __forceinline__ void transpose_item(const float* src, int spitch, int k0, int n0s, bf16* dst, int dpitch, int n0d, LAS unsigned* T, int lane) {
    const int kr = lane & 3, nq = lane >> 2;
#pragma unroll
    for (int i = 0; i < 8; ++i) {
        const int k = k0 + 8 * i + 2 * kr;
        const f32x4 a = *(const f32x4*)(src + (size_t)k * spitch + n0s + 4 * nq);
        const f32x4 b = *(const f32x4*)(src + (size_t)(k + 1) * spitch + n0s + 4 * nq);
#pragma unroll
        for (int j = 0; j < 4; ++j) T[(4 * nq + j) * 33 + 4 * i + kr] = pk2(a[j], b[j]);
    }
    LDS_WAIT();
#pragma unroll
    for (int it = 0; it < 8; ++it) {
        const int n = (lane >> 3) + 8 * it, c = lane & 7;
        v4u o; o.x = T[n * 33 + 4 * c]; o.y = T[n * 33 + 4 * c + 1]; o.z = T[n * 33 + 4 * c + 2]; o.w = T[n * 33 + 4 * c + 3];
        *(v4u*)(dst + (size_t)(n0d + n) * dpitch + k0 + 8 * c) = o;
    }
    LDS_WAIT();
}
__device__ __forceinline__ void transpose_item8(const float* src, int spitch, int k0, int n0s, unsigned char* dst, int dpitch, int n0d, float scale, LAS unsigned* T, int lane) {
    const int kr = lane & 3, nq = lane >> 2;
    f32x4 a[8][4];
#pragma unroll
    for (int i = 0; i < 8; ++i) { const float* p = src + (size_t)(k0 + 16 * i + 4 * kr) * spitch + n0s + 4 * nq;
#pragma unroll
        for (int q = 0; q < 4; ++q) a[i][q] = *(const f32x4*)(p + (size_t)q * spitch); }
#pragma unroll
    for (int i = 0; i < 8; ++i)
#pragma unroll
        for (int j = 0; j < 4; ++j) T[(4 * nq + j) * 33 + 4 * i + kr] = pg8::pk4_fp8(a[i][0][j] * scale, a[i][1][j] * scale, a[i][2][j] * scale, a[i][3][j] * scale);
    LDS_WAIT();
#pragma unroll
    for (int it = 0; it < 8; ++it) {
        const int n = (lane >> 3) + 8 * it, c = lane & 7;
        v4u o; o.x = T[n * 33 + 4 * c]; o.y = T[n * 33 + 4 * c + 1]; o.z = T[n * 33 + 4 * c + 2]; o.w = T[n * 33 + 4 * c + 3];
        *(v4u*)(dst + (size_t)(n0d + n) * dpitch + k0 + 16 * c) = o;
    }
    LDS_WAIT();
}
constexpr float WS8 = 64.0f;
constexpr int I_W13E = 8 * 16 * 224, I_W2E = 8 * 56 * 32, I_WIN = 32 * 80, I_WOUT = 32 * 32, I_W13 = 32 * 176, I_W2 = 88 * 32, I_WQKV = 32 * 96, I_WO = 32 * 32, I_POOL = 4 * 16;
constexpr int N_ITEMS = I_W13E + I_W2E + I_WIN + I_WOUT + I_W13 + I_W2 + I_WQKV + I_WO + I_POOL;
constexpr int NT_W13E = 8 * 8 * 56, NT_W2E = 8 * 28 * 8, NT_WIN = 16 * 20, NT_WOUT = 16 * 8, NT_W13 = 0, NT_W2 = 0  , NT_WQKV = 16 * 24, NT_WO = 16 * 8, NT_POOL = 8;
constexpr int NT_W13F = 8 * 44, NT_W2F = 22 * 8;
constexpr int NT_ALL = NT_W13E + NT_W2E + NT_W13F + NT_W2F + NT_WIN + NT_WOUT + NT_W13 + NT_W2 + NT_WQKV + NT_WO + NT_POOL;
constexpr int TAILQ2 = 7, TAILQ10 = 5, TAILQ6 = 1, TAILQ4 = 1;
constexpr int P0_TILE0 = 128 * (TAILQ2 + TAILQ10 + TAILQ6 + TAILQ4);
constexpr int QCVT_N = 1024, QCVT_LO = NT_W13E + NT_W2E - QCVT_N;

template <bool DYN = false>
__device__ __forceinline__ void convert_tiles(Frame& F, const Args& args, int first, int last, int stride, gu32* q = nullptr) {
    int tid = threadIdx.x; asm volatile("" : "+v"(tid)); const int lane = tid & 63, wave = __builtin_amdgcn_readfirstlane(tid >> 6);
    unsigned char* ws = F.ws;
    {
        const int nl = 4 * lane;
        struct Tile { const float* s; int spitch; unsigned char* d; size_t dpitch; bool f8; };
        auto decode = [&](int it) -> Tile {
            Tile t; int r = it; if (!DYN && r >= QCVT_LO) r += QCVT_N;
            if (r < NT_W13E) { const int e = r / (8 * 56), rr = r % (8 * 56), kb = rr / 56, nb = rr % 56; t.f8 = true; t.spitch = DFE;
                t.s = (nl < 128 ? args.in[21] + nb * 128 + nl : args.in[22] + nb * 128 + nl - 128) + (size_t)e * 2048 * DFE + (size_t)(kb * 256 + wave * 32) * DFE;
                t.d = ws + WS_W13E + ((size_t)e * 14336 + nb * 256) * 2048 + kb * 256; t.dpitch = 2048; }
            else if ((r -= NT_W13E) < NT_W2E) { const int e = r / (28 * 8), rr = r % (28 * 8), kb = rr / 8, nb = rr % 8; t.f8 = true; t.spitch = 2048;
                t.s = args.in[23] + (size_t)e * DFE * 2048 + (size_t)(kb * 256 + wave * 32) * 2048 + nb * 256 + nl;
                t.d = ws + WS_W2E + ((size_t)e * 2048 + nb * 256) * DFE + kb * 256; t.dpitch = DFE; }
            else if ((r -= NT_W2E) < NT_W13F) { const int kb = r / 44, nb = r % 44; t.f8 = true; t.spitch = DFF;
                t.s = (nl < 128 ? args.in[15] + nb * 128 + nl : args.in[16] + nb * 128 + nl - 128) + (size_t)(kb * 256 + wave * 32) * DFF;
                t.d = ws + WS_W13 + ((size_t)nb * 256) * 2048 + kb * 256; t.dpitch = 2048; }
            else if ((r -= NT_W13F) < NT_W2F) { const int kb = r / 8, nb = r % 8; t.f8 = true; t.spitch = 2048;
                t.s = args.in[17] + (size_t)(kb * 256 + wave * 32) * 2048 + nb * 256 + nl;
                t.d = ws + WS_W2 + ((size_t)nb * 256) * DFF + kb * 256; t.dpitch = DFF; }
            else { t.f8 = false; r -= NT_W2F; int kb, nb, K; const float* base; unsigned char* db; int scol;
                if (r < NT_WIN) { kb = r / 20; nb = r % 20; K = 2048; t.spitch = DINS; base = args.in[7]; db = ws + WS_WIN; scol = nb * 256 + nl + (nb >= 16 ? 8 : 0); }
                else if ((r -= NT_WIN) < NT_WOUT) { kb = r / 8; nb = r % 8; K = 2048; t.spitch = 2048; base = args.in[14]; db = ws + WS_WOUT; scol = nb * 256 + nl; }
                else if ((r -= NT_WOUT) < NT_W13) { kb = r / 44; nb = r % 44; K = 2048; t.spitch = DFF; base = (nl < 128 ? args.in[15] : args.in[16] - 128); db = ws + WS_W13; scol = nb * 128 + nl; }
                else if ((r -= NT_W13) < NT_W2) { kb = r / 8; nb = r % 8; K = DFF; t.spitch = 2048; base = args.in[17]; db = ws + WS_W2; scol = nb * 256 + nl; }
                else if ((r -= NT_W2) < NT_WQKV) { kb = r / 24; nb = r % 24; K = 2048; t.spitch = 6144; base = args.in[18]; db = ws + WS_WQKV; scol = nb * 256 + nl; }
                else if ((r -= NT_WQKV) < NT_WO) { kb = r / 8; nb = r % 8; K = 2048; t.spitch = 2048; base = args.in[19]; db = ws + WS_WO; scol = nb * 256 + nl; }
                else { r -= NT_WO; kb = r & 1; nb = 0; K = 256; t.spitch = 256; base = args.in[12] + (size_t)(r >> 1) * 65536; db = ws + WS_POOLW + (size_t)(r >> 1) * 131072; scol = nl; }
                t.s = base + (size_t)(kb * 128 + wave * 16) * t.spitch + scol; t.d = db + ((size_t)nb * 256 * K + kb * 128) * 2; t.dpitch = (size_t)K * 2; }
            return t; };
        int buf = 0;
        f32x4 a[32];
        LAS int* slot = (LAS int*)(F.lds + RING_OFF + RING_BYTES + 8192);
        int it = first, nxt = 0, kq = 0;
        if (DYN) { if (tid == 0) { slot[0] = first + (int)__hip_atomic_fetch_add(q, 1u, __ATOMIC_RELAXED, __HIP_MEMORY_SCOPE_AGENT); slot[1] = first + (int)__hip_atomic_fetch_add(q, 1u, __ATOMIC_RELAXED, __HIP_MEMORY_SCOPE_AGENT); }
            __syncthreads(); it = __builtin_amdgcn_readfirstlane(slot[0]); nxt = __builtin_amdgcn_readfirstlane(slot[1]); __syncthreads(); }
        Tile cur = decode(it < last ? it : 0);
        if (it < last) {
#pragma unroll
            for (int kk = 0; kk < 32; ++kk) if (kk < 16 || cur.f8) a[kk] = __builtin_nontemporal_load((const f32x4*)(cur.s + (size_t)kk * cur.spitch));
        }
        for (; it < last; ) {
            LAS unsigned char* T = F.lds + buf * 65536;
            int tk = 0; if (DYN && tid == 0) tk = first + (int)__hip_atomic_fetch_add(q, 1u, __ATOMIC_RELAXED, __HIP_MEMORY_SCOPE_AGENT);
            const int c0 = 2 * wave, sw = lane & 15;
            if (cur.f8) {
#pragma unroll
                for (int j = 0; j < 4; ++j) { v4u o0, o1;
                    o0.x = pg8::pk4_fp8(a[0][j] * WS8, a[1][j] * WS8, a[2][j] * WS8, a[3][j] * WS8);     o0.y = pg8::pk4_fp8(a[4][j] * WS8, a[5][j] * WS8, a[6][j] * WS8, a[7][j] * WS8);
                    o0.z = pg8::pk4_fp8(a[8][j] * WS8, a[9][j] * WS8, a[10][j] * WS8, a[11][j] * WS8);   o0.w = pg8::pk4_fp8(a[12][j] * WS8, a[13][j] * WS8, a[14][j] * WS8, a[15][j] * WS8);
                    o1.x = pg8::pk4_fp8(a[16][j] * WS8, a[17][j] * WS8, a[18][j] * WS8, a[19][j] * WS8); o1.y = pg8::pk4_fp8(a[20][j] * WS8, a[21][j] * WS8, a[22][j] * WS8, a[23][j] * WS8);
                    o1.z = pg8::pk4_fp8(a[24][j] * WS8, a[25][j] * WS8, a[26][j] * WS8, a[27][j] * WS8); o1.w = pg8::pk4_fp8(a[28][j] * WS8, a[29][j] * WS8, a[30][j] * WS8, a[31][j] * WS8);
                    *(LAS v4u*)(T + (nl + j) * 256 + ((c0 ^ sw) << 4)) = o0; *(LAS v4u*)(T + (nl + j) * 256 + (((c0 + 1) ^ sw) << 4)) = o1; }
            } else {
#pragma unroll
                for (int j = 0; j < 4; ++j) { v4u o0, o1;
                    o0.x = pk2(a[0][j], a[1][j]); o0.y = pk2(a[2][j], a[3][j]); o0.z = pk2(a[4][j], a[5][j]); o0.w = pk2(a[6][j], a[7][j]);
                    o1.x = pk2(a[8][j], a[9][j]); o1.y = pk2(a[10][j], a[11][j]); o1.z = pk2(a[12][j], a[13][j]); o1.w = pk2(a[14][j], a[15][j]);
                    *(LAS v4u*)(T + (nl + j) * 256 + ((c0 ^ sw) << 4)) = o0; *(LAS v4u*)(T + (nl + j) * 256 + (((c0 + 1) ^ sw) << 4)) = o1; }
            }
            const Tile done = cur; const int nx = DYN ? nxt : it + stride;
            if (nx < last) { cur = decode(nx);
#pragma unroll
                for (int kk = 0; kk < 32; ++kk) if (kk < 16 || cur.f8) a[kk] = __builtin_nontemporal_load((const f32x4*)(cur.s + (size_t)kk * cur.spitch)); }
            if (DYN && tid == 0) slot[kq & 1] = tk;
            __syncthreads();
#pragma unroll
            for (int i = 0; i < 8; ++i) { const int row = (tid >> 4) + 32 * i, c = tid & 15;
                const v4u o = *(const LAS v4u*)(T + row * 256 + ((c ^ ((row >> 2) & 15)) << 4));
                __builtin_nontemporal_store(o, (v4u*)(done.d + (size_t)row * done.dpitch + 16 * c)); }
            buf ^= 1;
            if (DYN) { it = nxt; nxt = __builtin_amdgcn_readfirstlane(slot[kq & 1]); ++kq; } else it += stride;
        }
    }
    __syncthreads();
}

__device__ __forceinline__ void p0_prologue(Frame& F, const Args& args) {
    int tid = threadIdx.x; asm volatile("" : "+v"(tid)); const int lane = tid & 63, wave = __builtin_amdgcn_readfirstlane(tid >> 6); (void)lane; (void)wave;
    unsigned char* ws = F.ws;
    {
        LAS float* sC = (LAS float*)(F.lds);
        LAS float* sR = sC + 4096;
        const float* c = args.in[1]; const float* adaw = args.in[2]; const float* adab = args.in[3]; float* MOD = (float*)(ws + WS_MOD);
        bool have = false;
        for (int task = F.bid; task < 256; task += F.G) {
            if (!have) { for (int i = tid; i < 4096; i += 512) { const float cv = c[i]; sC[i] = cv / (1.0f + expf(-cv)); } __syncthreads(); have = true; }
            const int l = task >> 7, n0 = (task & 127) * 96, cq = tid % 24, ks = tid / 24;
            if (ks < 21) {
                const int k0 = ks * 98, k1 = (k0 + 98 < 2048) ? k0 + 98 : 2048;
                const float* W = adaw + (size_t)l * 2048 * 12288 + n0 + 4 * cq;
                f32x4 a0 = {0.f, 0.f, 0.f, 0.f}, a1 = {0.f, 0.f, 0.f, 0.f};
#pragma unroll 7
                for (int k = k0; k < k1; ++k) { const f32x4 w = __builtin_nontemporal_load((const f32x4*)(W + (size_t)k * 12288)); a0 += sC[k] * w; a1 += sC[2048 + k] * w; }
#pragma unroll
                for (int j = 0; j < 4; ++j) { sR[(ks * 2 + 0) * 96 + 4 * cq + j] = a0[j]; sR[(ks * 2 + 1) * 96 + 4 * cq + j] = a1[j]; }
            }
            __syncthreads();
            if (tid < 192) { const int b = tid / 96, n = tid % 96; float s = 0.f;
#pragma unroll
                for (int k2 = 0; k2 < 21; ++k2) s += sR[(k2 * 2 + b) * 96 + n];
                __hip_atomic_store((gu32*)(MOD + (size_t)(l * 2 + b) * 12288 + n0 + n), __float_as_uint(s + adab[l * 12288 + n0 + n]), RLX_AGENT); }
            __syncthreads();
        }
        __syncthreads();
    }
    {
        const float* win = args.in[7]; const float* rw = args.in[20]; float* GWT = (float*)(ws + WS_GWT); float* RWT = (float*)(ws + WS_RWT);
        for (int i = F.bid * 512 + tid; i < 16384; i += F.G * 512) { const int g = i >> 11, k = i & 2047; __hip_atomic_store((gu32*)(GWT + i), __float_as_uint(win[(size_t)k * DINS + 4096 + g]), RLX_AGENT); RWT[i] = rw[k * 8 + g]; }
    }
    asm volatile("s_waitcnt vmcnt(0)" ::: "memory");
    __syncthreads();
    if (tid == 0) __hip_atomic_fetch_add(F.ctl + CW_P0PUB, 1u, RLX_AGENT);
    const int cv0 = (F.G == 256 ? P0_TILE0 : 0) + F.bid;
    convert_tiles(F, args, cv0, cv0 + 2 * F.G < NT_ALL - QCVT_N ? cv0 + 2 * F.G : NT_ALL - QCVT_N, F.G);
}

template <int MODE, bool X16, bool OUT8 = false>
__device__ __forceinline__ void norm_phase(Frame& F, const void* xin, const float* gain, const float* modl, int sh_off, int sc_off, bf16* HN,
                                           const float* tab, const float* bias8, float* gates_out, unsigned* tokinfo, gu32* cnt) {
    int tid = threadIdx.x; asm volatile("" : "+v"(tid)); const int lane = tid & 63, wave = __builtin_amdgcn_readfirstlane(tid >> 6); (void)lane; (void)wave;
    LAS float* sT = (LAS float*)(F.lds);
    if (MODE != 1) { for (int i = tid; i < 16384; i += 512) sT[i] = tab[i]; __syncthreads(); }
    const int gw = F.bid * NWAVES + wave, NGW = F.G * NWAVES;
    for (int t0 = gw * 4; t0 < NTOK; t0 += NGW * 4) {
        const int b = t0 >> 12;
        f32x4 ga[8], sb[8];
#pragma unroll
        for (int j = 0; j < 8; ++j) { const int col = 4 * (lane + 64 * j);
            const f32x4 g = *(const f32x4*)(gain + col), sc = *(const f32x4*)(modl + (size_t)b * 12288 + sc_off + col);
            ga[j] = g * (sc + 1.0f); sb[j] = *(const f32x4*)(modl + (size_t)b * 12288 + sh_off + col); }
        v2u xw4[4][8]; (void)xw4;
        if (X16) {
#pragma unroll
            for (int i = 0; i < 4; ++i)
#pragma unroll
                for (int j = 0; j < 8; ++j) xw4[i][j] = *(const v2u*)((const bf16*)xin + (size_t)(t0 + i) * DM + 4 * (lane + 64 * j)); }
#pragma unroll
        for (int i = 0; i < 4; ++i) {
            const int t = t0 + i;
            f32x4 v[8]; float ss = 0.f;
#pragma unroll
            for (int j = 0; j < 8; ++j) {
                if (X16) { const v2u w = xw4[i][j]; v[j] = (f32x4){bflo(w.x), bfhi(w.x), bflo(w.y), bfhi(w.y)}; }
                else v[j] = *(const f32x4*)((const float*)xin + (size_t)t * DM + 4 * (lane + 64 * j));
                ss += dot4(v[j], v[j]); }
            ss = wave_sum(ss);
            const float r = 1.0f / sqrtf(ss * (1.0f / DM) + EPS);
#pragma unroll
            for (int j = 0; j < 8; ++j) { v[j] = v[j] * r * ga[j] + sb[j];
                if (OUT8) *(unsigned*)((unsigned char*)HN + (size_t)t * DM + 4 * (lane + 64 * j)) = pg8::pk4_fp8(v[j].x, v[j].y, v[j].z, v[j].w);
                else { v2u o; o.x = pk2(v[j].x, v[j].y); o.y = pk2(v[j].z, v[j].w);
                *(v2u*)(HN + (size_t)t * DM + 4 * (lane + 64 * j)) = o; } }
            if (MODE != 1) {
                float a8[8];
#pragma unroll
                for (int g = 0; g < 8; ++g) { float s = 0.f;
#pragma unroll
                    for (int j = 0; j < 8; ++j) { const f32x4 tv = *(const LAS f32x4*)(sT + g * 2048 + 4 * (lane + 64 * j)); s += dot4(v[j], tv); }
                    a8[g] = wave_sum(s); }
                if (MODE == 0) {
                    if (lane == 0) {
                        f32x4 o0 = {a8[0] + bias8[0], a8[1] + bias8[1], a8[2] + bias8[2], a8[3] + bias8[3]}, o1 = {a8[4] + bias8[4], a8[5] + bias8[5], a8[6] + bias8[6], a8[7] + bias8[7]};
                        *(f32x4*)(gates_out + (size_t)t * 8) = o0; *(f32x4*)(gates_out + (size_t)t * 8 + 4) = o1; }
                } else {
                    if (lane == 0) {
                        int e0 = 0; float v0 = a8[0];
#pragma unroll
                        for (int g = 1; g < 8; ++g) if (a8[g] > v0) { v0 = a8[g]; e0 = g; }
                        int e1 = -1; float v1 = -3.0e38f;
#pragma unroll
                        for (int g = 0; g < 8; ++g) if (g != e0 && a8[g] > v1) { v1 = a8[g]; e1 = g; }
                        const float ex = expf(v1 - v0), g0 = 1.0f / (1.0f + ex), g1 = ex / (1.0f + ex);
                        const unsigned p0 = __hip_atomic_fetch_add(cnt + 64 * e0, 1u, RLX_AGENT), p1 = __hip_atomic_fetch_add(cnt + 64 * e1, 1u, RLX_AGENT);
                        v4u w0; w0.x = (unsigned)e0; w0.y = (unsigned)e1; w0.z = p0; w0.w = p1;
                        v4u w1; w1.x = __float_as_uint(g0); w1.y = __float_as_uint(g1); w1.z = 0u; w1.w = 0u;
                        *(v4u*)(tokinfo + (size_t)t * 8) = w0; *(v4u*)(tokinfo + (size_t)t * 8 + 4) = w1; }
                }
            }
        }
    }
    if (MODE != 1) __syncthreads();
}

template <int W>
__device__ __forceinline__ void pool_rows(const bf16* __restrict__ PROJ, bf16* __restrict__ POOLED, int tb, int posb, int col) {
    float h0[W - 1], h1[W - 1];
#pragma unroll
    for (int j = 0; j < W - 1; ++j) { const bool in = posb - 1 - j >= 0; const unsigned rr = *(const unsigned*)(PROJ + (size_t)(in ? tb - 1 - j : tb) * DINP + 4096 + col); const unsigned r = in ? rr : 0u; h0[j] = bflo(r); h1[j] = bfhi(r); }
    for (int i8 = 0; i8 < 32; i8 += 8) {
        unsigned r8[8];
#pragma unroll
        for (int ii = 0; ii < 8; ++ii) r8[ii] = *(const unsigned*)(PROJ + (size_t)(tb + i8 + ii) * DINP + 4096 + col);
#pragma unroll
        for (int ii = 0; ii < 8; ++ii) {
            const int t = tb + i8 + ii, pos = posb + i8 + ii, cnt = (pos + 1 < W) ? pos + 1 : W;
            const float x0 = bflo(r8[ii]), x1 = bfhi(r8[ii]);
            float s0 = x0, s1 = x1;
#pragma unroll
            for (int j = 0; j < W - 1; ++j) { s0 += h0[j]; s1 += h1[j]; }
            const float ic = __builtin_amdgcn_rcpf((float)cnt);
            *(unsigned*)(POOLED + (size_t)t * 1024 + col) = pk2(s0 * ic - x0, s1 * ic - x1);
#pragma unroll
            for (int j = W - 2; j > 0; --j) { h0[j] = h0[j - 1]; h1[j] = h1[j - 1]; }
            h0[0] = x0; h1[0] = x1;
        }
    }
}
__device__ __forceinline__ void prep_phase(Frame& F, const Args& args) {
    int tid = threadIdx.x; asm volatile("" : "+v"(tid)); const int lane = tid & 63, wave = __builtin_amdgcn_readfirstlane(tid >> 6);
    unsigned char* ws = F.ws;
    const bf16* __restrict__ PROJ = (const bf16*)(ws + WS_PROJ); const float* __restrict__ GATES = (const float*)(ws + WS_GATES);
    float* __restrict__ BCUM = (float*)(ws + WS_BCUM); float* __restrict__ IG = (float*)(ws + WS_IG); float* __restrict__ GTOT = (float*)(ws + WS_GTOT); float* __restrict__ DN = (float*)(ws + WS_DN);
    bf16* __restrict__ QB = (bf16*)(ws + WS_QB); bf16* __restrict__ KB = (bf16*)(ws + WS_KB); bf16* __restrict__ KWT = (bf16*)(ws + WS_KWT); bf16* __restrict__ AP = (bf16*)(ws + WS_AP); bf16* __restrict__ BP = (bf16*)(ws + WS_BP);
    bf16* __restrict__ POOLED = (bf16*)(ws + WS_POOLED);
    const float* __restrict__ convw = args.in[9]; const float* __restrict__ convb = args.in[10];
    LAS float* sB = (LAS float*)(F.lds); LAS float* sI = sB + 256; LAS float* sW = sI + 256;
    LAS unsigned* TK = (LAS unsigned*)(F.lds + 4096); LAS unsigned* TV = TK + 128 * 129;
    for (int task = F.bid; task < 2 * NUNIT; task += F.G) {
        const int u = task >> 1, half = task & 1, b = u >> 6, h = (u >> 4) & 3, c = u & 15, t0 = b * SEQ + c * 256;
        float sc = 0.f, ir = 0.f;
        if (tid < 256) { const float fr = GATES[(size_t)(t0 + tid) * 8 + 4 + h]; ir = GATES[(size_t)(t0 + tid) * 8 + h]; sc = logsig(fr);
#pragma unroll
            for (int o = 1; o < 64; o <<= 1) { const float y = __shfl_up(sc, o); if (lane >= o) sc += y; }
            sI[tid] = ir; if (lane == 63) sW[wave] = sc; }
        __syncthreads();
        if (tid < 256) { for (int w2 = 0; w2 < wave; ++w2) sc += sW[w2]; sB[tid] = sc; if (half == 0) { BCUM[u * 256 + tid] = sc; IG[u * 256 + tid] = ir; } }
        __syncthreads();
        const float Gt = sB[255];
        if (half == 0 && tid == 0) GTOT[u] = Gt;
        {
            const int cp = tid & 63, tg = tid >> 6, dc = half * 128 + 2 * cp, chq = h * 256 + dc, chk = 1024 + h * 256 + dc, chv = 2048 + h * 256 + dc;
            float wq[4][2], wk[4][2], bq[2], bk[2];
#pragma unroll
            for (int j = 0; j < 4; ++j) { wq[j][0] = convw[j * 2048 + chq]; wq[j][1] = convw[j * 2048 + chq + 1]; wk[j][0] = convw[j * 2048 + chk]; wk[j][1] = convw[j * 2048 + chk + 1]; }
            bq[0] = convb[chq]; bq[1] = convb[chq + 1]; bk[0] = convb[chk]; bk[1] = convb[chk + 1];
            const int tl0 = tg * 32, pos0 = c * 256 + tl0;
            float xq[3][2], xk[3][2];
#pragma unroll
            for (int jj = 0; jj < 3; ++jj) { const int p = pos0 - 3 + jj; unsigned rq = 0u, rk = 0u;
                if (p >= 0) { const bf16* row = PROJ + (size_t)(b * SEQ + p) * DINP; rq = *(const unsigned*)(row + chq); rk = *(const unsigned*)(row + chk); }
                xq[jj][0] = bflo(rq); xq[jj][1] = bfhi(rq); xk[jj][0] = bflo(rk); xk[jj][1] = bfhi(rk); }
            for (int i8 = 0; i8 < 32; i8 += 8) {
                unsigned rq8[8], rk8[8], rv8[8];
#pragma unroll
                for (int ii = 0; ii < 8; ++ii) { const bf16* row = PROJ + (size_t)(t0 + tl0 + i8 + ii) * DINP; rq8[ii] = *(const unsigned*)(row + chq); rk8[ii] = *(const unsigned*)(row + chk); rv8[ii] = *(const unsigned*)(row + chv); }
                float pkw0 = 0.f, pkw1 = 0.f, pv0 = 0.f, pv1 = 0.f;
#pragma unroll
                for (int ii = 0; ii < 8; ++ii) {
                    const int tl = tl0 + i8 + ii; const unsigned rq = rq8[ii], rk = rk8[ii], rv = rv8[ii];
                    const float cq0 = bflo(rq), cq1 = bfhi(rq), ck0 = bflo(rk), ck1 = bfhi(rk);
                    const float yq0 = bq[0] + wq[0][0] * xq[0][0] + wq[1][0] * xq[1][0] + wq[2][0] * xq[2][0] + wq[3][0] * cq0;
                    const float yq1 = bq[1] + wq[0][1] * xq[0][1] + wq[1][1] * xq[1][1] + wq[2][1] * xq[2][1] + wq[3][1] * cq1;
                    const float yk0 = bk[0] + wk[0][0] * xk[0][0] + wk[1][0] * xk[1][0] + wk[2][0] * xk[2][0] + wk[3][0] * ck0;
                    const float yk1 = bk[1] + wk[0][1] * xk[0][1] + wk[1][1] * xk[1][1] + wk[2][1] * xk[2][1] + wk[3][1] * ck1;
                    xq[0][0] = xq[1][0]; xq[1][0] = xq[2][0]; xq[2][0] = cq0; xq[0][1] = xq[1][1]; xq[1][1] = xq[2][1]; xq[2][1] = cq1;
                    xk[0][0] = xk[1][0]; xk[1][0] = xk[2][0]; xk[2][0] = ck0; xk[0][1] = xk[1][1]; xk[1][1] = xk[2][1]; xk[2][1] = ck1;
                    const float q0 = yq0 * __builtin_amdgcn_rcpf(1.0f + __expf(-yq0)) * 0.0625f, q1 = yq1 * __builtin_amdgcn_rcpf(1.0f + __expf(-yq1)) * 0.0625f;
                    const float k0 = yk0 * __builtin_amdgcn_rcpf(1.0f + __expf(-yk0)), k1 = yk1 * __builtin_amdgcn_rcpf(1.0f + __expf(-yk1));
                    const float bt = sB[tl], it = sI[tl], eb = __expf(bt), kwf = __expf(Gt - bt + it);
                    const size_t ro = (size_t)u * 256 + tl;
                    *(unsigned*)(QB + ro * 256 + dc) = pk2(q0, q1);
                    *(unsigned*)(AP + ro * 512 + dc) = pk2(eb * q0, eb * q1);
                    *(unsigned*)(KB + ro * 256 + dc) = pk2(k0, k1);
                    const float kw0 = kwf * k0, kw1 = kwf * k1, v0 = bflo(rv), v1 = bfhi(rv);
                    if (ii & 1) { TK[(2 * cp) * 129 + (tl >> 1)] = pk2(pkw0, kw0); TK[(2 * cp + 1) * 129 + (tl >> 1)] = pk2(pkw1, kw1);
                                  TV[(2 * cp) * 129 + (tl >> 1)] = pk2(pv0, v0);   TV[(2 * cp + 1) * 129 + (tl >> 1)] = pk2(pv1, v1); }
                    else { pkw0 = kw0; pkw1 = kw1; pv0 = v0; pv1 = v1; }
                }
            }
        }
        __syncthreads();
        for (int idx = tid; idx < 128 * 32; idx += 512) { const int dl = idx >> 5, ch = idx & 31;
            v4u o; o.x = TK[dl * 129 + 4 * ch]; o.y = TK[dl * 129 + 4 * ch + 1]; o.z = TK[dl * 129 + 4 * ch + 2]; o.w = TK[dl * 129 + 4 * ch + 3];
            *(v4u*)(KWT + ((size_t)u * 256 + half * 128 + dl) * 256 + 8 * ch) = o;
            o.x = TV[dl * 129 + 4 * ch]; o.y = TV[dl * 129 + 4 * ch + 1]; o.z = TV[dl * 129 + 4 * ch + 2]; o.w = TV[dl * 129 + 4 * ch + 3];
            *(v4u*)(BP + ((size_t)u * 256 + half * 128 + dl) * 512 + 256 + 8 * ch) = o; }
        if (tid < 128) { float s = 0.f; for (int w2 = 0; w2 < 128; ++w2) { const unsigned p = TK[tid * 129 + w2]; s += bflo(p) + bfhi(p); } DN[u * 256 + half * 128 + tid] = s; }
        __syncthreads();
    }
    for (int pb = F.bid; pb < NTOK / 32; pb += F.G) {
        const int col = 2 * tid, g = __builtin_amdgcn_readfirstlane(col >> 8), tb = pb * 32, posb = tb & (SEQ - 1);
        if (g == 0) pool_rows<2>(PROJ, POOLED, tb, posb, col); else if (g == 1) pool_rows<4>(PROJ, POOLED, tb, posb, col);
        else if (g == 2) pool_rows<8>(PROJ, POOLED, tb, posb, col); else pool_rows<16>(PROJ, POOLED, tb, posb, col);
    }
}

__device__ __forceinline__ void scan_phase(Frame& F) {
    int tid = threadIdx.x; asm volatile("" : "+v"(tid)); const int lane = tid & 63, wave = __builtin_amdgcn_readfirstlane(tid >> 6); (void)lane; (void)wave;
    unsigned char* ws = F.ws;
    const float* DCT = (const float*)(ws + WS_DCT); const float* GTOT = (const float*)(ws + WS_GTOT); const float* DN = (const float*)(ws + WS_DN);
    bf16* BP = (bf16*)(ws + WS_BP); float* NVEC = (float*)(ws + WS_NVEC);
    for (int eg = F.bid * 512 + tid; eg < 8 * 16384; eg += F.G * 512) {
        const int bh = eg >> 14, rem = eg & 16383, e = rem >> 6, d4 = (rem & 63) * 4;
        f32x4 C = {0.f, 0.f, 0.f, 0.f};
        for (int c = 0; c < 16; ++c) { const int u = bh * 16 + c;
            v2u o; o.x = pk2(C.x, C.y); o.y = pk2(C.z, C.w);
            *(v2u*)(BP + ((size_t)u * 256 + e) * 512 + d4) = o;
            const f32x4 d = *(const f32x4*)(DCT + ((size_t)u * 256 + e) * 256 + d4);
            C = C * __expf(GTOT[u]) + d; }
    }
    for (int id = F.bid * 512 + tid; id < 2048; id += F.G * 512) {
        const int bh = id >> 8, d = id & 255; float n = 0.f;
        for (int c = 0; c < 16; ++c) { const int u = bh * 16 + c; NVEC[u * 256 + d] = n; n = n * __expf(GTOT[u]) + DN[u * 256 + d]; }
    }
}

typedef float f32x16 __attribute__((ext_vector_type(16)));
typedef short s16x8 __attribute__((ext_vector_type(8)));
typedef float f32x2_t __attribute__((ext_vector_type(2))); typedef __bf16 bf16x2_t __attribute__((ext_vector_type(2)));
__device__ __forceinline__ unsigned cvtpk_s(float lo, float hi) { f32x2_t v = {lo, hi}; bf16x2_t b = __builtin_convertvector(v, bf16x2_t); return __builtin_bit_cast(unsigned, b); }
__device__ __forceinline__ void attn_phase(Frame& F) {
    int tid = threadIdx.x; asm volatile("" : "+v"(tid)); const int lane = tid & 63, wave = __builtin_amdgcn_readfirstlane(tid >> 6);
    unsigned char* ws = F.ws;
    const bf16* QB = (const bf16*)(ws + WS_QB2); const bf16* KB = (const bf16*)(ws + WS_KB2); const bf16* VT = (const bf16*)(ws + WS_VT);
    bf16* ATTO = (bf16*)(ws + WS_ATTO);
    const int gw = F.bid * NWAVES + wave, NGW = F.G * NWAVES;
    const int r = lane & 31, hlf = lane >> 5;
    for (int p = gw; p < 4096; p += NGW) {
        const int qt = p & 127, hh = (p >> 7) & 15, b = p >> 11, t0 = qt * 32;
        const size_t hb = ((size_t)(b * 16 + hh) * 128) * 4096; const int lo16 = r * 16 + hlf * 8;
        const bf16* qrow = QB + hb + (size_t)qt * 4096 + lo16;
        s16x8 qf[8];
#pragma unroll
        for (int kk = 0; kk < 8; ++kk) qf[kk] = *(const s16x8*)(qrow + 512 * kk);
        f32x16 O[4];
#pragma unroll
        for (int et = 0; et < 4; ++et)
#pragma unroll
            for (int i = 0; i < 16; ++i) O[et][i] = 0.f;
        float R = 1.0f;
        s16x8 kf[8];
        { const bf16* krow = KB + hb + (size_t)qt * 4096 + lo16;
#pragma unroll
          for (int kk = 0; kk < 8; ++kk) kf[kk] = *(const s16x8*)(krow + 512 * kk); }
        for (int s0 = t0; ; s0 -= 32) {
            s16x8 vf[8];
            { const bf16* vp = VT + hb + (size_t)(s0 >> 5) * 4096 + lo16;
#pragma unroll
              for (int q = 0; q < 8; ++q) vf[q] = *(const s16x8*)(vp + 512 * q); }
            __builtin_amdgcn_sched_barrier(0);
            f32x16 zt;
#pragma unroll
            for (int i = 0; i < 16; ++i) zt[i] = 0.f;
#pragma unroll
            for (int kk = 0; kk < 8; ++kk) zt = __builtin_amdgcn_mfma_f32_32x32x16_bf16(kf[kk], qf[kk], zt, 0, 0, 0);
            __builtin_amdgcn_sched_barrier(0);
            { const int sn = (s0 >= 32) ? s0 - 32 : s0;
              const bf16* krow = KB + hb + (size_t)(sn >> 5) * 4096 + lo16;
#pragma unroll
              for (int kk = 0; kk < 8; ++kk) kf[kk] = *(const s16x8*)(krow + 512 * kk); }
            __builtin_amdgcn_sched_barrier(0);
            const bool diag = (s0 == t0);
            float sg[16], om[16];
            if (diag) {
#pragma unroll
                for (int i = 0; i < 16; ++i) { const int sl = (i & 3) + 8 * (i >> 2) + 4 * hlf;
                    const float s = __builtin_amdgcn_rcpf(1.0f + __builtin_amdgcn_exp2f(-zt[i]));
                    const bool valid = sl < r;
                    sg[i] = valid ? s : 0.f; om[i] = valid ? 1.0f - s : 1.0f; }
            } else {
#pragma unroll
                for (int i = 0; i < 16; ++i) { const float s = __builtin_amdgcn_rcpf(1.0f + __builtin_amdgcn_exp2f(-zt[i])); sg[i] = s; om[i] = 1.0f - s; }
            }
            float Sg[4], Pg[4], tot[4];
#pragma unroll
            for (int g = 0; g < 4; ++g) { Sg[g] = (om[4 * g] * om[4 * g + 1]) * (om[4 * g + 2] * om[4 * g + 3]); Pg[g] = __shfl_xor(Sg[g], 32); tot[g] = Sg[g] * Pg[g]; }
            float after[4]; after[3] = 1.0f; after[2] = tot[3]; after[1] = tot[3] * tot[2]; after[0] = (tot[3] * tot[2]) * tot[1];
            const float T = ((tot[3] * tot[2]) * tot[1]) * tot[0];
            float A[16];
#pragma unroll
            for (int g = 0; g < 4; ++g) { float run = R * after[g] * (hlf == 0 ? Pg[g] : 1.0f);
#pragma unroll
                for (int w = 3; w >= 0; --w) { const int i = 4 * g + w; A[i] = sg[i] * run; run *= om[i]; } }
            R *= T;
#pragma unroll
            for (int sp = 0; sp < 2; ++sp) {
                v4u xa; xa.x = cvtpk_s(A[8 * sp], A[8 * sp + 1]); xa.y = cvtpk_s(A[8 * sp + 2], A[8 * sp + 3]); xa.z = cvtpk_s(A[8 * sp + 4], A[8 * sp + 5]); xa.w = cvtpk_s(A[8 * sp + 6], A[8 * sp + 7]);
                const s16x8 xf = __builtin_bit_cast(s16x8, xa);
#pragma unroll
                for (int et = 0; et < 4; ++et) {
                    O[et] = __builtin_amdgcn_mfma_f32_32x32x16_bf16(xf, vf[sp * 4 + et], O[et], 0, 0, 0);
                }
            }
            if (s0 == 0 || __all(R == 0.f)) break;
        }
        { LAS unsigned char* ot = F.lds + wave * 8704;
#pragma unroll
          for (int et = 0; et < 4; ++et)
#pragma unroll
              for (int i = 0; i < 16; ++i) { const int tr = (i & 3) + 8 * (i >> 2) + 4 * hlf;
                  *(LAS bf16*)(ot + tr * 272 + (32 * et + r) * 2) = (bf16)(cvtpk_s(O[et][i], 0.f) & 0xffffu); }
          LDS_WAIT();
#pragma unroll
          for (int q = 0; q < 8; ++q) { const int tr = 4 * q + (lane >> 4), ch = lane & 15;
              const v4u o = *(const LAS v4u*)(ot + tr * 272 + 16 * ch);
              *(v4u*)(ATTO + (size_t)(b * SEQ + t0 + tr) * DM + hh * 128 + 8 * ch) = o; }
          LDS_WAIT(); }
    }
}

__device__ __forceinline__ void moe_bases(const gu32* cnt, int (&base)[8], int (&cn)[8]) {
    int acc = 0;
#pragma unroll
    for (int e = 0; e < 8; ++e) { cn[e] = (int)__hip_atomic_load(cnt + 64 * e, RLX_AGENT); base[e] = acc; acc += (cn[e] + 255) & ~255; }
}
__device__ __forceinline__ void gather_phase(Frame& F) {
    int tid = threadIdx.x; asm volatile("" : "+v"(tid)); const int lane = tid & 63, wave = __builtin_amdgcn_readfirstlane(tid >> 6);
    unsigned char* ws = F.ws;
    const unsigned* TOKINFO = (const unsigned*)(ws + WS_TOKINFO); int* TOKSLOT = (int*)(ws + WS_TOKSLOT); float* SLOTGATE = (float*)(ws + WS_SLOTGATE);
    const bf16* HN = (const bf16*)(ws + WS_HN); unsigned char* HPERM = ws + WS_HPERM;
    int base[8], cn[8]; moe_bases(F.ctl + CW_CNT, base, cn);
    const int gw = F.bid * NWAVES + wave, NGW = F.G * NWAVES;
    for (int p0 = gw * 4; p0 < NTOK; p0 += NGW * 4) {
        v4u w0[4], w1[4];
#pragma unroll
        for (int i = 0; i < 4; ++i) { w0[i] = *(const v4u*)(TOKINFO + (size_t)(p0 + i) * 8); w1[i] = *(const v4u*)(TOKINFO + (size_t)(p0 + i) * 8 + 4); }
        v4u v[4][4];
#pragma unroll
        for (int i = 0; i < 4; ++i) { const v4u* src = (const v4u*)(HN + (size_t)(p0 + i) * DM);
#pragma unroll
            for (int j = 0; j < 4; ++j) v[i][j] = src[lane + 64 * j]; }
#pragma unroll
        for (int i = 0; i < 4; ++i) {
            int b0 = 0, b1 = 0;
#pragma unroll
            for (int e = 0; e < 8; ++e) { b0 = ((int)w0[i].x == e) ? base[e] : b0; b1 = ((int)w0[i].y == e) ? base[e] : b1; }
            const int s0 = b0 + (int)w0[i].z, s1 = b1 + (int)w0[i].w;
            v2u* d0 = (v2u*)(HPERM + (size_t)s0 * DM); v2u* d1 = (v2u*)(HPERM + (size_t)s1 * DM);
#pragma unroll
            for (int j = 0; j < 4; ++j) { const v4u x = v[i][j];
                v2u o; o.x = pg8::pk4_fp8(bflo(x.x), bfhi(x.x), bflo(x.y), bfhi(x.y)); o.y = pg8::pk4_fp8(bflo(x.z), bfhi(x.z), bflo(x.w), bfhi(x.w));
                d0[lane + 64 * j] = o; d1[lane + 64 * j] = o; }
            if (lane == 0) { TOKSLOT[(p0 + i) * 2] = s0; TOKSLOT[(p0 + i) * 2 + 1] = s1; SLOTGATE[s0] = __uint_as_float(w1[i].x); SLOTGATE[s1] = __uint_as_float(w1[i].y); }
        }
    }
    for (int q = gw; q < 2048; q += NGW) {
        const int e = q >> 8, r = q & 255;
        int be = 0, ce = 0;
#pragma unroll
        for (int k = 0; k < 8; ++k) { be = (e == k) ? base[k] : be; ce = (e == k) ? cn[k] : ce; }
        if ((ce & 255) != 0 && r >= (ce & 255)) { const int row = be + (ce & ~255) + r; v4u* d = (v4u*)(HPERM + (size_t)row * DM); const v4u z = {0u, 0u, 0u, 0u};
#pragma unroll
            for (int j = 0; j < 2; ++j) d[lane + 64 * j] = z;
            if (lane == 0) SLOTGATE[row] = 0.f; }
    }
}

__device__ __forceinline__ void route_phase(Frame& F, const bf16* xin, const float* gain, const float* modl, int sh_off, int sc_off, const float* tab, gu32* cnt, gu32* donec) {
    int tid = threadIdx.x; asm volatile("" : "+v"(tid)); const int lane = tid & 63, wave = __builtin_amdgcn_readfirstlane(tid >> 6);
    unsigned char* ws = F.ws;
    int* TOKSLOT = (int*)(ws + WS_TOKSLOT); float* SLOTGATE = (float*)(ws + WS_SLOTGATE); unsigned char* HPERM = ws + WS_HPERM;
    LAS float* sT = (LAS float*)(F.lds);
    LAS unsigned* lcnt = (LAS unsigned*)(F.lds + 65536 + 16384);
    for (int i = tid; i < 16384; i += 512) sT[i] = tab[i];
    if (tid < 16) lcnt[tid] = 0u;
    __syncthreads();
    const int gw = F.bid * NWAVES + wave, NGW = F.G * NWAVES, t0 = gw * 4;
    unsigned rowq[4][8]; int e0[4], e1[4]; unsigned p0[4], p1[4]; float g0[4], g1[4];
    if (t0 < NTOK) {
        const int b = t0 >> 12;
        f32x4 ga[8], sb[8];
#pragma unroll
        for (int j = 0; j < 8; ++j) { const int col = 4 * (lane + 64 * j);
            const f32x4 g = *(const f32x4*)(gain + col), sc = *(const f32x4*)(modl + (size_t)b * 12288 + sc_off + col);
            ga[j] = g * (sc + 1.0f); sb[j] = *(const f32x4*)(modl + (size_t)b * 12288 + sh_off + col); }
#pragma unroll
        for (int i = 0; i < 4; ++i) {
            const int t = t0 + i;
            f32x4 v[8]; float ss = 0.f;
#pragma unroll
            for (int j = 0; j < 8; ++j) { const v2u w = *(const v2u*)(xin + (size_t)t * DM + 4 * (lane + 64 * j)); v[j] = (f32x4){bflo(w.x), bfhi(w.x), bflo(w.y), bfhi(w.y)}; ss += dot4(v[j], v[j]); }
            ss = wave_sum(ss);
            const float r = 1.0f / sqrtf(ss * (1.0f / DM) + EPS);
#pragma unroll
            for (int j = 0; j < 8; ++j) { v[j] = v[j] * r * ga[j] + sb[j]; rowq[i][j] = pg8::pk4_fp8(v[j].x, v[j].y, v[j].z, v[j].w); }
            float a8[8]; int zi; asm volatile("v_mov_b32 %0, 0" : "=v"(zi));
#pragma unroll
            for (int g = 0; g < 8; ++g) { float s = 0.f;
#pragma unroll
                for (int j = 0; j < 8; ++j) { const f32x4 tv = *(const LAS f32x4*)(sT + g * 2048 + 4 * (lane + 64 * j) + zi); s += dot4(v[j], tv); }
                a8[g] = wave_sum(s); }
            int ea = 0; float va = a8[0];
#pragma unroll
            for (int g = 1; g < 8; ++g) if (a8[g] > va) { va = a8[g]; ea = g; }
            int eb = -1; float vb = -3.0e38f;
#pragma unroll
            for (int g = 0; g < 8; ++g) if (g != ea && a8[g] > vb) { vb = a8[g]; eb = g; }
            ea = __builtin_amdgcn_readfirstlane(ea); eb = __builtin_amdgcn_readfirstlane(eb);
            const float ex = expf(vb - va); g0[i] = 1.0f / (1.0f + ex); g1[i] = ex / (1.0f + ex);
            unsigned pa = 0u, pb = 0u;
            if (lane == 0) { pa = __hip_atomic_fetch_add((LAS unsigned*)(lcnt + ea), 1u, __ATOMIC_RELAXED, __HIP_MEMORY_SCOPE_WORKGROUP); pb = __hip_atomic_fetch_add((LAS unsigned*)(lcnt + eb), 1u, __ATOMIC_RELAXED, __HIP_MEMORY_SCOPE_WORKGROUP); }
            e0[i] = ea; e1[i] = eb; p0[i] = (unsigned)__builtin_amdgcn_readfirstlane((int)pa); p1[i] = (unsigned)__builtin_amdgcn_readfirstlane((int)pb);
        }
    }
    asm volatile("s_waitcnt vmcnt(0) lgkmcnt(0)" ::: "memory");
    __syncthreads();
    if (tid < 8) { const unsigned n = lcnt[tid]; lcnt[8 + tid] = n ? __hip_atomic_fetch_add(cnt + 64 * tid, n, RLX_AGENT) : 0u; }
    asm volatile("s_waitcnt vmcnt(0) lgkmcnt(0)" ::: "memory");
    __syncthreads();
    if (tid == 0) { __hip_atomic_fetch_add(donec, 1u, RLX_AGENT);
        unsigned sp = 0; while (__hip_atomic_load(donec, RLX_AGENT) < (unsigned)F.G) { __builtin_amdgcn_s_sleep(1); if (++sp > (1u << 22)) break; } }
    __syncthreads();
    int base[8], cn[8]; moe_bases(cnt, base, cn);
    LAS unsigned char* stg = F.lds + 65536 + wave * 2048;
    if (t0 < NTOK) {
#pragma unroll
        for (int i = 0; i < 4; ++i) {
            int b0 = 0, b1 = 0;
#pragma unroll
            for (int e = 0; e < 8; ++e) { b0 = (e0[i] == e) ? base[e] : b0; b1 = (e1[i] == e) ? base[e] : b1; }
            const int s0 = b0 + (int)(lcnt[8 + e0[i]] + p0[i]), s1 = b1 + (int)(lcnt[8 + e1[i]] + p1[i]);
#pragma unroll
            for (int j = 0; j < 8; ++j) *(LAS unsigned*)(stg + 4 * (lane + 64 * j)) = rowq[i][j];
            LDS_WAIT();
            const v4u o0 = *(const LAS v4u*)(stg + 32 * lane), o1 = *(const LAS v4u*)(stg + 32 * lane + 16);
            LDS_WAIT();
            v4u* d0 = (v4u*)(HPERM + (size_t)s0 * DM + 32 * lane); v4u* d1 = (v4u*)(HPERM + (size_t)s1 * DM + 32 * lane);
            d0[0] = o0; d0[1] = o1; d1[0] = o0; d1[1] = o1;
            if (lane == 0) { TOKSLOT[(t0 + i) * 2] = s0; TOKSLOT[(t0 + i) * 2 + 1] = s1; SLOTGATE[s0] = g0[i]; SLOTGATE[s1] = g1[i]; }
        }
    }
    for (int q = gw; q < 2048; q += NGW) {
        const int e = q >> 8, r = q & 255;
        int be = 0, ce = 0;
#pragma unroll
        for (int k = 0; k < 8; ++k) { be = (e == k) ? base[k] : be; ce = (e == k) ? cn[k] : ce; }
        if ((ce & 255) != 0 && r >= (ce & 255)) { const int row = be + (ce & ~255) + r; v4u* d = (v4u*)(HPERM + (size_t)row * DM); const v4u z = {0u, 0u, 0u, 0u};
#pragma unroll
            for (int j = 0; j < 2; ++j) d[lane + 64 * j] = z;
            if (lane == 0) SLOTGATE[row] = 0.f; }
    }
    __syncthreads();
}

__device__ __forceinline__ void final_phase(Frame& F, const Args& args) {
    int tid = threadIdx.x; asm volatile("" : "+v"(tid)); const int lane = tid & 63, wave = __builtin_amdgcn_readfirstlane(tid >> 6); (void)lane; (void)wave;
    unsigned char* ws = F.ws;
    const bf16* XR = (const bf16*)(ws + WS_XR); const bf16* Y = (const bf16*)(ws + WS_Y); const bf16* YP = (const bf16*)(ws + WS_YP); const int* TOKSLOT = (const int*)(ws + WS_TOKSLOT);
    const float* g2 = (const float*)(ws + WS_MOD) + (size_t)2 * 12288 + 10240; const float* gfin = args.in[6]; float* out = args.out;
    const int gw = F.bid * NWAVES + wave, NGW = F.G * NWAVES;
    for (int t = gw; t < NTOK; t += NGW) {
        const int b = t >> 12, s0 = __builtin_amdgcn_readfirstlane(TOKSLOT[t * 2]), s1 = __builtin_amdgcn_readfirstlane(TOKSLOT[t * 2 + 1]);
        f32x4 v[8]; float ss = 0.f;
        if (s0 < 16384 && s1 < 16384) {
            v2u xw[8], y0[8], y1[8]; f32x4 g[8];
#pragma unroll
            for (int j = 0; j < 8; ++j) { const int col = 4 * (lane + 64 * j);
                xw[j] = *(const v2u*)(XR + (size_t)t * DM + col); g[j] = *(const f32x4*)(g2 + (size_t)b * 12288 + col);
                y0[j] = *(const v2u*)(Y + (size_t)s0 * DM + col); y1[j] = *(const v2u*)(Y + (size_t)s1 * DM + col); }
#pragma unroll
            for (int j = 0; j < 8; ++j) { const f32x4 x = {bflo(xw[j].x), bfhi(xw[j].x), bflo(xw[j].y), bfhi(xw[j].y)};
                f32x4 ys = {0.f, 0.f, 0.f, 0.f};
                ys.x += bflo(y0[j].x); ys.y += bfhi(y0[j].x); ys.z += bflo(y0[j].y); ys.w += bfhi(y0[j].y);
                ys.x += bflo(y1[j].x); ys.y += bfhi(y1[j].x); ys.z += bflo(y1[j].y); ys.w += bfhi(y1[j].y);
                v[j] = x + g[j] * ys; ss += dot4(v[j], v[j]); }
        } else {
            const bf16* r0[4]; const bf16* r1[4]; float w0[4], w1[4];
#pragma unroll
            for (int q = 0; q < 4; ++q) {
                r0[q] = (s0 < 16384) ? Y + (size_t)s0 * DM : YP + ((size_t)q * 1792 + (s0 - 16384)) * DM; w0[q] = (s0 < 16384 && q > 0) ? 0.f : 1.f;
                r1[q] = (s1 < 16384) ? Y + (size_t)s1 * DM : YP + ((size_t)q * 1792 + (s1 - 16384)) * DM; w1[q] = (s1 < 16384 && q > 0) ? 0.f : 1.f; }
#pragma unroll
            for (int jh = 0; jh < 8; jh += 4) {
                v2u xw[4], ya[4][4], yb[4][4]; f32x4 g[4];
#pragma unroll
                for (int jj = 0; jj < 4; ++jj) { const int col = 4 * (lane + 64 * (jh + jj));
                    xw[jj] = *(const v2u*)(XR + (size_t)t * DM + col); g[jj] = *(const f32x4*)(g2 + (size_t)b * 12288 + col);
#pragma unroll
                    for (int q = 0; q < 4; ++q) { ya[jj][q] = *(const v2u*)(r0[q] + col); yb[jj][q] = *(const v2u*)(r1[q] + col); } }
#pragma unroll
                for (int jj = 0; jj < 4; ++jj) { const f32x4 x = {bflo(xw[jj].x), bfhi(xw[jj].x), bflo(xw[jj].y), bfhi(xw[jj].y)};
                    f32x4 ys = {0.f, 0.f, 0.f, 0.f};
#pragma unroll
                    for (int q = 0; q < 4; ++q) {
                        ys.x += w0[q] * bflo(ya[jj][q].x) + w1[q] * bflo(yb[jj][q].x); ys.y += w0[q] * bfhi(ya[jj][q].x) + w1[q] * bfhi(yb[jj][q].x);
                        ys.z += w0[q] * bflo(ya[jj][q].y) + w1[q] * bflo(yb[jj][q].y); ys.w += w0[q] * bfhi(ya[jj][q].y) + w1[q] * bfhi(yb[jj][q].y); }
                    v[jh + jj] = x + g[jj] * ys; ss += dot4(v[jh + jj], v[jh + jj]); }
            }
        }
        ss = wave_sum(ss);
        const float r = 1.0f / sqrtf(ss * (1.0f / DM) + EPS);
#pragma unroll
        for (int j = 0; j < 8; ++j) { const int col = 4 * (lane + 64 * j); const f32x4 g = *(const f32x4*)(gfin + col); *(f32x4*)(out + (size_t)t * DM + col) = v[j] * r * g; }
    }
}

__device__ __forceinline__ void panel_handoff(gu32* cnt, int my_pm, bool has, int need_pm, unsigned need) {
    int tid = threadIdx.x; asm volatile("" : "+v"(tid));
    asm volatile("s_waitcnt vmcnt(0)" ::: "memory");
    __syncthreads();
    if (tid == 0) {
        if (has) __hip_atomic_fetch_add(cnt + 64 * my_pm, 1u, RLX_AGENT);
        unsigned sp = 0; while (__hip_atomic_load(cnt + 64 * need_pm, RLX_AGENT) < need) { __builtin_amdgcn_s_sleep(1); if (++sp > (1u << 22)) break; }
        __builtin_amdgcn_fence(__ATOMIC_ACQUIRE, "agent"); asm volatile("s_waitcnt vmcnt(0)" ::: "memory");
    }
    __syncthreads();
}
__global__ void __launch_bounds__(NWAVES * 64, 2) hybrid_fwd(Args args) {
    extern __shared__ __attribute__((aligned(16))) unsigned char lds[];
    Frame F;
    F.lds = (LAS unsigned char*)lds;
    F.MISC = (volatile LAS unsigned*)(F.lds + MISC_OFF);
    F.G = gridDim.x; F.bid = blockIdx.x;
    unsigned char* ws = args.ws; F.ws = ws;
    F.ctl = (gu32*)(ws + WS_CTL);
    for (int u = threadIdx.x; u < (LDS_BYTES - LDSCTL_OFF) / 4; u += NWAVES * 64) ((LAS unsigned*)(F.lds + LDSCTL_OFF))[u] = 0u;
    __syncthreads();
    XcdBarrier bar = xcd_barrier_post((unsigned*)(F.ctl + CW_BAR), F.MISC + 8);
#define GRID_BAR() xcd_barrier(bar)
    using namespace pg8;
    PG8_LAS unsigned char* ring = F.lds + RING_OFF;
    const float* MOD = (const float*)(ws + WS_MOD);
    bf16* HN = (bf16*)(ws + WS_HN); bf16* XR = (bf16*)(ws + WS_XR);

#if SKELETON
    for (int k = 0; k < 20; ++k) GRID_BAR();
    for (size_t i = (size_t)F.bid * 512 + threadIdx.x; i < (size_t)NTOK * DM / 4; i += (size_t)F.G * 512) ((f32x4*)args.out)[i] = ((const f32x4*)args.in[0])[i];
#else
    p0_prologue(F, args);
    { int tid = threadIdx.x; asm volatile("" : "+v"(tid));
      if (tid == 0) { unsigned sp = 0; while (__hip_atomic_load(F.ctl + CW_P0PUB, RLX_AGENT) < (unsigned)F.G) { __builtin_amdgcn_s_sleep(1); if (++sp > (1u << 22)) break; }
          __builtin_amdgcn_fence(__ATOMIC_ACQUIRE, "agent"); asm volatile("s_waitcnt vmcnt(0)" ::: "memory"); }
      __syncthreads();
      norm_phase<0, false>(F, args.in[0], args.in[4], MOD, 0, 2048, HN, (const float*)(ws + WS_GWT), args.in[8], (float*)(ws + WS_GATES), nullptr, nullptr);
      const int cv0 = (F.G == 256 ? P0_TILE0 : 0) + F.bid;
      convert_tiles(F, args, cv0 + 2 * F.G, NT_ALL - QCVT_N, F.G); }
    GRID_BAR();
    { Dims g{DM, DM, DM}; DenseOrder S; S.init(NTOK, DINP, F.G, F.bid, HN, ws + WS_WIN, DM, DM); EpiBf16 E{(bf16*)(ws + WS_PROJ), DINP};
      gemm_phase<EpiBf16, DenseOrder, true, true>(ring, g, S, E);
      if (TAILQ2 > 0 && F.G == 256 && (long)((S.nwg + F.G - 1) / F.G - 1) * F.G + F.bid >= S.nwg) { const int k = F.bid - (S.nwg % F.G); convert_tiles(F, args, k, 128 * TAILQ2, 128); } }
    GRID_BAR();
    prep_phase(F, args);
    GRID_BAR();
    { const int hg = F.G / 2, lo = (F.bid < hg) ? F.bid : -1, hi = (F.bid >= hg) ? F.bid - hg : -1;
      { Dims g{256, 256, 256}; BatchOrder S{NUNIT, hg, lo, (const char*)(ws + WS_QB), (const char*)(ws + WS_KB), (size_t)256 * 256 * 2, (size_t)256 * 256 * 2};
        EpiW E{(bf16*)(ws + WS_AP), (const float*)(ws + WS_BCUM), (const float*)(ws + WS_IG)};
        gemm_phase<EpiW, BatchOrder, true, true>(ring, g, S, E); }
      { Dims g{512, 256, 256}; BatchOrder S{NUNIT, F.G - hg, hi, (const char*)(ws + WS_BP) + 512, (const char*)(ws + WS_KWT), (size_t)256 * 512 * 2, (size_t)256 * 256 * 2};
        EpiDC E{(float*)(ws + WS_DCT)};
        gemm_phase<EpiDC, BatchOrder, true, true>(ring, g, S, E);
        if (TAILQ4 > 0 && F.G == 256 && hi >= 0) convert_tiles(F, args, 128 * (TAILQ2 + TAILQ10 + TAILQ6) + hi, 128 * (TAILQ2 + TAILQ10 + TAILQ6 + TAILQ4), 128); }
      { Dims g{1024, 256, 256}; PoolOrder S{hg, lo, (const char*)(ws + WS_POOLED), (const char*)(ws + WS_POOLW)};
        EpiPool E{(bf16*)(ws + WS_MIXCAT), args.in[13]};
        gemm_phase<EpiPool, PoolOrder, true, true>(ring, g, S, E); } }
    GRID_BAR();
    scan_phase(F);
    GRID_BAR();
    { LAS float* sDen = (LAS float*)(F.lds + RING_OFF + RING_BYTES); LAS float* sSS = sDen + 256;
      if (F.bid < NUNIT) {
          int tid = threadIdx.x; asm volatile("" : "+v"(tid)); const int lane = tid & 63, wave = __builtin_amdgcn_readfirstlane(tid >> 6);
          const bf16* ap0 = (const bf16*)(ws + WS_AP) + (size_t)F.bid * 256 * 512; const f32x4 nv = *(const f32x4*)((const float*)(ws + WS_NVEC) + F.bid * 256 + 4 * lane);
#pragma nounroll
          for (int r0 = wave * 32; r0 < wave * 32 + 32; r0 += 8) {
              v2u qa[8], wa[8];
#pragma unroll
              for (int i = 0; i < 8; ++i) { const bf16* ap = ap0 + (size_t)(r0 + i) * 512; qa[i] = *(const v2u*)(ap + 4 * lane); wa[i] = *(const v2u*)(ap + 256 + 4 * lane); }
#pragma unroll
              for (int i = 0; i < 8; ++i) {
                  const float part = bflo(qa[i].x) * nv.x + bfhi(qa[i].x) * nv.y + bflo(qa[i].y) * nv.z + bfhi(qa[i].y) * nv.w + (bflo(wa[i].x) + bfhi(wa[i].x)) + (bflo(wa[i].y) + bfhi(wa[i].y));
                  const float den = wave_sum(part);
                  if (lane == 0) sDen[r0 + i] = 1.0f / fmaxf(fabsf(den), 1.0f); } }
      }
      Dims g{512, 512, 512}; BatchOrder S{NUNIT, F.G, F.bid, (const char*)(ws + WS_AP), (const char*)(ws + WS_BP), (size_t)256 * 512 * 2, (size_t)256 * 512 * 2};
      EpiFin E{(bf16*)(ws + WS_MIXCAT), (const bf16*)(ws + WS_PROJ), DINP, args.in[11], sDen, sSS, EPS};
      gemm_phase<EpiFin, BatchOrder, true, true>(ring, g, S, E);
      if (TAILQ6 > 0 && F.G == 256 && F.bid >= NUNIT) convert_tiles(F, args, 128 * (TAILQ2 + TAILQ10) + (F.bid - NUNIT), 128 * (TAILQ2 + TAILQ10 + TAILQ6), 128); }
    GRID_BAR();
    { Dims g{DM, DM, DM}; DenseOrder S; S.init(NTOK, DM, F.G, F.bid, ws + WS_MIXCAT, ws + WS_WOUT, DM, DM); EpiResid<false> E{args.in[0], XR, MOD + 4096, 1.0f};
      gemm_phase<EpiResid<false>, DenseOrder, true, true>(ring, g, S, E);
      Unit u0; const bool has = S.next(0, u0);
      if (F.G == 256 && S.nwg == F.G) panel_handoff(F.ctl + CW_PAN8, u0.pm, has, F.bid >> 3, 8u); else GRID_BAR(); }
    norm_phase<1, true, true>(F, XR, args.in[5], MOD, 6144, 8192, HN, nullptr, nullptr, nullptr, nullptr, nullptr);
    GRID_BAR();
    { Dims g{DM / 2, DM / 2, DM / 2}; DenseOrder S; S.init(NTOK, 2 * DFF, F.G, F.bid, HN, ws + WS_W13, DM / 2, DM / 2); EpiSwiglu8 E{ws + WS_U, DFF, 1 << 20, 1.0f / WS8};
      gemm_phase<EpiSwiglu8, DenseOrder, true, true, true>(ring, g, S, E);
      if (TAILQ10 > 0 && F.G == 256 && (long)((S.nwg + F.G - 1) / F.G - 1) * F.G + F.bid >= S.nwg) { const int k = F.bid - (S.nwg % F.G); convert_tiles(F, args, 128 * TAILQ2 + k, 128 * (TAILQ2 + TAILQ10), 128); } }
    GRID_BAR();
    { Dims g{DFF / 2, DFF / 2, DFF / 2}; DenseOrder S; S.init(NTOK, DM, F.G, F.bid, ws + WS_U, ws + WS_W2, DFF / 2, DFF / 2); EpiResid<true> E{XR, XR, MOD + 10240, 1.0f / WS8};
      gemm_phase<EpiResid<true>, DenseOrder, true, true, true>(ring, g, S, E);
      Unit u0; const bool has = S.next(0, u0);
      if (F.G == 256 && S.nwg == F.G) panel_handoff(F.ctl + CW_PAN11, u0.pm, has, F.bid >> 3, 8u); else GRID_BAR(); }
    const float* MOD1 = MOD + 2 * 12288;
    norm_phase<1, true>(F, XR, args.in[4] + DM, MOD1, 0, 2048, HN, nullptr, nullptr, nullptr, nullptr, nullptr);
    GRID_BAR();
    { Dims g{DM, DM, DM}; DenseOrder S; S.init(NTOK, 2 * DM, F.G, F.bid, HN, ws + WS_WQKV, DM, DM); EpiQKblk E{(bf16*)(ws + WS_QB2), (bf16*)(ws + WS_KB2), 0.08838834764831845f * 1.4426950408889634f};
      gemm_phase<EpiQKblk, DenseOrder, true, true>(ring, g, S, E); }
    { Dims g{DM, DM, DM}; DenseOrder S; S.init(DM, NTOK, F.G, F.bid, ws + WS_WQKV + (size_t)2 * DM * DM * 2, HN, DM, DM); EpiVblk E{(bf16*)(ws + WS_VT)};
      gemm_phase<EpiVblk, DenseOrder, true, true>(ring, g, S, E); }
    GRID_BAR();
    attn_phase(F);
    GRID_BAR();
    { Dims g{DM, DM, DM}; DenseOrder S; S.init(NTOK, DM, F.G, F.bid, ws + WS_ATTO, ws + WS_WO, DM, DM); EpiResid<true> E{XR, XR, MOD1 + 4096, 1.0f};
      gemm_phase<EpiResid<true>, DenseOrder, true, true>(ring, g, S, E);
      Unit u0; const bool has = S.next(0, u0);
      if (F.G == 256 && S.nwg == F.G) panel_handoff(F.ctl + CW_PAN15, u0.pm, has, F.bid >> 3, 8u); else GRID_BAR(); }
    if (F.G * NWAVES * 4 >= NTOK) {
        route_phase(F, XR, args.in[5] + DM, MOD1, 6144, 8192, (const float*)(ws + WS_RWT), F.ctl + CW_CNT, F.ctl + CW_RDONE);
    } else {
        norm_phase<2, true>(F, XR, args.in[5] + DM, MOD1, 6144, 8192, HN, (const float*)(ws + WS_RWT), nullptr, nullptr, (unsigned*)(ws + WS_TOKINFO), F.ctl + CW_CNT);
        GRID_BAR();
        gather_phase(F);
    }
    GRID_BAR();
    { int base[8], cn[8]; moe_bases(F.ctl + CW_CNT, base, cn);
      MoeOrder S; S.G = F.G; S.c = F.bid;
#pragma unroll
      for (int e = 0; e < 8; ++e) S.cumP[e] = base[e] >> 8;
      S.cumP[8] = (base[7] + ((cn[7] + 255) & ~255)) >> 8;
      { S.nNl = 56; S.A = (const char*)(ws + WS_HPERM); S.Bt = (const char*)(ws + WS_W13E); S.tsa = (size_t)256 * DM; S.tsb = (size_t)256 * DM;
        Dims g{DM / 2, DM / 2, DM / 2}; EpiSwiglu8 E{ws + WS_UE, DFE, 56, 1.0f / WS8};
        gemm_phase<EpiSwiglu8, MoeOrder, true, true, true>(ring, g, S, E); }
      convert_tiles<true>(F, args, QCVT_LO, QCVT_LO + QCVT_N, 0, F.ctl + CW_QCVT);
      GRID_BAR();
      { const int Ptot = S.cumP[8];
        SplitOrder T; T.G = F.G; T.c = F.bid; T.A = (const char*)(ws + WS_UE); T.Bt = (const char*)(ws + WS_W2E); T.tsa = (size_t)256 * DFE; T.tsb = (size_t)256 * DFE; T.kq_bytes = DFE / 4;
#pragma unroll
        for (int e = 0; e < 9; ++e) { T.cumP[e] = S.cumP[e]; S.cumP[e] = S.cumP[e] < 64 ? S.cumP[e] : 64; }
        (void)Ptot;
        S.nNl = 8; S.A = (const char*)(ws + WS_UE); S.Bt = (const char*)(ws + WS_W2E); S.tsa = (size_t)256 * DFE; S.tsb = (size_t)256 * DFE;
        { Dims g{DFE / 2, DFE / 2, DFE / 2}; EpiY E{(bf16*)(ws + WS_Y), (const float*)(ws + WS_SLOTGATE), 1.0f / WS8};
          gemm_phase<EpiY, MoeOrder, true, true, true>(ring, g, S, E); }
        { Dims g{DFE / 2, DFE / 2, DFE / 8}; EpiYp E{(bf16*)(ws + WS_YP), (const float*)(ws + WS_SLOTGATE), 1.0f / WS8};
          gemm_phase<EpiYp, SplitOrder, true, true, true>(ring, g, T, E); } }
    }
    GRID_BAR();
    final_phase(F, args);
#endif
}

extern "C" void kernel_launch(void* const* d_in, const int* in_sizes, int n_in, void* d_out, int out_size, void* d_ws, size_t ws_size, hipStream_t stream) {
    static int grid = 0;
    if (grid == 0) {
        if (n_in != 24 || out_size != NTOK * DM || ws_size < WS_END) { fprintf(stderr, "kernel_launch: unexpected shapes (n_in %d, out %d, ws %zu < %zu); nothing launched\n", n_in, out_size, ws_size, (size_t)WS_END); grid = -1; return; }
        int dev = 0, cus = 0, per_cu = 0;
        if (hipGetDevice(&dev) != hipSuccess || hipDeviceGetAttribute(&cus, hipDeviceAttributeMultiprocessorCount, dev) != hipSuccess) { grid = -1; return; }
        if (hipFuncSetAttribute((const void*)hybrid_fwd, hipFuncAttributeMaxDynamicSharedMemorySize, LDS_BYTES) != hipSuccess) { fprintf(stderr, "kernel_launch: hipFuncSetAttribute failed\n"); grid = -1; return; }
        if (hipOccupancyMaxActiveBlocksPerMultiprocessor(&per_cu, (const void*)hybrid_fwd, NWAVES * 64, LDS_BYTES) != hipSuccess || per_cu < 1)
            fprintf(stderr, "kernel_launch: note: occupancy query reports %d workgroups per CU\n", per_cu);
        (void)hipGetLastError();
        grid = cus;
    }
    if (grid < 0) return;
    if (hipMemsetAsync((char*)d_ws + WS_CTL, 0, CTL_ZERO_BYTES, stream) != hipSuccess) return;
    Args a{};
    for (int i = 0; i < 24; ++i) a.in[i] = (const float*)d_in[i];
    a.out = (float*)d_out; a.ws = (unsigned char*)d_ws;
    hipLaunchKernelGGL(hybrid_fwd, dim3(grid), dim3(NWAVES * 64), LDS_BYTES, stream, a);
    const hipError_t le = hipPeekAtLastError();
    if (le != hipSuccess) fprintf(stderr, "kernel_launch: launch failed: %s\n", hipGetErrorName(le));
}
```

```cpp
#include <hip/hip_runtime.h>
#include <cstdio>
#include <cstdint>

#ifndef SKELETON
#define SKELETON 0
#endif

namespace pg8 {
#define PG8_LAS __attribute__((address_space(3)))
typedef unsigned short bf16_t;
typedef short bf16x8 __attribute__((ext_vector_type(8)));
typedef float f32x4 __attribute__((ext_vector_type(4)));
typedef unsigned u32x4 __attribute__((ext_vector_type(4)));
constexpr int BM = 256, BK = 64, HALF = 128, HTB = HALF * BK * 2  , STAGE_BYTES = 8 * HTB, NXCD = 8, WGM = 4;

__host__ __device__ __forceinline__ int lds_byte(int r, int c) { const int st = (r >> 4) * 2 + (c >> 5), rr = r & 15, cc = c & 31, ob = rr * 64 + cc * 2; return st * 1024 + (ob ^ (((ob >> 9) & 1) << 5)); }
__host__ __device__ __forceinline__ void stage_rc(int b, int& R, int& C) { const int st = b / 1024, sb = b % 1024, swz = sb ^ (((sb >> 9) & 1) << 5); R = (st >> 1) * 16 + swz / 64; C = (st & 1) * 32 + (swz % 64) / 2; }
__host__ __device__ __forceinline__ int perm32(int rho) { const int n = rho >> 4, i = rho & 15; return 8 * (i >> 2) + 4 * n + (i & 3); }

struct Unit { int pm, pn; const char* a; const char* b; };
struct Dims { int lda, ldb, K; };

__device__ __forceinline__ unsigned cvt_pk_bf16(float lo, float hi) { unsigned r; asm volatile("v_cvt_pk_bf16_f32 %0, %1, %2" : "=v"(r) : "v"(lo), "v"(hi)); return r; }

__device__ __forceinline__ int xcd_remap(int wgid, int nwg) { const int q = nwg / NXCD, r = nwg % NXCD, xcd = wgid % NXCD, off = wgid / NXCD; return (xcd < r ? xcd * (q + 1) : r * (q + 1) + (xcd - r) * q) + off; }

struct DenseOrder {
    int nM, nN, nwg, G, c; const char* A; const char* Bt; size_t tsa, tsb;
    __device__ __forceinline__ void init(int M, int N, int G_, int c_, const void* A_, const void* Bt_, int lda, int ldb) { nM = M / BM; nN = N / BM; nwg = nM * nN; G = G_; c = c_; A = (const char*)A_; Bt = (const char*)Bt_; tsa = (size_t)BM * lda * 2; tsb = (size_t)BM * ldb * 2; }
    __device__ __forceinline__ bool next(int i, Unit& u) const {
        const long L = (long)i * G + c; if (L >= nwg) return false;
        const int wgid = xcd_remap((int)L, nwg);
        const int nig = WGM * nN, gid = wgid / nig, fm = gid * WGM, gsz = (nM - fm) < WGM ? (nM - fm) : WGM;
        u.pm = fm + ((wgid % nig) % gsz); u.pn = (wgid % nig) / gsz; u.a = A + (size_t)u.pm * tsa; u.b = Bt + (size_t)u.pn * tsb; return true;
    }
    __device__ __forceinline__ void a_ready(const Unit&) const {}
    __device__ __forceinline__ void done(const Unit&) const {}
};
struct DenseOrderA : DenseOrder {
    const __attribute__((address_space(1))) unsigned* ready; unsigned need;
    __device__ __forceinline__ void a_ready(const Unit& u) const {
        if (need == 0u) return;
        if (threadIdx.x < 64) { unsigned sp = 0;
            while ((unsigned)__builtin_amdgcn_readfirstlane((int)__hip_atomic_load(ready + 64 * u.pm, __ATOMIC_RELAXED, __HIP_MEMORY_SCOPE_AGENT)) < need) { __builtin_amdgcn_s_sleep(1); if (++sp > (1u << 22)) break; }
            __builtin_amdgcn_fence(__ATOMIC_ACQUIRE, "agent");
            asm volatile("s_waitcnt vmcnt(0)" ::: "memory"); }
        asm volatile("" ::: "memory"); __builtin_amdgcn_s_barrier(); asm volatile("" ::: "memory");
    }
};
struct BatchOrder {
    int n, G, c; const char* A; const char* Bt; size_t tsa, tsb;
    __device__ __forceinline__ bool next(int i, Unit& u) const { const long L = (long)i * G + c; if (c < 0 || L >= n) return false; u.pm = (int)L; u.pn = (int)L; u.a = A + (size_t)L * tsa; u.b = Bt + (size_t)L * tsb; return true; }
    __device__ __forceinline__ void a_ready(const Unit&) const {}
    __device__ __forceinline__ void done(const Unit&) const {}
};
struct PoolOrder {
    int G, c; const char* A; const char* Bt;
    __device__ __forceinline__ bool next(int i, Unit& u) const { const long L = (long)i * G + c; if (c < 0 || L >= 128) return false; u.pm = (int)L & 31; u.pn = (int)L >> 5; u.a = A + (size_t)u.pm * (256 * 1024 * 2) + (size_t)u.pn * 512; u.b = Bt + (size_t)u.pn * (256 * 256 * 2); return true; }
    __device__ __forceinline__ void a_ready(const Unit&) const {}
    __device__ __forceinline__ void done(const Unit&) const {}
};
struct MoeOrder {
    int G, c, nNl; int cumP[9]; const char* A; const char* Bt; size_t tsa, tsb;
    __device__ __forceinline__ bool next(int i, Unit& u) const {
        const int nwg = cumP[8] * nNl; const long L = (long)i * G + c; if (L >= nwg) return false;
        const int wgid = xcd_remap((int)L, nwg);
        int e = 0;
#pragma unroll
        for (int k = 1; k < 8; ++k) e += (wgid >= cumP[k] * nNl) ? 1 : 0;
        int p0 = cumP[0], p1 = cumP[1];
#pragma unroll
        for (int k = 1; k < 8; ++k) { p0 = (e == k) ? cumP[k] : p0; p1 = (e == k) ? cumP[k + 1] : p1; }
        const int local = wgid - p0 * nNl, Pe = p1 - p0;
        u.pm = p0 + local % Pe; u.pn = e * nNl + local / Pe; u.a = A + (size_t)u.pm * tsa; u.b = Bt + (size_t)u.pn * tsb; return true;
    }
    __device__ __forceinline__ void a_ready(const Unit&) const {}
    __device__ __forceinline__ void done(const Unit&) const {}
};

struct SplitOrder {
    int G, c; int cumP[9]; const char* A; const char* Bt; size_t tsa, tsb; int kq_bytes;
    __device__ __forceinline__ bool next(int i, Unit& u) const {
        const long L = (long)i * G + c; const int n = (cumP[8] - 64) * 32; if (L >= n) return false;
        const int p = 64 + (int)L / 32, rem = (int)L & 31, pnl = rem >> 2, kq = rem & 3;
        int e = 0;
#pragma unroll
        for (int k = 1; k < 8; ++k) e += (p >= cumP[k]) ? 1 : 0;
        u.pm = p; u.pn = pnl + 64 * kq; u.a = A + (size_t)p * tsa + (size_t)kq * kq_bytes; u.b = Bt + (size_t)(e * 8 + pnl) * tsb + (size_t)kq * kq_bytes; return true;
    }
    __device__ __forceinline__ void a_ready(const Unit&) const {}
    __device__ __forceinline__ void done(const Unit&) const {}
};

__device__ __forceinline__ float silu_f(float x) { return x * __builtin_amdgcn_rcpf(1.0f + __expf(-x)); }
typedef float f32x2p __attribute__((ext_vector_type(2)));
__device__ __forceinline__ f32x2p swiglu2(f32x2p a, f32x2p b, float c1, float c2) {
    const f32x2p z = a * c1; f32x2p t; t.x = __builtin_amdgcn_exp2f(z.x); t.y = __builtin_amdgcn_exp2f(z.y);
    const f32x2p d = t + 1.0f; f32x2p s; s.x = __builtin_amdgcn_rcpf(d.x); s.y = __builtin_amdgcn_rcpf(d.y);
    return (a * b) * (s * c2);
}
__device__ __forceinline__ f32x2p sigm2(unsigned w) {
    f32x2p x; x.x = __uint_as_float(w << 16); x.y = __uint_as_float(w & 0xffff0000u);
    const f32x2p z = x * -1.4426950408889634f; f32x2p t; t.x = __builtin_amdgcn_exp2f(z.x); t.y = __builtin_amdgcn_exp2f(z.y);
    const f32x2p d = t + 1.0f; f32x2p s; s.x = __builtin_amdgcn_rcpf(d.x); s.y = __builtin_amdgcn_rcpf(d.y); return s;
}

struct EpiBf16 {
    static constexpr bool PERM = true;
    bf16_t* O; int ldc;
    __device__ __forceinline__ void operator()(const f32x4 (&acc)[2][2][4][2], const Unit& u, int wr, int wc, int fr_, int fq_) const {
        int z_; asm volatile("v_mov_b32 %0, 0" : "=v"(z_)); const int fr = fr_ + z_, fq = fq_ + z_;
        const int row0 = u.pm * BM + wr * 64 + fr, col0 = u.pn * BM + wc * 32 + 8 * fq;
#pragma unroll
        for (int ai = 0; ai < 2; ++ai)
#pragma unroll
            for (int m = 0; m < 4; ++m) { bf16_t* rowp = O + (size_t)(row0 + ai * HALF + m * 16) * ldc + col0;
#pragma unroll
                for (int bj = 0; bj < 2; ++bj) { const f32x4 v0 = acc[ai][bj][m][0], v1 = acc[ai][bj][m][1];
                    u32x4 w; w.x = cvt_pk_bf16(v0[0], v0[1]); w.y = cvt_pk_bf16(v0[2], v0[3]); w.z = cvt_pk_bf16(v1[0], v1[1]); w.w = cvt_pk_bf16(v1[2], v1[3]);
                    *(u32x4*)(rowp + bj * HALF) = w; } }
    }
};
struct EpiQKblk {
    static constexpr bool PERM = true;
    bf16_t* Q; bf16_t* K; float qs;
    __device__ __forceinline__ void operator()(const f32x4 (&acc)[2][2][4][2], const Unit& u, int wr, int wc, int fr_, int fq_) const {
        int z_; asm volatile("v_mov_b32 %0, 0" : "=v"(z_)); const int fr = fr_ + z_, fq = fq_ + z_;
#pragma unroll
        for (int bj = 0; bj < 2; ++bj) { const int c0 = u.pn * BM + bj * HALF + wc * 32 + 8 * fq; bf16_t* base = (c0 >= 2048) ? K : Q; const float sc = (c0 >= 2048) ? 1.0f : qs;
            const int hh = (c0 & 2047) >> 7, d0 = c0 & 127; const size_t cofs = (size_t)hh * (128 * 4096) + (d0 >> 4) * 512 + ((d0 >> 3) & 1) * 8;
#pragma unroll
            for (int ai = 0; ai < 2; ++ai)
#pragma unroll
                for (int m = 0; m < 4; ++m) { const int t = u.pm * BM + ai * HALF + wr * 64 + m * 16 + fr, b = t >> 12, pos = t & 4095;
                    bf16_t* dst = base + (size_t)b * (16 * 128 * 4096) + cofs + (size_t)(pos >> 5) * 4096 + (pos & 31) * 16;
                    const f32x4 v0 = acc[ai][bj][m][0] * sc, v1 = acc[ai][bj][m][1] * sc;
                    u32x4 w; w.x = cvt_pk_bf16(v0[0], v0[1]); w.y = cvt_pk_bf16(v0[2], v0[3]); w.z = cvt_pk_bf16(v1[0], v1[1]); w.w = cvt_pk_bf16(v1[2], v1[3]);
                    *(u32x4*)dst = w; } }
    }
};
struct EpiVblk {
    static constexpr bool PERM = true;
    bf16_t* V;
    __device__ __forceinline__ void operator()(const f32x4 (&acc)[2][2][4][2], const Unit& u, int wr, int wc, int fr_, int fq_) const {
        int z_; asm volatile("v_mov_b32 %0, 0" : "=v"(z_)); const int fr = fr_ + z_, fq = fq_ + z_;
        typedef unsigned u32x2v __attribute__((ext_vector_type(2)));
#pragma unroll
        for (int bj = 0; bj < 2; ++bj) { const int tok0 = u.pn * BM + bj * HALF + wc * 32 + 8 * fq, b = tok0 >> 12, pos0 = tok0 & 4095, k0 = pos0 & 31;
            const size_t cofs = (size_t)b * (16 * 128 * 4096) + (size_t)(pos0 >> 5) * 4096 + (k0 >> 4) * 2048 + ((k0 >> 3) & 1) * 4;
#pragma unroll
            for (int ai = 0; ai < 2; ++ai)
#pragma unroll
                for (int m = 0; m < 4; ++m) { const int f = u.pm * BM + ai * HALF + wr * 64 + m * 16 + fr, hh = f >> 7, e = f & 127;
                    bf16_t* dst = V + cofs + (size_t)hh * (128 * 4096) + (e >> 5) * 512 + (e & 31) * 16;
                    const f32x4 v0 = acc[ai][bj][m][0], v1 = acc[ai][bj][m][1];
                    u32x2v w0, w1; w0.x = cvt_pk_bf16(v0[0], v0[1]); w0.y = cvt_pk_bf16(v0[2], v0[3]); w1.x = cvt_pk_bf16(v1[0], v1[1]); w1.y = cvt_pk_bf16(v1[2], v1[3]);
                    *(u32x2v*)dst = w0; *(u32x2v*)(dst + 8) = w1; } }
    }
};
template <bool BASE16> struct EpiResid {
    static constexpr bool PERM = true;
    const void* base; bf16_t* out; const float* gate; float gs;
    __device__ __forceinline__ void operator()(const f32x4 (&acc)[2][2][4][2], const Unit& u, int wr, int wc, int fr_, int fq_) const {
        int z_; asm volatile("v_mov_b32 %0, 0" : "=v"(z_)); const int fr = fr_ + z_, fq = fq_ + z_;
        const int row0 = u.pm * BM + wr * 64 + fr, col0 = u.pn * BM + wc * 32 + 8 * fq;
        const float* gp = gate + (size_t)((u.pm * BM) >> 12) * 12288 + col0;
        const __amdgpu_buffer_rsrc_t rs = __builtin_amdgcn_make_buffer_rsrc((void*)out, 0, 8192 * 2048 * 2, 0x00020000);
        f32x4 gv[2][2];
#pragma unroll
        for (int bj = 0; bj < 2; ++bj)
#pragma unroll
            for (int n = 0; n < 2; ++n) gv[bj][n] = *(const f32x4*)(gp + bj * HALF + 4 * n) * gs;
#pragma unroll
        for (int ai = 0; ai < 2; ++ai)
#pragma unroll
            for (int m = 0; m < 4; ++m) { const size_t off = (size_t)(row0 + ai * HALF + m * 16) * 2048 + col0;
#pragma unroll
                for (int bj = 0; bj < 2; ++bj) { f32x4 b0, b1;
                    if (BASE16) { const u32x4 w = *(const u32x4*)((const bf16_t*)base + off + bj * HALF);
                        b0 = (f32x4){__uint_as_float(w.x << 16), __uint_as_float(w.x & 0xffff0000u), __uint_as_float(w.y << 16), __uint_as_float(w.y & 0xffff0000u)};
                        b1 = (f32x4){__uint_as_float(w.z << 16), __uint_as_float(w.z & 0xffff0000u), __uint_as_float(w.w << 16), __uint_as_float(w.w & 0xffff0000u)}; }
                    else { b0 = *(const f32x4*)((const float*)base + off + bj * HALF); b1 = *(const f32x4*)((const float*)base + off + bj * HALF + 4); }
                    const f32x4 v0 = b0 + gv[bj][0] * acc[ai][bj][m][0], v1 = b1 + gv[bj][1] * acc[ai][bj][m][1];
                    u32x4 o; o.x = cvt_pk_bf16(v0[0], v0[1]); o.y = cvt_pk_bf16(v0[2], v0[3]); o.z = cvt_pk_bf16(v1[0], v1[1]); o.w = cvt_pk_bf16(v1[2], v1[3]);
                    __builtin_amdgcn_raw_buffer_store_b128(o, rs, (int)((off + bj * HALF) * 2), 0, 16); }
                asm volatile("" ::: "memory"); }
    }
};
struct EpiSwiglu {
    static constexpr bool PERM = true;
    bf16_t* O; int ldo; int nNl;
    __device__ __forceinline__ void operator()(const f32x4 (&acc)[2][2][4][2], const Unit& u, int wr, int wc, int fr_, int fq_) const {
        int z_; asm volatile("v_mov_b32 %0, 0" : "=v"(z_)); const int fr = fr_ + z_, fq = fq_ + z_;
        const int row0 = u.pm * BM + wr * 64 + fr, col0 = (u.pn % nNl) * HALF + wc * 32 + 8 * fq;
#pragma unroll
        for (int ai = 0; ai < 2; ++ai)
#pragma unroll
            for (int m = 0; m < 4; ++m) { bf16_t* rowp = O + (size_t)(row0 + ai * HALF + m * 16) * ldo + col0;
                const f32x4 a0 = acc[ai][0][m][0], a1 = acc[ai][0][m][1], b0 = acc[ai][1][m][0], b1 = acc[ai][1][m][1];
                const f32x2p r0 = swiglu2((f32x2p){a0[0], a0[1]}, (f32x2p){b0[0], b0[1]}, -1.4426950408889634f, 1.0f), r1 = swiglu2((f32x2p){a0[2], a0[3]}, (f32x2p){b0[2], b0[3]}, -1.4426950408889634f, 1.0f);
                const f32x2p r2 = swiglu2((f32x2p){a1[0], a1[1]}, (f32x2p){b1[0], b1[1]}, -1.4426950408889634f, 1.0f), r3 = swiglu2((f32x2p){a1[2], a1[3]}, (f32x2p){b1[2], b1[3]}, -1.4426950408889634f, 1.0f);
                u32x4 w; w.x = cvt_pk_bf16(r0.x, r0.y); w.y = cvt_pk_bf16(r1.x, r1.y); w.z = cvt_pk_bf16(r2.x, r2.y); w.w = cvt_pk_bf16(r3.x, r3.y);
                *(u32x4*)rowp = w; }
    }
};
__device__ __forceinline__ unsigned pk4_fp8(float a, float b, float c, float d) { int w = 0; w = __builtin_amdgcn_cvt_pk_fp8_f32(a, b, w, false); w = __builtin_amdgcn_cvt_pk_fp8_f32(c, d, w, true); return (unsigned)w; }
struct EpiSwiglu8 {
    static constexpr bool PERM = true;
    unsigned char* O; int ldo; int nNl; float inv;
    __device__ __forceinline__ void operator()(const f32x4 (&acc)[2][2][4][2], const Unit& u, int wr, int wc, int fr, int fq) const {
        const int row0 = u.pm * BM + wr * 64 + fr, col0 = (u.pn % nNl) * HALF + wc * 32 + 8 * fq;
#pragma unroll
        for (int ai = 0; ai < 2; ++ai)
#pragma unroll
            for (int m = 0; m < 4; ++m) { unsigned char* rowp = O + (size_t)(row0 + ai * HALF + m * 16) * ldo + col0;
                const f32x4 a0 = acc[ai][0][m][0], a1 = acc[ai][0][m][1], b0 = acc[ai][1][m][0], b1 = acc[ai][1][m][1];
                const float c1 = -1.4426950408889634f * inv, c2 = inv * inv;
                const f32x2p r0 = swiglu2((f32x2p){a0[0], a0[1]}, (f32x2p){b0[0], b0[1]}, c1, c2), r1 = swiglu2((f32x2p){a0[2], a0[3]}, (f32x2p){b0[2], b0[3]}, c1, c2);
                const f32x2p r2 = swiglu2((f32x2p){a1[0], a1[1]}, (f32x2p){b1[0], b1[1]}, c1, c2), r3 = swiglu2((f32x2p){a1[2], a1[3]}, (f32x2p){b1[2], b1[3]}, c1, c2);
                typedef unsigned u32x2v __attribute__((ext_vector_type(2)));
                u32x2v w; w.x = pk4_fp8(r0.x, r0.y, r1.x, r1.y); w.y = pk4_fp8(r2.x, r2.y, r3.x, r3.y);
                *(u32x2v*)rowp = w; }
    }
};
struct EpiY {
    static constexpr bool PERM = true;
    bf16_t* Y; const float* sg; float inv;
    __device__ __forceinline__ void operator()(const f32x4 (&acc)[2][2][4][2], const Unit& u, int wr, int wc, int fr_, int fq_) const {
        int z_; asm volatile("v_mov_b32 %0, 0" : "=v"(z_)); const int fr = fr_ + z_, fq = fq_ + z_;
        const int row0 = u.pm * BM + wr * 64 + fr, col0 = (u.pn & 7) * BM + wc * 32 + 8 * fq;
#pragma unroll
        for (int ai = 0; ai < 2; ++ai)
#pragma unroll
            for (int m = 0; m < 4; ++m) { const int row = row0 + ai * HALF + m * 16; const float g = sg[row] * inv; bf16_t* rowp = Y + (size_t)row * 2048 + col0;
#pragma unroll
                for (int bj = 0; bj < 2; ++bj) { const f32x4 v0 = acc[ai][bj][m][0] * g, v1 = acc[ai][bj][m][1] * g;
                    u32x4 w; w.x = cvt_pk_bf16(v0[0], v0[1]); w.y = cvt_pk_bf16(v0[2], v0[3]); w.z = cvt_pk_bf16(v1[0], v1[1]); w.w = cvt_pk_bf16(v1[2], v1[3]);
                    *(u32x4*)(rowp + bj * HALF) = w; } }
    }
};
struct EpiYp {
    static constexpr bool PERM = true;
    bf16_t* YP; const float* sg; float inv;
    __device__ __forceinline__ void operator()(const f32x4 (&acc)[2][2][4][2], const Unit& u, int wr, int wc, int fr_, int fq_) const {
        int z_; asm volatile("v_mov_b32 %0, 0" : "=v"(z_)); const int fr = fr_ + z_, fq = fq_ + z_;
        const int row0 = u.pm * BM + wr * 64 + fr, col0 = (u.pn & 7) * BM + wc * 32 + 8 * fq; bf16_t* base = YP + (size_t)(u.pn >> 6) * (1792 * 2048);
#pragma unroll
        for (int ai = 0; ai < 2; ++ai)
#pragma unroll
            for (int m = 0; m < 4; ++m) { const int row = row0 + ai * HALF + m * 16; const float g = sg[row] * inv; bf16_t* rowp = base + (size_t)(row - 16384) * 2048 + col0;
#pragma unroll
                for (int bj = 0; bj < 2; ++bj) { const f32x4 v0 = acc[ai][bj][m][0] * g, v1 = acc[ai][bj][m][1] * g;
                    u32x4 w; w.x = cvt_pk_bf16(v0[0], v0[1]); w.y = cvt_pk_bf16(v0[2], v0[3]); w.z = cvt_pk_bf16(v1[0], v1[1]); w.w = cvt_pk_bf16(v1[2], v1[3]);
                    *(u32x4*)(rowp + bj * HALF) = w; } }
    }
};
struct EpiW {
    static constexpr bool PERM = true;
    bf16_t* AP; const float* bcum; const float* ig;
    __device__ __forceinline__ void operator()(const f32x4 (&acc)[2][2][4][2], const Unit& u, int wr, int wc, int fr_, int fq_) const {
        int z_; asm volatile("v_mov_b32 %0, 0" : "=v"(z_)); const int fr = fr_ + z_, fq = fq_ + z_;
        const float* bc = bcum + u.pm * 256; const float* ii = ig + u.pm * 256;
#pragma unroll
        for (int bj = 0; bj < 2; ++bj) { const int s0 = bj * HALF + wc * 32 + 8 * fq;
            const f32x4 b0 = *(const f32x4*)(bc + s0), b1 = *(const f32x4*)(bc + s0 + 4), i0 = *(const f32x4*)(ii + s0), i1 = *(const f32x4*)(ii + s0 + 4);
            const f32x4 c0 = i0 - b0, c1 = i1 - b1;
#pragma unroll
            for (int ai = 0; ai < 2; ++ai)
#pragma unroll
                for (int m = 0; m < 4; ++m) { const int t = ai * HALF + wr * 64 + m * 16 + fr; const float bt = bc[t]; bf16_t* rowp = AP + ((size_t)u.pm * 256 + t) * 512 + 256;
                    const f32x4 v0 = acc[ai][bj][m][0], v1 = acc[ai][bj][m][1]; float r[8];
                    const int dts = t - s0;
#pragma unroll
                    for (int j = 0; j < 4; ++j) { const float m0 = (float)min(max(dts - j + 1, 0), 1), m1 = (float)min(max(dts - j - 3, 0), 1);
                        r[j] = v0[j] * __expf(fminf(bt + c0[j], 80.f)) * m0; r[4 + j] = v1[j] * __expf(fminf(bt + c1[j], 80.f)) * m1; }
                    u32x4 w; w.x = cvt_pk_bf16(r[0], r[1]); w.y = cvt_pk_bf16(r[2], r[3]); w.z = cvt_pk_bf16(r[4], r[5]); w.w = cvt_pk_bf16(r[6], r[7]);
                    *(u32x4*)(rowp + s0) = w; asm volatile("" ::: "memory"); } }
    }
};
struct EpiDC {
    static constexpr bool PERM = false;
    float* D;
    __device__ __forceinline__ void operator()(const f32x4 (&acc)[2][2][4][2], const Unit& u, int wr, int wc, int fr_, int fq_) const {
        int z_; asm volatile("v_mov_b32 %0, 0" : "=v"(z_)); const int fr = fr_ + z_, fq = fq_ + z_;
        const int row0 = wr * 64 + fr, col0 = wc * 32 + 4 * fq;
#pragma unroll
        for (int ai = 0; ai < 2; ++ai)
#pragma unroll
            for (int m = 0; m < 4; ++m) { float* rowp = D + ((size_t)u.pm * 256 + row0 + ai * HALF + m * 16) * 256 + col0;
#pragma unroll
                for (int bj = 0; bj < 2; ++bj)
#pragma unroll
                    for (int n = 0; n < 2; ++n) *(f32x4*)(rowp + bj * HALF + n * 16) = acc[ai][bj][m][n]; }
    }
};
struct EpiNum {
    static constexpr bool PERM = false;
    float* HR;
    __device__ __forceinline__ void operator()(const f32x4 (&acc)[2][2][4][2], const Unit& u, int wr, int wc, int fr_, int fq_) const {
        int z_; asm volatile("v_mov_b32 %0, 0" : "=v"(z_)); const int fr = fr_ + z_, fq = fq_ + z_;
        const int b = u.pm >> 6, h = (u.pm >> 4) & 3, c = u.pm & 15;
        const int row0 = b * 4096 + c * 256 + wr * 64 + fr, col0 = h * 256 + wc * 32 + 4 * fq;
#pragma unroll
        for (int ai = 0; ai < 2; ++ai)
#pragma unroll
            for (int m = 0; m < 4; ++m) { float* rowp = HR + (size_t)(row0 + ai * HALF + m * 16) * 1024 + col0;
#pragma unroll
                for (int bj = 0; bj < 2; ++bj)
#pragma unroll
                    for (int n = 0; n < 2; ++n) *(f32x4*)(rowp + bj * HALF + n * 16) = acc[ai][bj][m][n]; }
    }
};
struct EpiFin {
    static constexpr bool PERM = true;
    bf16_t* O; const bf16_t* PROJ; int ldp; const float* headg; PG8_LAS float* sDen; PG8_LAS float* sSS; float eps;
    __device__ __forceinline__ void operator()(const f32x4 (&acc)[2][2][4][2], const Unit& u, int wr, int wc, int fr_, int fq_) const {
        int z_; asm volatile("v_mov_b32 %0, 0" : "=v"(z_)); const int fr = fr_ + z_, fq = fq_ + z_;
        const int b = u.pm >> 6, h = (u.pm >> 4) & 3, c = u.pm & 15;
        const int rl0 = wr * 64 + fr, col0 = wc * 32 + 8 * fq; const __amdgpu_buffer_rsrc_t rs = __builtin_amdgcn_make_buffer_rsrc((void*)O, 0, 8192 * 2048 * 2, 0x00020000);
#pragma unroll
        for (int ai = 0; ai < 2; ++ai)
#pragma unroll
            for (int m = 0; m < 4; ++m) { float p = 0.f;
#pragma unroll
                for (int bj = 0; bj < 2; ++bj)
#pragma unroll
                    for (int n = 0; n < 2; ++n) { const f32x4 v = acc[ai][bj][m][n]; p += v[0] * v[0] + v[1] * v[1] + v[2] * v[2] + v[3] * v[3]; }
                p += __shfl_xor(p, 16); p += __shfl_xor(p, 32);
                if (fq == 0) sSS[wc * 256 + rl0 + ai * HALF + m * 16] = p; }
        asm volatile("s_waitcnt lgkmcnt(0)" ::: "memory"); __builtin_amdgcn_s_barrier();
        f32x4 hv[2][2];
#pragma unroll
        for (int bj = 0; bj < 2; ++bj)
#pragma unroll
            for (int n = 0; n < 2; ++n) hv[bj][n] = *(const f32x4*)(headg + h * 256 + col0 + bj * HALF + 4 * n);
#pragma unroll
        for (int ai = 0; ai < 2; ++ai) {
            const size_t t0 = (size_t)b * 4096 + c * 256 + rl0 + ai * HALF;
            u32x4 ow[4][2];
#pragma unroll
            for (int m = 0; m < 4; ++m)
#pragma unroll
                for (int bj = 0; bj < 2; ++bj) ow[m][bj] = *(const u32x4*)(PROJ + (t0 + m * 16) * ldp + 3072 + h * 256 + col0 + bj * HALF);
#pragma unroll
            for (int m = 0; m < 4; ++m) { const int rl = rl0 + ai * HALF + m * 16;
                const float P = (sSS[rl] + sSS[256 + rl]) + (sSS[512 + rl] + sSS[768 + rl]), idd = sDen[rl];
                const float f = idd * (1.0f / sqrtf(P * idd * idd * (1.0f / 256.0f) + eps));
                bf16_t* rowp = O + (t0 + m * 16) * 2048 + h * 256 + col0;
#pragma unroll
                for (int bj = 0; bj < 2; ++bj) { const f32x4 v0 = acc[ai][bj][m][0] * f * hv[bj][0], v1 = acc[ai][bj][m][1] * f * hv[bj][1]; const u32x4 o = ow[m][bj];
                    const f32x2p s0 = sigm2(o.x), s1 = sigm2(o.y), s2 = sigm2(o.z), s3 = sigm2(o.w);
                    u32x4 w; w.x = cvt_pk_bf16(v0[0] * s0.x, v0[1] * s0.y); w.y = cvt_pk_bf16(v0[2] * s1.x, v0[3] * s1.y); w.z = cvt_pk_bf16(v1[0] * s2.x, v1[1] * s2.y); w.w = cvt_pk_bf16(v1[2] * s3.x, v1[3] * s3.y);
                    __builtin_amdgcn_raw_buffer_store_b128(w, rs, (int)(((size_t)(rowp - O) + bj * HALF) * 2), 0, 16); } } }
    }
};
struct EpiPool {
    static constexpr bool PERM = true;
    bf16_t* O; const float* scale;
    __device__ __forceinline__ void operator()(const f32x4 (&acc)[2][2][4][2], const Unit& u, int wr, int wc, int fr_, int fq_) const {
        int z_; asm volatile("v_mov_b32 %0, 0" : "=v"(z_)); const int fr = fr_ + z_, fq = fq_ + z_;
        const int row0 = u.pm * BM + wr * 64 + fr, col0 = u.pn * 256 + wc * 32 + 8 * fq;
        f32x4 sv[2][2];
#pragma unroll
        for (int bj = 0; bj < 2; ++bj)
#pragma unroll
            for (int n = 0; n < 2; ++n) sv[bj][n] = *(const f32x4*)(scale + col0 + bj * HALF + 4 * n);
#pragma unroll
        for (int ai = 0; ai < 2; ++ai)
#pragma unroll
            for (int m = 0; m < 4; ++m) { bf16_t* rowp = O + (size_t)(row0 + ai * HALF + m * 16) * 2048 + 1024 + col0;
#pragma unroll
                for (int bj = 0; bj < 2; ++bj) { const f32x4 v0 = acc[ai][bj][m][0] * sv[bj][0], v1 = acc[ai][bj][m][1] * sv[bj][1];
                    u32x4 w; w.x = cvt_pk_bf16(v0[0], v0[1]); w.y = cvt_pk_bf16(v0[2], v0[3]); w.z = cvt_pk_bf16(v1[0], v1[1]); w.w = cvt_pk_bf16(v1[2], v1[3]);
                    *(u32x4*)(rowp + bj * HALF) = w; } }
    }
};

typedef int v8i_t __attribute__((ext_vector_type(8)));
typedef int v4i_t __attribute__((ext_vector_type(4)));
__device__ __forceinline__ v8i_t cat8(bf16x8 lo, bf16x8 hi) { return __builtin_shufflevector(__builtin_bit_cast(v4i_t, lo), __builtin_bit_cast(v4i_t, hi), 0, 1, 2, 3, 4, 5, 6, 7); }
template <class Epi, class Sched, bool ALIGN_EPI = false, bool SP2 = false, bool F8 = false>
__device__ __forceinline__ void gemm_phase(PG8_LAS unsigned char* lds, const Dims g, const Sched& S, const Epi& E) {
    int tid_ = threadIdx.x; asm volatile("" : "+v"(tid_));
    const int tid = tid_, wid = __builtin_amdgcn_readfirstlane(tid >> 6), lane = tid & 63, wr = wid >> 2, wc = wid & 3, fr = lane & 15, fq = lane >> 4;
    const int K = g.K, nt = K / BK;
    unsigned voffA[2], voffB[2];
#pragma unroll
    for (int i = 0; i < 2; ++i) { int R, C; stage_rc(tid * 16 + i * 8192, R, C); const int Rb = Epi::PERM ? ((R & ~31) + perm32(R & 31)) : R;
        voffA[i] = (unsigned)(R * g.lda + C) * 2u; voffB[i] = (unsigned)(Rb * g.ldb + C) * 2u; }
    const size_t kstep = (size_t)(BK * 2);
    const size_t hstepA = (size_t)HALF * g.lda * 2, hstepB = (size_t)HALF * g.ldb * 2;
    const unsigned ldsw = (unsigned)wid * 1024u;
    const int aoff = lds_byte(wr * 64 + fr, fq * 8), boff = lds_byte(wc * 32 + fr, fq * 8);
#define PG8_SA(b, h) (((b) * 2 + (h)) * HTB)
#define PG8_SB(b, h) ((4 + (b) * 2 + (h)) * HTB)
#define PG8_STAGE(bufoff, gbase, voff) do { _Pragma("unroll") for (int _i = 0; _i < 2; ++_i) \
        __builtin_amdgcn_global_load_lds((const unsigned*)((const char*)(gbase) + (voff)[_i]), (PG8_LAS unsigned*)(lds + (bufoff) + ldsw + _i * 8192), 16, 0, 0); } while (0)
#define PG8_LDA(dst, b, h) do { if constexpr (F8) { _Pragma("unroll") for (int m = 0; m < 4; ++m) { const v4i_t lo_ = *(const PG8_LAS v4i_t*)(lds + PG8_SA(b, h) + aoff + m * 2048), hi_ = *(const PG8_LAS v4i_t*)(lds + PG8_SA(b, h) + aoff + m * 2048 + 1024); dst##8[m] = __builtin_shufflevector(lo_, hi_, 0, 1, 2, 3, 4, 5, 6, 7); } } else { \
        _Pragma("unroll") for (int m = 0; m < 4; ++m) _Pragma("unroll") for (int k = 0; k < 2; ++k) dst[m][k] = *(const PG8_LAS bf16x8*)(lds + PG8_SA(b, h) + aoff + m * 2048 + k * 1024); } } while (0)
#define PG8_LDB(dst, b, h) do { if constexpr (F8) { _Pragma("unroll") for (int n = 0; n < 2; ++n) { const v4i_t lo_ = *(const PG8_LAS v4i_t*)(lds + PG8_SB(b, h) + boff + n * 2048), hi_ = *(const PG8_LAS v4i_t*)(lds + PG8_SB(b, h) + boff + n * 2048 + 1024); dst##8[n] = __builtin_shufflevector(lo_, hi_, 0, 1, 2, 3, 4, 5, 6, 7); } } else { \
        _Pragma("unroll") for (int n = 0; n < 2; ++n) _Pragma("unroll") for (int k = 0; k < 2; ++k) dst[n][k] = *(const PG8_LAS bf16x8*)(lds + PG8_SB(b, h) + boff + n * 2048 + k * 1024); } } while (0)
#define PG8_MMA(ai, bj, At, Bt) do { __builtin_amdgcn_s_setprio(1); if constexpr (F8) { _Pragma("unroll") for (int m = 0; m < 4; ++m) _Pragma("unroll") for (int n = 0; n < 2; ++n) \
        asm volatile("v_mfma_scale_f32_16x16x128_f8f6f4 %0, %1, %2, %0, %3, %3 op_sel_hi:[0,0,0]" : "+v"(acc[ai][bj][m][n]) : "v"(Bt##8[n]), "v"(At##8[m]), "v"(sc8)); } else { \
        _Pragma("unroll") for (int m = 0; m < 4; ++m) _Pragma("unroll") for (int n = 0; n < 2; ++n) _Pragma("unroll") for (int k = 0; k < 2; ++k) \
        acc[ai][bj][m][n] = __builtin_amdgcn_mfma_f32_16x16x32_bf16(Bt[n][k], At[m][k], acc[ai][bj][m][n], 0, 0, 0); } __builtin_amdgcn_s_setprio(0); } while (0)
#define PG8_WAIT_V(n) asm volatile("s_waitcnt vmcnt(" #n ")" ::: "memory")
#define PG8_WAIT_L(n) asm volatile("s_waitcnt lgkmcnt(" #n ")" ::: "memory")
#define PG8_BAR __builtin_amdgcn_s_barrier()
#define PG8_SCHED __builtin_amdgcn_sched_barrier(0)
    Unit cur, nxt; int ui = 0;
    if (!S.next(0, cur)) return;
    f32x4 acc[2][2][4][2];
#pragma unroll
    for (int a = 0; a < 2; ++a)
#pragma unroll
        for (int b = 0; b < 2; ++b)
#pragma unroll
            for (int m = 0; m < 4; ++m)
#pragma unroll
                for (int n = 0; n < 2; ++n) acc[a][b][m][n] = (f32x4){0.f, 0.f, 0.f, 0.f};
    int sc8 = 0x7f7f7f7f; asm volatile("" : "+v"(sc8));
    bf16x8 At[4][2], B0[2][2], B1[2][2]; v8i_t At8[4], B08[2], B18[2]; (void)At; (void)B0; (void)B1; (void)At8; (void)B08; (void)B18;
    const char* cA = cur.a; const char* cB = cur.b;
    S.a_ready(cur);
    if constexpr (SP2) {
        PG8_STAGE(PG8_SB(0, 0), cB, voffB); PG8_STAGE(PG8_SB(0, 1), cB + hstepB, voffB); PG8_STAGE(PG8_SA(0, 0), cA, voffA); PG8_STAGE(PG8_SA(0, 1), cA + hstepA, voffA);
        if (wr == 1) PG8_BAR;
        PG8_WAIT_V(2); PG8_BAR;
        PG8_STAGE(PG8_SB(1, 0), cB + kstep, voffB); PG8_STAGE(PG8_SA(1, 0), cA + kstep, voffA); PG8_STAGE(PG8_SB(1, 1), cB + hstepB + kstep, voffB);
        PG8_WAIT_V(6); PG8_BAR;
    } else {
        PG8_STAGE(PG8_SB(0, 0), cB, voffB); PG8_STAGE(PG8_SA(0, 0), cA, voffA); PG8_STAGE(PG8_SB(0, 1), cB + hstepB, voffB); PG8_STAGE(PG8_SA(0, 1), cA + hstepA, voffA);
        if (wr == 1) PG8_BAR;
        PG8_WAIT_V(4); PG8_BAR;
        PG8_STAGE(PG8_SB(1, 0), cB + kstep, voffB); PG8_STAGE(PG8_SA(1, 0), cA + kstep, voffA); PG8_STAGE(PG8_SB(1, 1), cB + hstepB + kstep, voffB);
        PG8_WAIT_V(6); PG8_BAR;
    }
    for (;;) {
        const bool has_next = S.next(ui + 1, nxt);
        const char* nA = has_next ? nxt.a : cA; const char* nB = has_next ? nxt.b : cB;
#pragma nounroll
        for (int t = 0; t < nt; t += 2) {
            const bool last = (t == nt - 2);
            const char* a1 = cA + (size_t)(t + 1) * kstep;
            const char* a2 = last ? nA : cA + (size_t)(t + 2) * kstep; const char* b2 = last ? nB : cB + (size_t)(t + 2) * kstep;
            const char* a3 = a2 + kstep; const char* b3 = b2 + kstep;
            if (last && has_next) S.a_ready(nxt);
            if constexpr (SP2) {
            PG8_LDB(B0, 0, 0); PG8_LDB(B1, 0, 1); PG8_SCHED; PG8_LDA(At, 0, 0); PG8_STAGE(PG8_SA(1, 1), a1 + hstepA, voffA);
            PG8_WAIT_V(8); PG8_WAIT_L(0); PG8_BAR; PG8_MMA(0, 0, At, B0); PG8_MMA(0, 1, At, B1); PG8_BAR; PG8_SCHED;
            PG8_LDA(At, 0, 1); PG8_STAGE(PG8_SB(0, 0), b2, voffB); PG8_STAGE(PG8_SB(0, 1), b2 + hstepB, voffB); PG8_STAGE(PG8_SA(0, 0), a2, voffA);
            PG8_WAIT_V(8); PG8_WAIT_L(0); PG8_BAR; PG8_MMA(1, 0, At, B0); PG8_MMA(1, 1, At, B1); PG8_BAR; PG8_SCHED;
            PG8_LDB(B0, 1, 0); PG8_LDB(B1, 1, 1); PG8_SCHED; PG8_LDA(At, 1, 0); PG8_STAGE(PG8_SA(0, 1), a2 + hstepA, voffA);
            PG8_WAIT_V(8); PG8_WAIT_L(0); PG8_BAR; PG8_MMA(0, 0, At, B0); PG8_MMA(0, 1, At, B1); PG8_BAR; PG8_SCHED;
            PG8_LDA(At, 1, 1); PG8_STAGE(PG8_SB(1, 0), b3, voffB); PG8_STAGE(PG8_SB(1, 1), b3 + hstepB, voffB); PG8_STAGE(PG8_SA(1, 0), a3, voffA);
            PG8_WAIT_V(8); PG8_WAIT_L(0); PG8_BAR; PG8_MMA(1, 0, At, B0); PG8_MMA(1, 1, At, B1); PG8_BAR; PG8_SCHED;
            } else {
            PG8_LDB(B0, 0, 0); PG8_SCHED; PG8_LDA(At, 0, 0); PG8_STAGE(PG8_SA(1, 1), a1 + hstepA, voffA);
            PG8_WAIT_L(8); PG8_BAR; PG8_WAIT_L(0); PG8_MMA(0, 0, At, B0); PG8_BAR; PG8_SCHED;
            PG8_LDB(B1, 0, 1); PG8_STAGE(PG8_SB(0, 0), b2, voffB);
            PG8_BAR; PG8_WAIT_L(0); PG8_MMA(0, 1, At, B1); PG8_BAR;
            PG8_LDA(At, 0, 1); PG8_STAGE(PG8_SA(0, 0), a2, voffA);
            PG8_BAR; PG8_WAIT_L(0); PG8_MMA(1, 0, At, B0); PG8_BAR; PG8_SCHED;
            PG8_STAGE(PG8_SB(0, 1), b2 + hstepB, voffB);
            PG8_WAIT_V(6); PG8_BAR; PG8_MMA(1, 1, At, B1); PG8_BAR;
            PG8_LDB(B0, 1, 0); PG8_SCHED; PG8_LDA(At, 1, 0); PG8_STAGE(PG8_SA(0, 1), a2 + hstepA, voffA);
            PG8_WAIT_L(8); PG8_BAR; PG8_WAIT_L(0); PG8_MMA(0, 0, At, B0); PG8_BAR; PG8_SCHED;
            PG8_LDB(B1, 1, 1); PG8_STAGE(PG8_SB(1, 0), b3, voffB);
            PG8_BAR; PG8_WAIT_L(0); PG8_MMA(0, 1, At, B1); PG8_BAR;
            PG8_LDA(At, 1, 1); PG8_STAGE(PG8_SA(1, 0), a3, voffA);
            PG8_BAR; PG8_WAIT_L(0); PG8_MMA(1, 0, At, B0); PG8_BAR; PG8_SCHED;
            PG8_STAGE(PG8_SB(1, 1), b3 + hstepB, voffB);
            PG8_WAIT_V(6); PG8_BAR; PG8_MMA(1, 1, At, B1); PG8_BAR;
            }
        }
        if constexpr (F8) {
#pragma unroll
            for (int a = 0; a < 2; ++a)
#pragma unroll
                for (int b = 0; b < 2; ++b)
                    asm volatile("s_nop 15\n\ts_nop 15" : "+v"(acc[a][b][0][0]), "+v"(acc[a][b][0][1]), "+v"(acc[a][b][1][0]), "+v"(acc[a][b][1][1]), "+v"(acc[a][b][2][0]), "+v"(acc[a][b][2][1]), "+v"(acc[a][b][3][0]), "+v"(acc[a][b][3][1]));
        }
        if constexpr (ALIGN_EPI) { if (wr == 0) PG8_BAR; }
        E(acc, cur, wr, wc, fr, fq); S.done(cur);
        if (!has_next) break;
#pragma unroll
        for (int a = 0; a < 2; ++a)
#pragma unroll
            for (int b = 0; b < 2; ++b)
#pragma unroll
                for (int m = 0; m < 4; ++m)
#pragma unroll
                    for (int n = 0; n < 2; ++n) acc[a][b][m][n] = (f32x4){0.f, 0.f, 0.f, 0.f};
        cur = nxt; cA = nA; cB = nB; ++ui;
        if constexpr (ALIGN_EPI) { if (wr == 1) PG8_BAR; }
    }
    PG8_WAIT_V(0);
    if constexpr (!ALIGN_EPI) { if (wr == 0) PG8_BAR; }
    PG8_BAR;
#undef PG8_SA
#undef PG8_SB
#undef PG8_STAGE
#undef PG8_LDA
#undef PG8_LDB
#undef PG8_MMA
#undef PG8_WAIT_V
#undef PG8_WAIT_L
#undef PG8_BAR
#undef PG8_SCHED
}
}

constexpr int NWAVES = 8;
constexpr int DM = 2048, NTOK = 8192, SEQ = 4096;
constexpr int DINS = 5128, DINP = 5120;
constexpr int DFF = 5632, NE = 8, DFE = 7168;
constexpr int NUNIT = 128;
constexpr int MAXSLOT = 18432;
constexpr float EPS = 1e-6f;

constexpr size_t MiB = 1u << 20;
constexpr size_t WS_CTL = 0, CTL_ZERO_BYTES = 1 * MiB;
constexpr size_t WS_MOD = 1 * MiB;
constexpr size_t WS_GWT = WS_MOD + 256 * 1024;
constexpr size_t WS_RWT = WS_GWT + 64 * 1024;
constexpr size_t WS_GATES = WS_RWT + 64 * 1024;
constexpr size_t WS_BCUM = WS_GATES + 256 * 1024;
constexpr size_t WS_IG = WS_BCUM + 128 * 1024;
constexpr size_t WS_GTOT = WS_IG + 128 * 1024;
constexpr size_t WS_DN = WS_GTOT + 4 * 1024;
constexpr size_t WS_NVEC = WS_DN + 128 * 1024;
constexpr size_t WS_TOKINFO = WS_NVEC + 128 * 1024;
constexpr size_t WS_TOKSLOT = WS_TOKINFO + 256 * 1024;
constexpr size_t WS_SLOTGATE = WS_TOKSLOT + 64 * 1024;
static_assert(WS_SLOTGATE + 128 * 1024 <= 4 * MiB, "small arrays");
constexpr size_t WS_WIN = 4 * MiB, WS_WOUT = 24 * MiB, WS_W13 = 32 * MiB, WS_W2 = 76 * MiB, WS_WQKV = 98 * MiB, WS_WO = 122 * MiB, WS_POOLW = 130 * MiB;
constexpr size_t WS_W13E = 132 * MiB, WS_W2E = 580 * MiB;
constexpr size_t WS_XR = 804 * MiB, WS_HN = 868 * MiB;
constexpr size_t WS_L = 900 * MiB;
constexpr size_t WS_PROJ = WS_L, WS_QB = WS_L + 80 * MiB, WS_KB = WS_L + 96 * MiB, WS_KWT = WS_L + 112 * MiB, WS_AP = WS_L + 128 * MiB, WS_BP = WS_L + 160 * MiB,
                 WS_DCT = WS_L + 192 * MiB, WS_HR = WS_L + 224 * MiB, WS_POOLED = WS_L + 256 * MiB, WS_MIXCAT = WS_L + 272 * MiB, WS_U = WS_L + 304 * MiB;
constexpr size_t WS_QB2 = WS_L, WS_KB2 = WS_L + 32 * MiB, WS_VT = WS_L + 64 * MiB, WS_ATTO = WS_L + 96 * MiB, WS_HPERM = WS_L + 128 * MiB, WS_UE = WS_L + 200 * MiB, WS_Y = WS_L + 452 * MiB;
constexpr size_t WS_YP = WS_L + 528 * MiB;
constexpr size_t WS_END = WS_L + 596 * MiB;

constexpr int CW_TMO = 0, CW_CODE = 1;
constexpr int CW_BAR = 4096;
constexpr int CW_PAN8 = 12288, CW_PAN11 = 16384, CW_PAN15 = 20480, CW_PAN6 = 24576;
constexpr int CW_P0PUB = 10752;
constexpr int CW_QCVT = 10496;
constexpr int CW_RDONE = 10240;
constexpr int CW_CNT = 8192;

constexpr int RING_OFF = 0, RING_BYTES = 131072;
constexpr int LDS_BYTES = 147456;
constexpr int LDSCTL_OFF = LDS_BYTES - 512, MISC_OFF = LDSCTL_OFF;

#define GAS __attribute__((address_space(1)))
#define LAS __attribute__((address_space(3)))
typedef unsigned short bf16;
typedef unsigned v4u __attribute__((ext_vector_type(4)));
typedef unsigned v2u __attribute__((ext_vector_type(2)));
typedef float f32x4 __attribute__((ext_vector_type(4)));
typedef GAS unsigned gu32;
#define RLX_AGENT __ATOMIC_RELAXED, __HIP_MEMORY_SCOPE_AGENT
#define LDS_WAIT() asm volatile("s_waitcnt lgkmcnt(0)" ::: "memory")
#define VM_WAIT() asm volatile("s_waitcnt vmcnt(0)" ::: "memory")
__device__ __forceinline__ unsigned pk2(float lo, float hi) { return pg8::cvt_pk_bf16(lo, hi); }
__device__ __forceinline__ float bflo(unsigned w) { return __uint_as_float(w << 16); }
__device__ __forceinline__ float bfhi(unsigned w) { return __uint_as_float(w & 0xffff0000u); }
__device__ __forceinline__ float logsig(float x) { return fminf(x, 0.f) - log1pf(expf(-fabsf(x))); }
__device__ __forceinline__ float dot4(f32x4 a, f32x4 b) { return (a.x * b.x + a.y * b.y) + (a.z * b.z + a.w * b.w); }

#define XB_TMO      128
#define XB_XCNT(j)  (256  + 64 * (j))
#define XB_XSUB(j)  (1280 + 64 * (j))
#define XB_XGEN(j)  (2304 + 64 * (j))
#define XB_TOP      3328
#define XB_TOPGEN   3392
#define XCD_BAR_WORDS 3456
#define XB_SPIN_CAP (1u << 20)

__device__ __forceinline__ unsigned xb_ld(unsigned* p)              { return __hip_atomic_load(p, __ATOMIC_RELAXED, __HIP_MEMORY_SCOPE_AGENT); }
__device__ __forceinline__ unsigned xb_add(unsigned* p, unsigned v) { return __hip_atomic_fetch_add(p, v, __ATOMIC_RELAXED, __HIP_MEMORY_SCOPE_AGENT); }
__device__ __forceinline__ unsigned xb_xcc_id() { return (unsigned)__builtin_amdgcn_s_getreg((3 << 11) | 20) & 0xFu; }
#define XB_SPIN(cond, bar) do { unsigned _sp = 0; while (cond) { __builtin_amdgcn_s_sleep(1); \
    if ((++_sp & 255u) == 0u) { if (xb_ld(&(bar)[XB_TMO])) break; if (_sp > XB_SPIN_CAP) { atomicAdd(&(bar)[XB_TMO], 1u); break; } } } } while (0)

struct XcdBarrier { unsigned* bar; unsigned x; volatile LAS unsigned* st; };

__device__ __forceinline__ XcdBarrier xcd_barrier_post(unsigned* bar, volatile LAS unsigned* st) {
    XcdBarrier b; b.bar = bar; b.x = xb_xcc_id(); b.st = st;
    if (threadIdx.x == 0) (void)xb_add(&bar[XB_XCNT(b.x)], 1u);
    return b;
}
__device__ __forceinline__ void xcd_barrier_complete(unsigned* bar, unsigned x, unsigned& nloc, unsigned& nx) {
    const unsigned G = gridDim.x * gridDim.y * gridDim.z;
    unsigned sum, cnt, mine, sp = 0u;
    for (;;) {
        sum = 0u; cnt = 0u; mine = 0u;
#pragma unroll
        for (unsigned j = 0; j < 16; ++j) { const unsigned c = xb_ld(&bar[XB_XCNT(j)]); sum += c; cnt += (c > 0u) ? 1u : 0u; mine = (j == x) ? c : mine; }
        if (sum == G) break;
        __builtin_amdgcn_s_sleep(1);
        if ((++sp & 255u) == 0u) { if (xb_ld(&bar[XB_TMO])) break; if (sp > XB_SPIN_CAP) { atomicAdd(&bar[XB_TMO], 1u); break; } }
    }
    nloc = mine > 0u ? mine : 1u; nx = cnt > 0u ? cnt : 1u;
}
__device__ __forceinline__ void xcd_barrier(const XcdBarrier& b) {
    asm volatile("s_waitcnt vmcnt(0)" ::: "memory");
    __syncthreads();
    int tid0 = threadIdx.x; asm volatile("" : "+v"(tid0));
    if (tid0 == 0) {
        unsigned* bar = b.bar;
        __builtin_amdgcn_s_waitcnt(0);
        unsigned nloc = b.st[0], nx = b.st[1];
        if (nloc == 0u) { xcd_barrier_complete(bar, b.x, nloc, nx); b.st[0] = nloc; b.st[1] = nx; }
        const unsigned old = xb_add(&bar[XB_XSUB(b.x)], 1u);
        const unsigned gen = old / nloc;
        if (old + 1u == (gen + 1u) * nloc) {
            __builtin_amdgcn_fence(__ATOMIC_RELEASE, "agent");
            asm volatile("s_waitcnt vmcnt(0)" ::: "memory");
            const unsigned og = xb_add(&bar[XB_TOP], 1u);
            const unsigned tg = og / nx;
            if (og + 1u == (tg + 1u) * nx) xb_add(&bar[XB_TOPGEN], 1u);
            else XB_SPIN(xb_ld(&bar[XB_TOPGEN]) == tg, bar);
            __builtin_amdgcn_fence(__ATOMIC_ACQUIRE, "agent");
            xb_add(&bar[XB_XGEN(b.x)], 1u);
            asm volatile("s_waitcnt vmcnt(0)" ::: "memory");
        } else {
            XB_SPIN(xb_ld(&bar[XB_XGEN(b.x)]) == gen, bar);
            __builtin_amdgcn_fence(__ATOMIC_ACQUIRE, "agent");
            asm volatile("s_waitcnt vmcnt(0)" ::: "memory");
        }
    }
    __syncthreads();
}

struct Args { const float* in[24]; float* out; unsigned char* ws; };
struct Frame {
    LAS unsigned char* lds; volatile LAS unsigned* MISC; gu32* ctl;
    int G, bid;
    unsigned char* ws;
};
__device__ __forceinline__ float wave_sum(float v) {
#pragma unroll
    for (int o = 1; o < 64; o <<= 1) v += __shfl_xor(v, o);
    return v;
}

__device__ __forceinline__ void transpose_item(const float* src, int spitch, int k0, int n0s, bf16* dst, int dpitch, int n0d, LAS unsigned* T, int lane) {
    const int kr = lane & 3, nq = lane >> 2;
#pragma unroll
    for (int i = 0; i < 8; ++i) {
        const int k = k0 + 8 * i + 2 * kr;
        const f32x4 a = *(const f32x4*)(src + (size_t)k * spitch + n0s + 4 * nq);
        const f32x4 b = *(const f32x4*)(src + (size_t)(k + 1) * spitch + n0s + 4 * nq);
#pragma unroll
        for (int j = 0; j < 4; ++j) T[(4 * nq + j) * 33 + 4 * i + kr] = pk2(a[j], b[j]);
    }
    LDS_WAIT();
#pragma unroll
    for (int it = 0; it < 8; ++it) {
        const int n = (lane >> 3) + 8 * it, c = lane & 7;
        v4u o; o.x = T[n * 33 + 4 * c]; o.y = T[n * 33 + 4 * c + 1]; o.z = T[n * 33 + 4 * c + 2]; o.w = T[n * 33 + 4 * c + 3];
        *(v4u*)(dst + (size_t)(n0d + n) * dpitch + k0 + 8 * c) = o;
    }
    LDS_WAIT();
}
__device__ __forceinline__ void transpose_item8(const float* src, int spitch, int k0, int n0s, unsigned char* dst, int dpitch, int n0d, float scale, LAS unsigned* T, int lane) {
    const int kr = lane & 3, nq = lane >> 2;
    f32x4 a[8][4];
#pragma unroll
    for (int i = 0; i < 8; ++i) { const float* p = src + (size_t)(k0 + 16 * i + 4 * kr) * spitch + n0s + 4 * nq;
#pragma unroll
        for (int q = 0; q < 4; ++q) a[i][q] = *(const f32x4*)(p + (size_t)q * spitch); }
#pragma unroll
    for (int i = 0; i < 8; ++i)
#pragma unroll
        for (int j = 0; j < 4; ++j) T[(4 * nq + j) * 33 + 4 * i + kr] = pg8::pk4_fp8(a[i][0][j] * scale, a[i][1][j] * scale, a[i][2][j] * scale, a[i][3][j] * scale);
    LDS_WAIT();
#pragma unroll
    for (int it = 0; it < 8; ++it) {
        const int n = (lane >> 3) + 8 * it, c = lane & 7;
        v4u o; o.x = T[n * 33 + 4 * c]; o.y = T[n * 33 + 4 * c + 1]; o.z = T[n * 33 + 4 * c + 2]; o.w = T[n * 33 + 4 * c + 3];
        *(v4u*)(dst + (size_t)(n0d + n) * dpitch + k0 + 16 * c) = o;
    }
    LDS_WAIT();
}
constexpr float WS8 = 64.0f;
constexpr int I_W13E = 8 * 16 * 224, I_W2E = 8 * 56 * 32, I_WIN = 32 * 80, I_WOUT = 32 * 32, I_W13 = 32 * 176, I_W2 = 88 * 32, I_WQKV = 32 * 96, I_WO = 32 * 32, I_POOL = 4 * 16;
constexpr int N_ITEMS = I_W13E + I_W2E + I_WIN + I_WOUT + I_W13 + I_W2 + I_WQKV + I_WO + I_POOL;
constexpr int NT_W13E = 8 * 8 * 56, NT_W2E = 8 * 28 * 8, NT_WIN = 16 * 20, NT_WOUT = 16 * 8, NT_W13 = 0, NT_W2 = 0  , NT_WQKV = 16 * 24, NT_WO = 16 * 8, NT_POOL = 8;
constexpr int NT_W13F = 8 * 44, NT_W2F = 22 * 8;
constexpr int NT_ALL = NT_W13E + NT_W2E + NT_W13F + NT_W2F + NT_WIN + NT_WOUT + NT_W13 + NT_W2 + NT_WQKV + NT_WO + NT_POOL;
constexpr int TAILQ2 = 7, TAILQ10 = 5, TAILQ6 = 1, TAILQ4 = 1;
constexpr int P0_TILE0 = 128 * (TAILQ2 + TAILQ10 + TAILQ6 + TAILQ4);
constexpr int QCVT_N = 1024, QCVT_LO = NT_W13E + NT_W2E - QCVT_N;

template <bool DYN = false>
__device__ __forceinline__ void convert_tiles(Frame& F, const Args& args, int first, int last, int stride, gu32* q = nullptr) {
    int tid = threadIdx.x; asm volatile("" : "+v"(tid)); const int lane = tid & 63, wave = __builtin_amdgcn_readfirstlane(tid >> 6);
    unsigned char* ws = F.ws;
    {
        const int nl = 4 * lane;
        struct Tile { const float* s; int spitch; unsigned char* d; size_t dpitch; bool f8; };
        auto decode = [&](int it) -> Tile {
            Tile t; int r = it; if (!DYN && r >= QCVT_LO) r += QCVT_N;
            if (r < NT_W13E) { const int e = r / (8 * 56), rr = r % (8 * 56), kb = rr / 56, nb = rr % 56; t.f8 = true; t.spitch = DFE;
                t.s = (nl < 128 ? args.in[21] + nb * 128 + nl : args.in[22] + nb * 128 + nl - 128) + (size_t)e * 2048 * DFE + (size_t)(kb * 256 + wave * 32) * DFE;
                t.d = ws + WS_W13E + ((size_t)e * 14336 + nb * 256) * 2048 + kb * 256; t.dpitch = 2048; }
            else if ((r -= NT_W13E) < NT_W2E) { const int e = r / (28 * 8), rr = r % (28 * 8), kb = rr / 8, nb = rr % 8; t.f8 = true; t.spitch = 2048;
                t.s = args.in[23] + (size_t)e * DFE * 2048 + (size_t)(kb * 256 + wave * 32) * 2048 + nb * 256 + nl;
                t.d = ws + WS_W2E + ((size_t)e * 2048 + nb * 256) * DFE + kb * 256; t.dpitch = DFE; }
            else if ((r -= NT_W2E) < NT_W13F) { const int kb = r / 44, nb = r % 44; t.f8 = true; t.spitch = DFF;
                t.s = (nl < 128 ? args.in[15] + nb * 128 + nl : args.in[16] + nb * 128 + nl - 128) + (size_t)(kb * 256 + wave * 32) * DFF;
                t.d = ws + WS_W13 + ((size_t)nb * 256) * 2048 + kb * 256; t.dpitch = 2048; }
            else if ((r -= NT_W13F) < NT_W2F) { const int kb = r / 8, nb = r % 8; t.f8 = true; t.spitch = 2048;
                t.s = args.in[17] + (size_t)(kb * 256 + wave * 32) * 2048 + nb * 256 + nl;
                t.d = ws + WS_W2 + ((size_t)nb * 256) * DFF + kb * 256; t.dpitch = DFF; }
            else { t.f8 = false; r -= NT_W2F; int kb, nb, K; const float* base; unsigned char* db; int scol;
                if (r < NT_WIN) { kb = r / 20; nb = r % 20; K = 2048; t.spitch = DINS; base = args.in[7]; db = ws + WS_WIN; scol = nb * 256 + nl + (nb >= 16 ? 8 : 0); }
                else if ((r -= NT_WIN) < NT_WOUT) { kb = r / 8; nb = r % 8; K = 2048; t.spitch = 2048; base = args.in[14]; db = ws + WS_WOUT; scol = nb * 256 + nl; }
                else if ((r -= NT_WOUT) < NT_W13) { kb = r / 44; nb = r % 44; K = 2048; t.spitch = DFF; base = (nl < 128 ? args.in[15] : args.in[16] - 128); db = ws + WS_W13; scol = nb * 128 + nl; }
                else if ((r -= NT_W13) < NT_W2) { kb = r / 8; nb = r % 8; K = DFF; t.spitch = 2048; base = args.in[17]; db = ws + WS_W2; scol = nb * 256 + nl; }
                else if ((r -= NT_W2) < NT_WQKV) { kb = r / 24; nb = r % 24; K = 2048; t.spitch = 6144; base = args.in[18]; db = ws + WS_WQKV; scol = nb * 256 + nl; }
                else if ((r -= NT_WQKV) < NT_WO) { kb = r / 8; nb = r % 8; K = 2048; t.spitch = 2048; base = args.in[19]; db = ws + WS_WO; scol = nb * 256 + nl; }
                else { r -= NT_WO; kb = r & 1; nb = 0; K = 256; t.spitch = 256; base = args.in[12] + (size_t)(r >> 1) * 65536; db = ws + WS_POOLW + (size_t)(r >> 1) * 131072; scol = nl; }
                t.s = base + (size_t)(kb * 128 + wave * 16) * t.spitch + scol; t.d = db + ((size_t)nb * 256 * K + kb * 128) * 2; t.dpitch = (size_t)K * 2; }
            return t; };
        int buf = 0;
        f32x4 a[32];
        LAS int* slot = (LAS int*)(F.lds + RING_OFF + RING_BYTES + 8192);
        int it = first, nxt = 0, kq = 0;
        if (DYN) { if (tid == 0) { slot[0] = first + (int)__hip_atomic_fetch_add(q, 1u, __ATOMIC_RELAXED, __HIP_MEMORY_SCOPE_AGENT); slot[1] = first + (int)__hip_atomic_fetch_add(q, 1u, __ATOMIC_RELAXED, __HIP_MEMORY_SCOPE_AGENT); }
            __syncthreads(); it = __builtin_amdgcn_readfirstlane(slot[0]); nxt = __builtin_amdgcn_readfirstlane(slot[1]); __syncthreads(); }
        Tile cur = decode(it < last ? it : 0);
        if (it < last) {
#pragma unroll
            for (int kk = 0; kk < 32; ++kk) if (kk < 16 || cur.f8) a[kk] = __builtin_nontemporal_load((const f32x4*)(cur.s + (size_t)kk * cur.spitch));
        }
        for (; it < last; ) {
            LAS unsigned char* T = F.lds + buf * 65536;
            int tk = 0; if (DYN && tid == 0) tk = first + (int)__hip_atomic_fetch_add(q, 1u, __ATOMIC_RELAXED, __HIP_MEMORY_SCOPE_AGENT);
            const int c0 = 2 * wave, sw = lane & 15;
            if (cur.f8) {
#pragma unroll
                for (int j = 0; j < 4; ++j) { v4u o0, o1;
                    o0.x = pg8::pk4_fp8(a[0][j] * WS8, a[1][j] * WS8, a[2][j] * WS8, a[3][j] * WS8);     o0.y = pg8::pk4_fp8(a[4][j] * WS8, a[5][j] * WS8, a[6][j] * WS8, a[7][j] * WS8);
                    o0.z = pg8::pk4_fp8(a[8][j] * WS8, a[9][j] * WS8, a[10][j] * WS8, a[11][j] * WS8);   o0.w = pg8::pk4_fp8(a[12][j] * WS8, a[13][j] * WS8, a[14][j] * WS8, a[15][j] * WS8);
                    o1.x = pg8::pk4_fp8(a[16][j] * WS8, a[17][j] * WS8, a[18][j] * WS8, a[19][j] * WS8); o1.y = pg8::pk4_fp8(a[20][j] * WS8, a[21][j] * WS8, a[22][j] * WS8, a[23][j] * WS8);
                    o1.z = pg8::pk4_fp8(a[24][j] * WS8, a[25][j] * WS8, a[26][j] * WS8, a[27][j] * WS8); o1.w = pg8::pk4_fp8(a[28][j] * WS8, a[29][j] * WS8, a[30][j] * WS8, a[31][j] * WS8);
                    *(LAS v4u*)(T + (nl + j) * 256 + ((c0 ^ sw) << 4)) = o0; *(LAS v4u*)(T + (nl + j) * 256 + (((c0 + 1) ^ sw) << 4)) = o1; }
            } else {
#pragma unroll
                for (int j = 0; j < 4; ++j) { v4u o0, o1;
                    o0.x = pk2(a[0][j], a[1][j]); o0.y = pk2(a[2][j], a[3][j]); o0.z = pk2(a[4][j], a[5][j]); o0.w = pk2(a[6][j], a[7][j]);
                    o1.x = pk2(a[8][j], a[9][j]); o1.y = pk2(a[10][j], a[11][j]); o1.z = pk2(a[12][j], a[13][j]); o1.w = pk2(a[14][j], a[15][j]);
                    *(LAS v4u*)(T + (nl + j) * 256 + ((c0 ^ sw) << 4)) = o0; *(LAS v4u*)(T + (nl + j) * 256 + (((c0 + 1) ^ sw) << 4)) = o1; }
            }
            const Tile done = cur; const int nx = DYN ? nxt : it + stride;
            if (nx < last) { cur = decode(nx);
#pragma unroll
                for (int kk = 0; kk < 32; ++kk) if (kk < 16 || cur.f8) a[kk] = __builtin_nontemporal_load((const f32x4*)(cur.s + (size_t)kk * cur.spitch)); }
            if (DYN && tid == 0) slot[kq & 1] = tk;
            __syncthreads();
#pragma unroll
            for (int i = 0; i < 8; ++i) { const int row = (tid >> 4) + 32 * i, c = tid & 15;
                const v4u o = *(const LAS v4u*)(T + row * 256 + ((c ^ ((row >> 2) & 15)) << 4));
                __builtin_nontemporal_store(o, (v4u*)(done.d + (size_t)row * done.dpitch + 16 * c)); }
            buf ^= 1;
            if (DYN) { it = nxt; nxt = __builtin_amdgcn_readfirstlane(slot[kq & 1]); ++kq; } else it += stride;
        }
    }
    __syncthreads();
}

__device__ __forceinline__ void p0_prologue(Frame& F, const Args& args) {
    int tid = threadIdx.x; asm volatile("" : "+v"(tid)); const int lane = tid & 63, wave = __builtin_amdgcn_readfirstlane(tid >> 6); (void)lane; (void)wave;
    unsigned char* ws = F.ws;
    {
        LAS float* sC = (LAS float*)(F.lds);
        LAS float* sR = sC + 4096;
        const float* c = args.in[1]; const float* adaw = args.in[2]; const float* adab = args.in[3]; float* MOD = (float*)(ws + WS_MOD);
        bool have = false;
        for (int task = F.bid; task < 256; task += F.G) {
            if (!have) { for (int i = tid; i < 4096; i += 512) { const float cv = c[i]; sC[i] = cv / (1.0f + expf(-cv)); } __syncthreads(); have = true; }
            const int l = task >> 7, n0 = (task & 127) * 96, cq = tid % 24, ks = tid / 24;
            if (ks < 21) {
                const int k0 = ks * 98, k1 = (k0 + 98 < 2048) ? k0 + 98 : 2048;
                const float* W = adaw + (size_t)l * 2048 * 12288 + n0 + 4 * cq;
                f32x4 a0 = {0.f, 0.f, 0.f, 0.f}, a1 = {0.f, 0.f, 0.f, 0.f};
#pragma unroll 7
                for (int k = k0; k < k1; ++k) { const f32x4 w = __builtin_nontemporal_load((const f32x4*)(W + (size_t)k * 12288)); a0 += sC[k] * w; a1 += sC[2048 + k] * w; }
#pragma unroll
                for (int j = 0; j < 4; ++j) { sR[(ks * 2 + 0) * 96 + 4 * cq + j] = a0[j]; sR[(ks * 2 + 1) * 96 + 4 * cq + j] = a1[j]; }
            }
            __syncthreads();
            if (tid < 192) { const int b = tid / 96, n = tid % 96; float s = 0.f;
#pragma unroll
                for (int k2 = 0; k2 < 21; ++k2) s += sR[(k2 * 2 + b) * 96 + n];
                __hip_atomic_store((gu32*)(MOD + (size_t)(l * 2 + b) * 12288 + n0 + n), __float_as_uint(s + adab[l * 12288 + n0 + n]), RLX_AGENT); }
            __syncthreads();
        }
        __syncthreads();
    }
    {
        const float* win = args.in[7]; const float* rw = args.in[20]; float* GWT = (float*)(ws + WS_GWT); float* RWT = (float*)(ws + WS_RWT);
        for (int i = F.bid * 512 + tid; i < 16384; i += F.G * 512) { const int g = i >> 11, k = i & 2047; __hip_atomic_store((gu32*)(GWT + i), __float_as_uint(win[(size_t)k * DINS + 4096 + g]), RLX_AGENT); RWT[i] = rw[k * 8 + g]; }
    }
    asm volatile("s_waitcnt vmcnt(0)" ::: "memory");
    __syncthreads();
    if (tid == 0) __hip_atomic_fetch_add(F.ctl + CW_P0PUB, 1u, RLX_AGENT);
    const int cv0 = (F.G == 256 ? P0_TILE0 : 0) + F.bid;
    convert_tiles(F, args, cv0, cv0 + 2 * F.G < NT_ALL - QCVT_N ? cv0 + 2 * F.G : NT_ALL - QCVT_N, F.G);
}

template <int MODE, bool X16, bool OUT8 = false>
__device__ __forceinline__ void norm_phase(Frame& F, const void* xin, const float* gain, const float* modl, int sh_off, int sc_off, bf16* HN,
                                           const float* tab, const float* bias8, float* gates_out, unsigned* tokinfo, gu32* cnt) {
    int tid = threadIdx.x; asm volatile("" : "+v"(tid)); const int lane = tid & 63, wave = __builtin_amdgcn_readfirstlane(tid >> 6); (void)lane; (void)wave;
    LAS float* sT = (LAS float*)(F.lds);
    if (MODE != 1) { for (int i = tid; i < 16384; i += 512) sT[i] = tab[i]; __syncthreads(); }
    const int gw = F.bid * NWAVES + wave, NGW = F.G * NWAVES;
    for (int t0 = gw * 4; t0 < NTOK; t0 += NGW * 4) {
        const int b = t0 >> 12;
        f32x4 ga[8], sb[8];
#pragma unroll
        for (int j = 0; j < 8; ++j) { const int col = 4 * (lane + 64 * j);
            const f32x4 g = *(const f32x4*)(gain + col), sc = *(const f32x4*)(modl + (size_t)b * 12288 + sc_off + col);
            ga[j] = g * (sc + 1.0f); sb[j] = *(const f32x4*)(modl + (size_t)b * 12288 + sh_off + col); }
        v2u xw4[4][8]; (void)xw4;
        if (X16) {
#pragma unroll
            for (int i = 0; i < 4; ++i)
#pragma unroll
                for (int j = 0; j < 8; ++j) xw4[i][j] = *(const v2u*)((const bf16*)xin + (size_t)(t0 + i) * DM + 4 * (lane + 64 * j)); }
#pragma unroll
        for (int i = 0; i < 4; ++i) {
            const int t = t0 + i;
            f32x4 v[8]; float ss = 0.f;
#pragma unroll
            for (int j = 0; j < 8; ++j) {
                if (X16) { const v2u w = xw4[i][j]; v[j] = (f32x4){bflo(w.x), bfhi(w.x), bflo(w.y), bfhi(w.y)}; }
                else v[j] = *(const f32x4*)((const float*)xin + (size_t)t * DM + 4 * (lane + 64 * j));
                ss += dot4(v[j], v[j]); }
            ss = wave_sum(ss);
            const float r = 1.0f / sqrtf(ss * (1.0f / DM) + EPS);
#pragma unroll
            for (int j = 0; j < 8; ++j) { v[j] = v[j] * r * ga[j] + sb[j];
                if (OUT8) *(unsigned*)((unsigned char*)HN + (size_t)t * DM + 4 * (lane + 64 * j)) = pg8::pk4_fp8(v[j].x, v[j].y, v[j].z, v[j].w);
                else { v2u o; o.x = pk2(v[j].x, v[j].y); o.y = pk2(v[j].z, v[j].w);
                *(v2u*)(HN + (size_t)t * DM + 4 * (lane + 64 * j)) = o; } }
            if (MODE != 1) {
                float a8[8];
#pragma unroll
                for (int g = 0; g < 8; ++g) { float s = 0.f;
#pragma unroll
                    for (int j = 0; j < 8; ++j) { const f32x4 tv = *(const LAS f32x4*)(sT + g * 2048 + 4 * (lane + 64 * j)); s += dot4(v[j], tv); }
                    a8[g] = wave_sum(s); }
                if (MODE == 0) {
                    if (lane == 0) {
                        f32x4 o0 = {a8[0] + bias8[0], a8[1] + bias8[1], a8[2] + bias8[2], a8[3] + bias8[3]}, o1 = {a8[4] + bias8[4], a8[5] + bias8[5], a8[6] + bias8[6], a8[7] + bias8[7]};
                        *(f32x4*)(gates_out + (size_t)t * 8) = o0; *(f32x4*)(gates_out + (size_t)t * 8 + 4) = o1; }
                } else {
                    if (lane == 0) {
                        int e0 = 0; float v0 = a8[0];
#pragma unroll
                        for (int g = 1; g < 8; ++g) if (a8[g] > v0) { v0 = a8[g]; e0 = g; }
                        int e1 = -1; float v1 = -3.0e38f;
#pragma unroll
                        for (int g = 0; g < 8; ++g) if (g != e0 && a8[g] > v1) { v1 = a8[g]; e1 = g; }
                        const float ex = expf(v1 - v0), g0 = 1.0f / (1.0f + ex), g1 = ex / (1.0f + ex);
                        const unsigned p0 = __hip_atomic_fetch_add(cnt + 64 * e0, 1u, RLX_AGENT), p1 = __hip_atomic_fetch_add(cnt + 64 * e1, 1u, RLX_AGENT);
                        v4u w0; w0.x = (unsigned)e0; w0.y = (unsigned)e1; w0.z = p0; w0.w = p1;
                        v4u w1; w1.x = __float_as_uint(g0); w1.y = __float_as_uint(g1); w1.z = 0u; w1.w = 0u;
                        *(v4u*)(tokinfo + (size_t)t * 8) = w0; *(v4u*)(tokinfo + (size_t)t * 8 + 4) = w1; }
                }
            }
        }
    }
    if (MODE != 1) __syncthreads();
}

template <int W>
__device__ __forceinline__ void pool_rows(const bf16* __restrict__ PROJ, bf16* __restrict__ POOLED, int tb, int posb, int col) {
    float h0[W - 1], h1[W - 1];
#pragma unroll
    for (int j = 0; j < W - 1; ++j) { const bool in = posb - 1 - j >= 0; const unsigned rr = *(const unsigned*)(PROJ + (size_t)(in ? tb - 1 - j : tb) * DINP + 4096 + col); const unsigned r = in ? rr : 0u; h0[j] = bflo(r); h1[j] = bfhi(r); }
    for (int i8 = 0; i8 < 32; i8 += 8) {
        unsigned r8[8];
#pragma unroll
        for (int ii = 0; ii < 8; ++ii) r8[ii] = *(const unsigned*)(PROJ + (size_t)(tb + i8 + ii) * DINP + 4096 + col);
#pragma unroll
        for (int ii = 0; ii < 8; ++ii) {
            const int t = tb + i8 + ii, pos = posb + i8 + ii, cnt = (pos + 1 < W) ? pos + 1 : W;
            const float x0 = bflo(r8[ii]), x1 = bfhi(r8[ii]);
            float s0 = x0, s1 = x1;
#pragma unroll
            for (int j = 0; j < W - 1; ++j) { s0 += h0[j]; s1 += h1[j]; }
            const float ic = __builtin_amdgcn_rcpf((float)cnt);
            *(unsigned*)(POOLED + (size_t)t * 1024 + col) = pk2(s0 * ic - x0, s1 * ic - x1);
#pragma unroll
            for (int j = W - 2; j > 0; --j) { h0[j] = h0[j - 1]; h1[j] = h1[j - 1]; }
            h0[0] = x0; h1[0] = x1;
        }
    }
}
__device__ __forceinline__ void prep_phase(Frame& F, const Args& args) {
    int tid = threadIdx.x; asm volatile("" : "+v"(tid)); const int lane = tid & 63, wave = __builtin_amdgcn_readfirstlane(tid >> 6);
    unsigned char* ws = F.ws;
    const bf16* __restrict__ PROJ = (const bf16*)(ws + WS_PROJ); const float* __restrict__ GATES = (const float*)(ws + WS_GATES);
    float* __restrict__ BCUM = (float*)(ws + WS_BCUM); float* __restrict__ IG = (float*)(ws + WS_IG); float* __restrict__ GTOT = (float*)(ws + WS_GTOT); float* __restrict__ DN = (float*)(ws + WS_DN);
    bf16* __restrict__ QB = (bf16*)(ws + WS_QB); bf16* __restrict__ KB = (bf16*)(ws + WS_KB); bf16* __restrict__ KWT = (bf16*)(ws + WS_KWT); bf16* __restrict__ AP = (bf16*)(ws + WS_AP); bf16* __restrict__ BP = (bf16*)(ws + WS_BP);
    bf16* __restrict__ POOLED = (bf16*)(ws + WS_POOLED);
    const float* __restrict__ convw = args.in[9]; const float* __restrict__ convb = args.in[10];
    LAS float* sB = (LAS float*)(F.lds); LAS float* sI = sB + 256; LAS float* sW = sI + 256;
    LAS unsigned* TK = (LAS unsigned*)(F.lds + 4096); LAS unsigned* TV = TK + 128 * 129;
    for (int task = F.bid; task < 2 * NUNIT; task += F.G) {
        const int u = task >> 1, half = task & 1, b = u >> 6, h = (u >> 4) & 3, c = u & 15, t0 = b * SEQ + c * 256;
        float sc = 0.f, ir = 0.f;
        if (tid < 256) { const float fr = GATES[(size_t)(t0 + tid) * 8 + 4 + h]; ir = GATES[(size_t)(t0 + tid) * 8 + h]; sc = logsig(fr);
#pragma unroll
            for (int o = 1; o < 64; o <<= 1) { const float y = __shfl_up(sc, o); if (lane >= o) sc += y; }
            sI[tid] = ir; if (lane == 63) sW[wave] = sc; }
        __syncthreads();
        if (tid < 256) { for (int w2 = 0; w2 < wave; ++w2) sc += sW[w2]; sB[tid] = sc; if (half == 0) { BCUM[u * 256 + tid] = sc; IG[u * 256 + tid] = ir; } }
        __syncthreads();
        const float Gt = sB[255];
        if (half == 0 && tid == 0) GTOT[u] = Gt;
        {
            const int cp = tid & 63, tg = tid >> 6, dc = half * 128 + 2 * cp, chq = h * 256 + dc, chk = 1024 + h * 256 + dc, chv = 2048 + h * 256 + dc;
            float wq[4][2], wk[4][2], bq[2], bk[2];
#pragma unroll
            for (int j = 0; j < 4; ++j) { wq[j][0] = convw[j * 2048 + chq]; wq[j][1] = convw[j * 2048 + chq + 1]; wk[j][0] = convw[j * 2048 + chk]; wk[j][1] = convw[j * 2048 + chk + 1]; }
            bq[0] = convb[chq]; bq[1] = convb[chq + 1]; bk[0] = convb[chk]; bk[1] = convb[chk + 1];
            const int tl0 = tg * 32, pos0 = c * 256 + tl0;
            float xq[3][2], xk[3][2];
#pragma unroll
            for (int jj = 0; jj < 3; ++jj) { const int p = pos0 - 3 + jj; unsigned rq = 0u, rk = 0u;
                if (p >= 0) { const bf16* row = PROJ + (size_t)(b * SEQ + p) * DINP; rq = *(const unsigned*)(row + chq); rk = *(const unsigned*)(row + chk); }
                xq[jj][0] = bflo(rq); xq[jj][1] = bfhi(rq); xk[jj][0] = bflo(rk); xk[jj][1] = bfhi(rk); }
            for (int i8 = 0; i8 < 32; i8 += 8) {
                unsigned rq8[8], rk8[8], rv8[8];
#pragma unroll
                for (int ii = 0; ii < 8; ++ii) { const bf16* row = PROJ + (size_t)(t0 + tl0 + i8 + ii) * DINP; rq8[ii] = *(const unsigned*)(row + chq); rk8[ii] = *(const unsigned*)(row + chk); rv8[ii] = *(const unsigned*)(row + chv); }
                float pkw0 = 0.f, pkw1 = 0.f, pv0 = 0.f, pv1 = 0.f;
#pragma unroll
                for (int ii = 0; ii < 8; ++ii) {
                    const int tl = tl0 + i8 + ii; const unsigned rq = rq8[ii], rk = rk8[ii], rv = rv8[ii];
                    const float cq0 = bflo(rq), cq1 = bfhi(rq), ck0 = bflo(rk), ck1 = bfhi(rk);
                    const float yq0 = bq[0] + wq[0][0] * xq[0][0] + wq[1][0] * xq[1][0] + wq[2][0] * xq[2][0] + wq[3][0] * cq0;
                    const float yq1 = bq[1] + wq[0][1] * xq[0][1] + wq[1][1] * xq[1][1] + wq[2][1] * xq[2][1] + wq[3][1] * cq1;
                    const float yk0 = bk[0] + wk[0][0] * xk[0][0] + wk[1][0] * xk[1][0] + wk[2][0] * xk[2][0] + wk[3][0] * ck0;
                    const float yk1 = bk[1] + wk[0][1] * xk[0][1] + wk[1][1] * xk[1][1] + wk[2][1] * xk[2][1] + wk[3][1] * ck1;
                    xq[0][0] = xq[1][0]; xq[1][0] = xq[2][0]; xq[2][0] = cq0; xq[0][1] = xq[1][1]; xq[1][1] = xq[2][1]; xq[2][1] = cq1;
                    xk[0][0] = xk[1][0]; xk[1][0] = xk[2][0]; xk[2][0] = ck0; xk[0][1] = xk[1][1]; xk[1][1] = xk[2][1]; xk[2][1] = ck1;
                    const float q0 = yq0 * __builtin_amdgcn_rcpf(1.0f + __expf(-yq0)) * 0.0625f, q1 = yq1 * __builtin_amdgcn_rcpf(1.0f + __expf(-yq1)) * 0.0625f;
                    const float k0 = yk0 * __builtin_amdgcn_rcpf(1.0f + __expf(-yk0)), k1 = yk1 * __builtin_amdgcn_rcpf(1.0f + __expf(-yk1));
                    const float bt = sB[tl], it = sI[tl], eb = __expf(bt), kwf = __expf(Gt - bt + it);
                    const size_t ro = (size_t)u * 256 + tl;
                    *(unsigned*)(QB + ro * 256 + dc) = pk2(q0, q1);
                    *(unsigned*)(AP + ro * 512 + dc) = pk2(eb * q0, eb * q1);
                    *(unsigned*)(KB + ro * 256 + dc) = pk2(k0, k1);
                    const float kw0 = kwf * k0, kw1 = kwf * k1, v0 = bflo(rv), v1 = bfhi(rv);
                    if (ii & 1) { TK[(2 * cp) * 129 + (tl >> 1)] = pk2(pkw0, kw0); TK[(2 * cp + 1) * 129 + (tl >> 1)] = pk2(pkw1, kw1);
                                  TV[(2 * cp) * 129 + (tl >> 1)] = pk2(pv0, v0);   TV[(2 * cp + 1) * 129 + (tl >> 1)] = pk2(pv1, v1); }
                    else { pkw0 = kw0; pkw1 = kw1; pv0 = v0; pv1 = v1; }
                }
            }
        }
        __syncthreads();
        for (int idx = tid; idx < 128 * 32; idx += 512) { const int dl = idx >> 5, ch = idx & 31;
            v4u o; o.x = TK[dl * 129 + 4 * ch]; o.y = TK[dl * 129 + 4 * ch + 1]; o.z = TK[dl * 129 + 4 * ch + 2]; o.w = TK[dl * 129 + 4 * ch + 3];
            *(v4u*)(KWT + ((size_t)u * 256 + half * 128 + dl) * 256 + 8 * ch) = o;
            o.x = TV[dl * 129 + 4 * ch]; o.y = TV[dl * 129 + 4 * ch + 1]; o.z = TV[dl * 129 + 4 * ch + 2]; o.w = TV[dl * 129 + 4 * ch + 3];
            *(v4u*)(BP + ((size_t)u * 256 + half * 128 + dl) * 512 + 256 + 8 * ch) = o; }
        if (tid < 128) { float s = 0.f; for (int w2 = 0; w2 < 128; ++w2) { const unsigned p = TK[tid * 129 + w2]; s += bflo(p) + bfhi(p); } DN[u * 256 + half * 128 + tid] = s; }
        __syncthreads();
    }
    for (int pb = F.bid; pb < NTOK / 32; pb += F.G) {
        const int col = 2 * tid, g = __builtin_amdgcn_readfirstlane(col >> 8), tb = pb * 32, posb = tb & (SEQ - 1);
        if (g == 0) pool_rows<2>(PROJ, POOLED, tb, posb, col); else if (g == 1) pool_rows<4>(PROJ, POOLED, tb, posb, col);
        else if (g == 2) pool_rows<8>(PROJ, POOLED, tb, posb, col); else pool_rows<16>(PROJ, POOLED, tb, posb, col);
    }
}

__device__ __forceinline__ void scan_phase(Frame& F) {
    int tid = threadIdx.x; asm volatile("" : "+v"(tid)); const int lane = tid & 63, wave = __builtin_amdgcn_readfirstlane(tid >> 6); (void)lane; (void)wave;
    unsigned char* ws = F.ws;
    const float* DCT = (const float*)(ws + WS_DCT); const float* GTOT = (const float*)(ws + WS_GTOT); const float* DN = (const float*)(ws + WS_DN);
    bf16* BP = (bf16*)(ws + WS_BP); float* NVEC = (float*)(ws + WS_NVEC);
    for (int eg = F.bid * 512 + tid; eg < 8 * 16384; eg += F.G * 512) {
        const int bh = eg >> 14, rem = eg & 16383, e = rem >> 6, d4 = (rem & 63) * 4;
        f32x4 C = {0.f, 0.f, 0.f, 0.f};
        for (int c = 0; c < 16; ++c) { const int u = bh * 16 + c;
            v2u o; o.x = pk2(C.x, C.y); o.y = pk2(C.z, C.w);
            *(v2u*)(BP + ((size_t)u * 256 + e) * 512 + d4) = o;
            const f32x4 d = *(const f32x4*)(DCT + ((size_t)u * 256 + e) * 256 + d4);
            C = C * __expf(GTOT[u]) + d; }
    }
    for (int id = F.bid * 512 + tid; id < 2048; id += F.G * 512) {
        const int bh = id >> 8, d = id & 255; float n = 0.f;
        for (int c = 0; c < 16; ++c) { const int u = bh * 16 + c; NVEC[u * 256 + d] = n; n = n * __expf(GTOT[u]) + DN[u * 256 + d]; }
    }
}

typedef float f32x16 __attribute__((ext_vector_type(16)));
typedef short s16x8 __attribute__((ext_vector_type(8)));
typedef float f32x2_t __attribute__((ext_vector_type(2))); typedef __bf16 bf16x2_t __attribute__((ext_vector_type(2)));
__device__ __forceinline__ unsigned cvtpk_s(float lo, float hi) { f32x2_t v = {lo, hi}; bf16x2_t b = __builtin_convertvector(v, bf16x2_t); return __builtin_bit_cast(unsigned, b); }
__device__ __forceinline__ void attn_phase(Frame& F) {
    int tid = threadIdx.x; asm volatile("" : "+v"(tid)); const int lane = tid & 63, wave = __builtin_amdgcn_readfirstlane(tid >> 6);
    unsigned char* ws = F.ws;
    const bf16* QB = (const bf16*)(ws + WS_QB2); const bf16* KB = (const bf16*)(ws + WS_KB2); const bf16* VT = (const bf16*)(ws + WS_VT);
    bf16* ATTO = (bf16*)(ws + WS_ATTO);
    const int gw = F.bid * NWAVES + wave, NGW = F.G * NWAVES;
    const int r = lane & 31, hlf = lane >> 5;
    for (int p = gw; p < 4096; p += NGW) {
        const int qt = p & 127, hh = (p >> 7) & 15, b = p >> 11, t0 = qt * 32;
        const size_t hb = ((size_t)(b * 16 + hh) * 128) * 4096; const int lo16 = r * 16 + hlf * 8;
        const bf16* qrow = QB + hb + (size_t)qt * 4096 + lo16;
        s16x8 qf[8];
#pragma unroll
        for (int kk = 0; kk < 8; ++kk) qf[kk] = *(const s16x8*)(qrow + 512 * kk);
        f32x16 O[4];
#pragma unroll
        for (int et = 0; et < 4; ++et)
#pragma unroll
            for (int i = 0; i < 16; ++i) O[et][i] = 0.f;
        float R = 1.0f;
        s16x8 kf[8];
        { const bf16* krow = KB + hb + (size_t)qt * 4096 + lo16;
#pragma unroll
          for (int kk = 0; kk < 8; ++kk) kf[kk] = *(const s16x8*)(krow + 512 * kk); }
        for (int s0 = t0; ; s0 -= 32) {
            s16x8 vf[8];
            { const bf16* vp = VT + hb + (size_t)(s0 >> 5) * 4096 + lo16;
#pragma unroll
              for (int q = 0; q < 8; ++q) vf[q] = *(const s16x8*)(vp + 512 * q); }
            __builtin_amdgcn_sched_barrier(0);
            f32x16 zt;
#pragma unroll
            for (int i = 0; i < 16; ++i) zt[i] = 0.f;
#pragma unroll
            for (int kk = 0; kk < 8; ++kk) zt = __builtin_amdgcn_mfma_f32_32x32x16_bf16(kf[kk], qf[kk], zt, 0, 0, 0);
            __builtin_amdgcn_sched_barrier(0);
            { const int sn = (s0 >= 32) ? s0 - 32 : s0;
              const bf16* krow = KB + hb + (size_t)(sn >> 5) * 4096 + lo16;
#pragma unroll
              for (int kk = 0; kk < 8; ++kk) kf[kk] = *(const s16x8*)(krow + 512 * kk); }
            __builtin_amdgcn_sched_barrier(0);
            const bool diag = (s0 == t0);
            float sg[16], om[16];
            if (diag) {
#pragma unroll
                for (int i = 0; i < 16; ++i) { const int sl = (i & 3) + 8 * (i >> 2) + 4 * hlf;
                    const float s = __builtin_amdgcn_rcpf(1.0f + __builtin_amdgcn_exp2f(-zt[i]));
                    const bool valid = sl < r;
                    sg[i] = valid ? s : 0.f; om[i] = valid ? 1.0f - s : 1.0f; }
            } else {
#pragma unroll
                for (int i = 0; i < 16; ++i) { const float s = __builtin_amdgcn_rcpf(1.0f + __builtin_amdgcn_exp2f(-zt[i])); sg[i] = s; om[i] = 1.0f - s; }
            }
            float Sg[4], Pg[4], tot[4];
#pragma unroll
            for (int g = 0; g < 4; ++g) { Sg[g] = (om[4 * g] * om[4 * g + 1]) * (om[4 * g + 2] * om[4 * g + 3]); Pg[g] = __shfl_xor(Sg[g], 32); tot[g] = Sg[g] * Pg[g]; }
            float after[4]; after[3] = 1.0f; after[2] = tot[3]; after[1] = tot[3] * tot[2]; after[0] = (tot[3] * tot[2]) * tot[1];
            const float T = ((tot[3] * tot[2]) * tot[1]) * tot[0];
            float A[16];
#pragma unroll
            for (int g = 0; g < 4; ++g) { float run = R * after[g] * (hlf == 0 ? Pg[g] : 1.0f);
#pragma unroll
                for (int w = 3; w >= 0; --w) { const int i = 4 * g + w; A[i] = sg[i] * run; run *= om[i]; } }
            R *= T;
#pragma unroll
            for (int sp = 0; sp < 2; ++sp) {
                v4u xa; xa.x = cvtpk_s(A[8 * sp], A[8 * sp + 1]); xa.y = cvtpk_s(A[8 * sp + 2], A[8 * sp + 3]); xa.z = cvtpk_s(A[8 * sp + 4], A[8 * sp + 5]); xa.w = cvtpk_s(A[8 * sp + 6], A[8 * sp + 7]);
                const s16x8 xf = __builtin_bit_cast(s16x8, xa);
#pragma unroll
                for (int et = 0; et < 4; ++et) {
                    O[et] = __builtin_amdgcn_mfma_f32_32x32x16_bf16(xf, vf[sp * 4 + et], O[et], 0, 0, 0);
                }
            }
            if (s0 == 0 || __all(R == 0.f)) break;
        }
        { LAS unsigned char* ot = F.lds + wave * 8704;
#pragma unroll
          for (int et = 0; et < 4; ++et)
#pragma unroll
              for (int i = 0; i < 16; ++i) { const int tr = (i & 3) + 8 * (i >> 2) + 4 * hlf;
                  *(LAS bf16*)(ot + tr * 272 + (32 * et + r) * 2) = (bf16)(cvtpk_s(O[et][i], 0.f) & 0xffffu); }
          LDS_WAIT();
#pragma unroll
          for (int q = 0; q < 8; ++q) { const int tr = 4 * q + (lane >> 4), ch = lane & 15;
              const v4u o = *(const LAS v4u*)(ot + tr * 272 + 16 * ch);
              *(v4u*)(ATTO + (size_t)(b * SEQ + t0 + tr) * DM + hh * 128 + 8 * ch) = o; }
          LDS_WAIT(); }
    }
}

__device__ __forceinline__ void moe_bases(const gu32* cnt, int (&base)[8], int (&cn)[8]) {
    int acc = 0;
#pragma unroll
    for (int e = 0; e < 8; ++e) { cn[e] = (int)__hip_atomic_load(cnt + 64 * e, RLX_AGENT); base[e] = acc; acc += (cn[e] + 255) & ~255; }
}
__device__ __forceinline__ void gather_phase(Frame& F) {
    int tid = threadIdx.x; asm volatile("" : "+v"(tid)); const int lane = tid & 63, wave = __builtin_amdgcn_readfirstlane(tid >> 6);
    unsigned char* ws = F.ws;
    const unsigned* TOKINFO = (const unsigned*)(ws + WS_TOKINFO); int* TOKSLOT = (int*)(ws + WS_TOKSLOT); float* SLOTGATE = (float*)(ws + WS_SLOTGATE);
    const bf16* HN = (const bf16*)(ws + WS_HN); unsigned char* HPERM = ws + WS_HPERM;
    int base[8], cn[8]; moe_bases(F.ctl + CW_CNT, base, cn);
    const int gw = F.bid * NWAVES + wave, NGW = F.G * NWAVES;
    for (int p0 = gw * 4; p0 < NTOK; p0 += NGW * 4) {
        v4u w0[4], w1[4];
#pragma unroll
        for (int i = 0; i < 4; ++i) { w0[i] = *(const v4u*)(TOKINFO + (size_t)(p0 + i) * 8); w1[i] = *(const v4u*)(TOKINFO + (size_t)(p0 + i) * 8 + 4); }
        v4u v[4][4];
#pragma unroll
        for (int i = 0; i < 4; ++i) { const v4u* src = (const v4u*)(HN + (size_t)(p0 + i) * DM);
#pragma unroll
            for (int j = 0; j < 4; ++j) v[i][j] = src[lane + 64 * j]; }
#pragma unroll
        for (int i = 0; i < 4; ++i) {
            int b0 = 0, b1 = 0;
#pragma unroll
            for (int e = 0; e < 8; ++e) { b0 = ((int)w0[i].x == e) ? base[e] : b0; b1 = ((int)w0[i].y == e) ? base[e] : b1; }
            const int s0 = b0 + (int)w0[i].z, s1 = b1 + (int)w0[i].w;
            v2u* d0 = (v2u*)(HPERM + (size_t)s0 * DM); v2u* d1 = (v2u*)(HPERM + (size_t)s1 * DM);
#pragma unroll
            for (int j = 0; j < 4; ++j) { const v4u x = v[i][j];
                v2u o; o.x = pg8::pk4_fp8(bflo(x.x), bfhi(x.x), bflo(x.y), bfhi(x.y)); o.y = pg8::pk4_fp8(bflo(x.z), bfhi(x.z), bflo(x.w), bfhi(x.w));
                d0[lane + 64 * j] = o; d1[lane + 64 * j] = o; }
            if (lane == 0) { TOKSLOT[(p0 + i) * 2] = s0; TOKSLOT[(p0 + i) * 2 + 1] = s1; SLOTGATE[s0] = __uint_as_float(w1[i].x); SLOTGATE[s1] = __uint_as_float(w1[i].y); }
        }
    }
    for (int q = gw; q < 2048; q += NGW) {
        const int e = q >> 8, r = q & 255;
        int be = 0, ce = 0;
#pragma unroll
        for (int k = 0; k < 8; ++k) { be = (e == k) ? base[k] : be; ce = (e == k) ? cn[k] : ce; }
        if ((ce & 255) != 0 && r >= (ce & 255)) { const int row = be + (ce & ~255) + r; v4u* d = (v4u*)(HPERM + (size_t)row * DM); const v4u z = {0u, 0u, 0u, 0u};
#pragma unroll
            for (int j = 0; j < 2; ++j) d[lane + 64 * j] = z;
            if (lane == 0) SLOTGATE[row] = 0.f; }
    }
}

__device__ __forceinline__ void route_phase(Frame& F, const bf16* xin, const float* gain, const float* modl, int sh_off, int sc_off, const float* tab, gu32* cnt, gu32* donec) {
    int tid = threadIdx.x; asm volatile("" : "+v"(tid)); const int lane = tid & 63, wave = __builtin_amdgcn_readfirstlane(tid >> 6);
    unsigned char* ws = F.ws;
    int* TOKSLOT = (int*)(ws + WS_TOKSLOT); float* SLOTGATE = (float*)(ws + WS_SLOTGATE); unsigned char* HPERM = ws + WS_HPERM;
    LAS float* sT = (LAS float*)(F.lds);
    LAS unsigned* lcnt = (LAS unsigned*)(F.lds + 65536 + 16384);
    for (int i = tid; i < 16384; i += 512) sT[i] = tab[i];
    if (tid < 16) lcnt[tid] = 0u;
    __syncthreads();
    const int gw = F.bid * NWAVES + wave, NGW = F.G * NWAVES, t0 = gw * 4;
    unsigned rowq[4][8]; int e0[4], e1[4]; unsigned p0[4], p1[4]; float g0[4], g1[4];
    if (t0 < NTOK) {
        const int b = t0 >> 12;
        f32x4 ga[8], sb[8];
#pragma unroll
        for (int j = 0; j < 8; ++j) { const int col = 4 * (lane + 64 * j);
            const f32x4 g = *(const f32x4*)(gain + col), sc = *(const f32x4*)(modl + (size_t)b * 12288 + sc_off + col);
            ga[j] = g * (sc + 1.0f); sb[j] = *(const f32x4*)(modl + (size_t)b * 12288 + sh_off + col); }
#pragma unroll
        for (int i = 0; i < 4; ++i) {
            const int t = t0 + i;
            f32x4 v[8]; float ss = 0.f;
#pragma unroll
            for (int j = 0; j < 8; ++j) { const v2u w = *(const v2u*)(xin + (size_t)t * DM + 4 * (lane + 64 * j)); v[j] = (f32x4){bflo(w.x), bfhi(w.x), bflo(w.y), bfhi(w.y)}; ss += dot4(v[j], v[j]); }
            ss = wave_sum(ss);
            const float r = 1.0f / sqrtf(ss * (1.0f / DM) + EPS);
#pragma unroll
            for (int j = 0; j < 8; ++j) { v[j] = v[j] * r * ga[j] + sb[j]; rowq[i][j] = pg8::pk4_fp8(v[j].x, v[j].y, v[j].z, v[j].w); }
            float a8[8]; int zi; asm volatile("v_mov_b32 %0, 0" : "=v"(zi));
#pragma unroll
            for (int g = 0; g < 8; ++g) { float s = 0.f;
#pragma unroll
                for (int j = 0; j < 8; ++j) { const f32x4 tv = *(const LAS f32x4*)(sT + g * 2048 + 4 * (lane + 64 * j) + zi); s += dot4(v[j], tv); }
                a8[g] = wave_sum(s); }
            int ea = 0; float va = a8[0];
#pragma unroll
            for (int g = 1; g < 8; ++g) if (a8[g] > va) { va = a8[g]; ea = g; }
            int eb = -1; float vb = -3.0e38f;
#pragma unroll
            for (int g = 0; g < 8; ++g) if (g != ea && a8[g] > vb) { vb = a8[g]; eb = g; }
            ea = __builtin_amdgcn_readfirstlane(ea); eb = __builtin_amdgcn_readfirstlane(eb);
            const float ex = expf(vb - va); g0[i] = 1.0f / (1.0f + ex); g1[i] = ex / (1.0f + ex);
            unsigned pa = 0u, pb = 0u;
            if (lane == 0) { pa = __hip_atomic_fetch_add((LAS unsigned*)(lcnt + ea), 1u, __ATOMIC_RELAXED, __HIP_MEMORY_SCOPE_WORKGROUP); pb = __hip_atomic_fetch_add((LAS unsigned*)(lcnt + eb), 1u, __ATOMIC_RELAXED, __HIP_MEMORY_SCOPE_WORKGROUP); }
            e0[i] = ea; e1[i] = eb; p0[i] = (unsigned)__builtin_amdgcn_readfirstlane((int)pa); p1[i] = (unsigned)__builtin_amdgcn_readfirstlane((int)pb);
        }
    }
    asm volatile("s_waitcnt vmcnt(0) lgkmcnt(0)" ::: "memory");
    __syncthreads();
    if (tid < 8) { const unsigned n = lcnt[tid]; lcnt[8 + tid] = n ? __hip_atomic_fetch_add(cnt + 64 * tid, n, RLX_AGENT) : 0u; }
    asm volatile("s_waitcnt vmcnt(0) lgkmcnt(0)" ::: "memory");
    __syncthreads();
    if (tid == 0) { __hip_atomic_fetch_add(donec, 1u, RLX_AGENT);
        unsigned sp = 0; while (__hip_atomic_load(donec, RLX_AGENT) < (unsigned)F.G) { __builtin_amdgcn_s_sleep(1); if (++sp > (1u << 22)) break; } }
    __syncthreads();
    int base[8], cn[8]; moe_bases(cnt, base, cn);
    LAS unsigned char* stg = F.lds + 65536 + wave * 2048;
    if (t0 < NTOK) {
#pragma unroll
        for (int i = 0; i < 4; ++i) {
            int b0 = 0, b1 = 0;
#pragma unroll
            for (int e = 0; e < 8; ++e) { b0 = (e0[i] == e) ? base[e] : b0; b1 = (e1[i] == e) ? base[e] : b1; }
            const int s0 = b0 + (int)(lcnt[8 + e0[i]] + p0[i]), s1 = b1 + (int)(lcnt[8 + e1[i]] + p1[i]);
#pragma unroll
            for (int j = 0; j < 8; ++j) *(LAS unsigned*)(stg + 4 * (lane + 64 * j)) = rowq[i][j];
            LDS_WAIT();
            const v4u o0 = *(const LAS v4u*)(stg + 32 * lane), o1 = *(const LAS v4u*)(stg + 32 * lane + 16);
            LDS_WAIT();
            v4u* d0 = (v4u*)(HPERM + (size_t)s0 * DM + 32 * lane); v4u* d1 = (v4u*)(HPERM + (size_t)s1 * DM + 32 * lane);
            d0[0] = o0; d0[1] = o1; d1[0] = o0; d1[1] = o1;
            if (lane == 0) { TOKSLOT[(t0 + i) * 2] = s0; TOKSLOT[(t0 + i) * 2 + 1] = s1; SLOTGATE[s0] = g0[i]; SLOTGATE[s1] = g1[i]; }
        }
    }
    for (int q = gw; q < 2048; q += NGW) {
        const int e = q >> 8, r = q & 255;
        int be = 0, ce = 0;
#pragma unroll
        for (int k = 0; k < 8; ++k) { be = (e == k) ? base[k] : be; ce = (e == k) ? cn[k] : ce; }
        if ((ce & 255) != 0 && r >= (ce & 255)) { const int row = be + (ce & ~255) + r; v4u* d = (v4u*)(HPERM + (size_t)row * DM); const v4u z = {0u, 0u, 0u, 0u};
#pragma unroll
            for (int j = 0; j < 2; ++j) d[lane + 64 * j] = z;
            if (lane == 0) SLOTGATE[row] = 0.f; }
    }
    __syncthreads();
}

__device__ __forceinline__ void final_phase(Frame& F, const Args& args) {
    int tid = threadIdx.x; asm volatile("" : "+v"(tid)); const int lane = tid & 63, wave = __builtin_amdgcn_readfirstlane(tid >> 6); (void)lane; (void)wave;
    unsigned char* ws = F.ws;
    const bf16* XR = (const bf16*)(ws + WS_XR); const bf16* Y = (const bf16*)(ws + WS_Y); const bf16* YP = (const bf16*)(ws + WS_YP); const int* TOKSLOT = (const int*)(ws + WS_TOKSLOT);
    const float* g2 = (const float*)(ws + WS_MOD) + (size_t)2 * 12288 + 10240; const float* gfin = args.in[6]; float* out = args.out;
    const int gw = F.bid * NWAVES + wave, NGW = F.G * NWAVES;
    for (int t = gw; t < NTOK; t += NGW) {
        const int b = t >> 12, s0 = __builtin_amdgcn_readfirstlane(TOKSLOT[t * 2]), s1 = __builtin_amdgcn_readfirstlane(TOKSLOT[t * 2 + 1]);
        f32x4 v[8]; float ss = 0.f;
        if (s0 < 16384 && s1 < 16384) {
            v2u xw[8], y0[8], y1[8]; f32x4 g[8];
#pragma unroll
            for (int j = 0; j < 8; ++j) { const int col = 4 * (lane + 64 * j);
                xw[j] = *(const v2u*)(XR + (size_t)t * DM + col); g[j] = *(const f32x4*)(g2 + (size_t)b * 12288 + col);
                y0[j] = *(const v2u*)(Y + (size_t)s0 * DM + col); y1[j] = *(const v2u*)(Y + (size_t)s1 * DM + col); }
#pragma unroll
            for (int j = 0; j < 8; ++j) { const f32x4 x = {bflo(xw[j].x), bfhi(xw[j].x), bflo(xw[j].y), bfhi(xw[j].y)};
                f32x4 ys = {0.f, 0.f, 0.f, 0.f};
                ys.x += bflo(y0[j].x); ys.y += bfhi(y0[j].x); ys.z += bflo(y0[j].y); ys.w += bfhi(y0[j].y);
                ys.x += bflo(y1[j].x); ys.y += bfhi(y1[j].x); ys.z += bflo(y1[j].y); ys.w += bfhi(y1[j].y);
                v[j] = x + g[j] * ys; ss += dot4(v[j], v[j]); }
        } else {
            const bf16* r0[4]; const bf16* r1[4]; float w0[4], w1[4];
#pragma unroll
            for (int q = 0; q < 4; ++q) {
                r0[q] = (s0 < 16384) ? Y + (size_t)s0 * DM : YP + ((size_t)q * 1792 + (s0 - 16384)) * DM; w0[q] = (s0 < 16384 && q > 0) ? 0.f : 1.f;
                r1[q] = (s1 < 16384) ? Y + (size_t)s1 * DM : YP + ((size_t)q * 1792 + (s1 - 16384)) * DM; w1[q] = (s1 < 16384 && q > 0) ? 0.f : 1.f; }
#pragma unroll
            for (int jh = 0; jh < 8; jh += 4) {
                v2u xw[4], ya[4][4], yb[4][4]; f32x4 g[4];
#pragma unroll
                for (int jj = 0; jj < 4; ++jj) { const int col = 4 * (lane + 64 * (jh + jj));
                    xw[jj] = *(const v2u*)(XR + (size_t)t * DM + col); g[jj] = *(const f32x4*)(g2 + (size_t)b * 12288 + col);
#pragma unroll
                    for (int q = 0; q < 4; ++q) { ya[jj][q] = *(const v2u*)(r0[q] + col); yb[jj][q] = *(const v2u*)(r1[q] + col); } }
#pragma unroll
                for (int jj = 0; jj < 4; ++jj) { const f32x4 x = {bflo(xw[jj].x), bfhi(xw[jj].x), bflo(xw[jj].y), bfhi(xw[jj].y)};
                    f32x4 ys = {0.f, 0.f, 0.f, 0.f};
#pragma unroll
                    for (int q = 0; q < 4; ++q) {
                        ys.x += w0[q] * bflo(ya[jj][q].x) + w1[q] * bflo(yb[jj][q].x); ys.y += w0[q] * bfhi(ya[jj][q].x) + w1[q] * bfhi(yb[jj][q].x);
                        ys.z += w0[q] * bflo(ya[jj][q].y) + w1[q] * bflo(yb[jj][q].y); ys.w += w0[q] * bfhi(ya[jj][q].y) + w1[q] * bfhi(yb[jj][q].y); }
                    v[jh + jj] = x + g[jj] * ys; ss += dot4(v[jh + jj], v[jh + jj]); }
            }
        }
        ss = wave_sum(ss);
        const float r = 1.0f / sqrtf(ss * (1.0f / DM) + EPS);
#pragma unroll
        for (int j = 0; j < 8; ++j) { const int col = 4 * (lane + 64 * j); const f32x4 g = *(const f32x4*)(gfin + col); *(f32x4*)(out + (size_t)t * DM + col) = v[j] * r * g; }
    }
}

__device__ __forceinline__ void panel_handoff(gu32* cnt, int my_pm, bool has, int need_pm, unsigned need) {
    int tid = threadIdx.x; asm volatile("" : "+v"(tid));
    asm volatile("s_waitcnt vmcnt(0)" ::: "memory");
    __syncthreads();
    if (tid == 0) {
        if (has) __hip_atomic_fetch_add(cnt + 64 * my_pm, 1u, RLX_AGENT);
        unsigned sp = 0; while (__hip_atomic_load(cnt + 64 * need_pm, RLX_AGENT) < need) { __builtin_amdgcn_s_sleep(1); if (++sp > (1u << 22)) break; }
        __builtin_amdgcn_fence(__ATOMIC_ACQUIRE, "agent"); asm volatile("s_waitcnt vmcnt(0)" ::: "memory");
    }
    __syncthreads();
}
__global__ void __launch_bounds__(NWAVES * 64, 2) hybrid_fwd(Args args) {
    extern __shared__ __attribute__((aligned(16))) unsigned char lds[];
    Frame F;
    F.lds = (LAS unsigned char*)lds;
    F.MISC = (volatile LAS unsigned*)(F.lds + MISC_OFF);
    F.G = gridDim.x; F.bid = blockIdx.x;
    unsigned char* ws = args.ws; F.ws = ws;
    F.ctl = (gu32*)(ws + WS_CTL);
    for (int u = threadIdx.x; u < (LDS_BYTES - LDSCTL_OFF) / 4; u += NWAVES * 64) ((LAS unsigned*)(F.lds + LDSCTL_OFF))[u] = 0u;
    __syncthreads();
    XcdBarrier bar = xcd_barrier_post((unsigned*)(F.ctl + CW_BAR), F.MISC + 8);
#define GRID_BAR() xcd_barrier(bar)
    using namespace pg8;
    PG8_LAS unsigned char* ring = F.lds + RING_OFF;
    const float* MOD = (const float*)(ws + WS_MOD);
    bf16* HN = (bf16*)(ws + WS_HN); bf16* XR = (bf16*)(ws + WS_XR);

#if SKELETON
    for (int k = 0; k < 20; ++k) GRID_BAR();
    for (size_t i = (size_t)F.bid * 512 + threadIdx.x; i < (size_t)NTOK * DM / 4; i += (size_t)F.G * 512) ((f32x4*)args.out)[i] = ((const f32x4*)args.in[0])[i];
#else
    p0_prologue(F, args);
    { int tid = threadIdx.x; asm volatile("" : "+v"(tid));
      if (tid == 0) { unsigned sp = 0; while (__hip_atomic_load(F.ctl + CW_P0PUB, RLX_AGENT) < (unsigned)F.G) { __builtin_amdgcn_s_sleep(1); if (++sp > (1u << 22)) break; }
          __builtin_amdgcn_fence(__ATOMIC_ACQUIRE, "agent"); asm volatile("s_waitcnt vmcnt(0)" ::: "memory"); }
      __syncthreads();
      norm_phase<0, false>(F, args.in[0], args.in[4], MOD, 0, 2048, HN, (const float*)(ws + WS_GWT), args.in[8], (float*)(ws + WS_GATES), nullptr, nullptr);
      const int cv0 = (F.G == 256 ? P0_TILE0 : 0) + F.bid;
      convert_tiles(F, args, cv0 + 2 * F.G, NT_ALL - QCVT_N, F.G); }
    GRID_BAR();
    { Dims g{DM, DM, DM}; DenseOrder S; S.init(NTOK, DINP, F.G, F.bid, HN, ws + WS_WIN, DM, DM); EpiBf16 E{(bf16*)(ws + WS_PROJ), DINP};
      gemm_phase<EpiBf16, DenseOrder, true, true>(ring, g, S, E);
      if (TAILQ2 > 0 && F.G == 256 && (long)((S.nwg + F.G - 1) / F.G - 1) * F.G + F.bid >= S.nwg) { const int k = F.bid - (S.nwg % F.G); convert_tiles(F, args, k, 128 * TAILQ2, 128); } }
    GRID_BAR();
    prep_phase(F, args);
    GRID_BAR();
    { const int hg = F.G / 2, lo = (F.bid < hg) ? F.bid : -1, hi = (F.bid >= hg) ? F.bid - hg : -1;
      { Dims g{256, 256, 256}; BatchOrder S{NUNIT, hg, lo, (const char*)(ws + WS_QB), (const char*)(ws + WS_KB), (size_t)256 * 256 * 2, (size_t)256 * 256 * 2};
        EpiW E{(bf16*)(ws + WS_AP), (const float*)(ws + WS_BCUM), (const float*)(ws + WS_IG)};
        gemm_phase<EpiW, BatchOrder, true, true>(ring, g, S, E); }
      { Dims g{512, 256, 256}; BatchOrder S{NUNIT, F.G - hg, hi, (const char*)(ws + WS_BP) + 512, (const char*)(ws + WS_KWT), (size_t)256 * 512 * 2, (size_t)256 * 256 * 2};
        EpiDC E{(float*)(ws + WS_DCT)};
        gemm_phase<EpiDC, BatchOrder, true, true>(ring, g, S, E);
        if (TAILQ4 > 0 && F.G == 256 && hi >= 0) convert_tiles(F, args, 128 * (TAILQ2 + TAILQ10 + TAILQ6) + hi, 128 * (TAILQ2 + TAILQ10 + TAILQ6 + TAILQ4), 128); }
      { Dims g{1024, 256, 256}; PoolOrder S{hg, lo, (const char*)(ws + WS_POOLED), (const char*)(ws + WS_POOLW)};
        EpiPool E{(bf16*)(ws + WS_MIXCAT), args.in[13]};
        gemm_phase<EpiPool, PoolOrder, true, true>(ring, g, S, E); } }
    GRID_BAR();
    scan_phase(F);
    GRID_BAR();
    { LAS float* sDen = (LAS float*)(F.lds + RING_OFF + RING_BYTES); LAS float* sSS = sDen + 256;
      if (F.bid < NUNIT) {
          int tid = threadIdx.x; asm volatile("" : "+v"(tid)); const int lane = tid & 63, wave = __builtin_amdgcn_readfirstlane(tid >> 6);
          const bf16* ap0 = (const bf16*)(ws + WS_AP) + (size_t)F.bid * 256 * 512; const f32x4 nv = *(const f32x4*)((const float*)(ws + WS_NVEC) + F.bid * 256 + 4 * lane);
          { const int r0 = wave * 32;
              v2u qa[32], wa[32];
#pragma unroll
              for (int i = 0; i < 32; ++i) { const bf16* ap = ap0 + (size_t)(r0 + i) * 512; qa[i] = *(const v2u*)(ap + 4 * lane); wa[i] = *(const v2u*)(ap + 256 + 4 * lane); }
#pragma unroll
              for (int i = 0; i < 32; ++i) {
                  const float part = bflo(qa[i].x) * nv.x + bfhi(qa[i].x) * nv.y + bflo(qa[i].y) * nv.z + bfhi(qa[i].y) * nv.w + (bflo(wa[i].x) + bfhi(wa[i].x)) + (bflo(wa[i].y) + bfhi(wa[i].y));
                  const float den = wave_sum(part);
                  if (lane == 0) sDen[r0 + i] = 1.0f / fmaxf(fabsf(den), 1.0f); } }
      }
      Dims g{512, 512, 512}; BatchOrder S{NUNIT, F.G, F.bid, (const char*)(ws + WS_AP), (const char*)(ws + WS_BP), (size_t)256 * 512 * 2, (size_t)256 * 512 * 2};
      EpiFin E{(bf16*)(ws + WS_MIXCAT), (const bf16*)(ws + WS_PROJ), DINP, args.in[11], sDen, sSS, EPS};
      gemm_phase<EpiFin, BatchOrder, true, true>(ring, g, S, E);
      if (F.G == 256 && F.bid < NUNIT) { int tid = threadIdx.x; asm volatile("" : "+v"(tid));
          asm volatile("s_waitcnt vmcnt(0)" ::: "memory"); __syncthreads();
          if (tid == 0) __hip_atomic_fetch_add(F.ctl + CW_PAN6 + 64 * ((F.bid >> 6) * 16 + (F.bid & 15)), 1u, RLX_AGENT); }
      if (TAILQ6 > 0 && F.G == 256 && F.bid >= NUNIT) convert_tiles(F, args, 128 * (TAILQ2 + TAILQ10) + (F.bid - NUNIT), 128 * (TAILQ2 + TAILQ10 + TAILQ6), 128); }
    if (F.G != 256) GRID_BAR();
    { Dims g{DM, DM, DM}; DenseOrderA S; S.init(NTOK, DM, F.G, F.bid, ws + WS_MIXCAT, ws + WS_WOUT, DM, DM); S.ready = F.ctl + CW_PAN6; S.need = (F.G == 256) ? 4u : 0u; EpiResid<false> E{args.in[0], XR, MOD + 4096, 1.0f};
      gemm_phase<EpiResid<false>, DenseOrderA, true, true>(ring, g, S, E);
      Unit u0; const bool has = S.next(0, u0);
      if (F.G == 256 && S.nwg == F.G) panel_handoff(F.ctl + CW_PAN8, u0.pm, has, F.bid >> 3, 8u); else GRID_BAR(); }
    norm_phase<1, true, true>(F, XR, args.in[5], MOD, 6144, 8192, HN, nullptr, nullptr, nullptr, nullptr, nullptr);
    GRID_BAR();
    { Dims g{DM / 2, DM / 2, DM / 2}; DenseOrder S; S.init(NTOK, 2 * DFF, F.G, F.bid, HN, ws + WS_W13, DM / 2, DM / 2); EpiSwiglu8 E{ws + WS_U, DFF, 1 << 20, 1.0f / WS8};
      gemm_phase<EpiSwiglu8, DenseOrder, true, true, true>(ring, g, S, E);
      if (TAILQ10 > 0 && F.G == 256 && (long)((S.nwg + F.G - 1) / F.G - 1) * F.G + F.bid >= S.nwg) { const int k = F.bid - (S.nwg % F.G); convert_tiles(F, args, 128 * TAILQ2 + k, 128 * (TAILQ2 + TAILQ10), 128); } }
    GRID_BAR();
    { Dims g{DFF / 2, DFF / 2, DFF / 2}; DenseOrder S; S.init(NTOK, DM, F.G, F.bid, ws + WS_U, ws + WS_W2, DFF / 2, DFF / 2); EpiResid<true> E{XR, XR, MOD + 10240, 1.0f / WS8};
      gemm_phase<EpiResid<true>, DenseOrder, true, true, true>(ring, g, S, E);
      Unit u0; const bool has = S.next(0, u0);
      if (F.G == 256 && S.nwg == F.G) panel_handoff(F.ctl + CW_PAN11, u0.pm, has, F.bid >> 3, 8u); else GRID_BAR(); }
    const float* MOD1 = MOD + 2 * 12288;
    norm_phase<1, true>(F, XR, args.in[4] + DM, MOD1, 0, 2048, HN, nullptr, nullptr, nullptr, nullptr, nullptr);
    GRID_BAR();
    { Dims g{DM, DM, DM}; DenseOrder S; S.init(NTOK, 2 * DM, F.G, F.bid, HN, ws + WS_WQKV, DM, DM); EpiQKblk E{(bf16*)(ws + WS_QB2), (bf16*)(ws + WS_KB2), 0.08838834764831845f * 1.4426950408889634f};
      gemm_phase<EpiQKblk, DenseOrder, true, true>(ring, g, S, E); }
    { Dims g{DM, DM, DM}; DenseOrder S; S.init(DM, NTOK, F.G, F.bid, ws + WS_WQKV + (size_t)2 * DM * DM * 2, HN, DM, DM); EpiVblk E{(bf16*)(ws + WS_VT)};
      gemm_phase<EpiVblk, DenseOrder, true, true>(ring, g, S, E); }
    GRID_BAR();
    attn_phase(F);
    GRID_BAR();
    { Dims g{DM, DM, DM}; DenseOrder S; S.init(NTOK, DM, F.G, F.bid, ws + WS_ATTO, ws + WS_WO, DM, DM); EpiResid<true> E{XR, XR, MOD1 + 4096, 1.0f};
      gemm_phase<EpiResid<true>, DenseOrder, true, true>(ring, g, S, E);
      Unit u0; const bool has = S.next(0, u0);
      if (F.G == 256 && S.nwg == F.G) panel_handoff(F.ctl + CW_PAN15, u0.pm, has, F.bid >> 3, 8u); else GRID_BAR(); }
    if (F.G * NWAVES * 4 >= NTOK) {
        route_phase(F, XR, args.in[5] + DM, MOD1, 6144, 8192, (const float*)(ws + WS_RWT), F.ctl + CW_CNT, F.ctl + CW_RDONE);
    } else {
        norm_phase<2, true>(F, XR, args.in[5] + DM, MOD1, 6144, 8192, HN, (const float*)(ws + WS_RWT), nullptr, nullptr, (unsigned*)(ws + WS_TOKINFO), F.ctl + CW_CNT);
        GRID_BAR();
        gather_phase(F);
    }
    GRID_BAR();
    { int base[8], cn[8]; moe_bases(F.ctl + CW_CNT, base, cn);
      MoeOrder S; S.G = F.G; S.c = F.bid;
#pragma unroll
      for (int e = 0; e < 8; ++e) S.cumP[e] = base[e] >> 8;
      S.cumP[8] = (base[7] + ((cn[7] + 255) & ~255)) >> 8;
      { S.nNl = 56; S.A = (const char*)(ws + WS_HPERM); S.Bt = (const char*)(ws + WS_W13E); S.tsa = (size_t)256 * DM; S.tsb = (size_t)256 * DM;
        Dims g{DM / 2, DM / 2, DM / 2}; EpiSwiglu8 E{ws + WS_UE, DFE, 56, 1.0f / WS8};
        gemm_phase<EpiSwiglu8, MoeOrder, true, true, true>(ring, g, S, E); }
      convert_tiles<true>(F, args, QCVT_LO, QCVT_LO + QCVT_N, 0, F.ctl + CW_QCVT);
      GRID_BAR();
      { const int Ptot = S.cumP[8];
        SplitOrder T; T.G = F.G; T.c = F.bid; T.A = (const char*)(ws + WS_UE); T.Bt = (const char*)(ws + WS_W2E); T.tsa = (size_t)256 * DFE; T.tsb = (size_t)256 * DFE; T.kq_bytes = DFE / 4;
#pragma unroll
        for (int e = 0; e < 9; ++e) { T.cumP[e] = S.cumP[e]; S.cumP[e] = S.cumP[e] < 64 ? S.cumP[e] : 64; }
        (void)Ptot;
        S.nNl = 8; S.A = (const char*)(ws + WS_UE); S.Bt = (const char*)(ws + WS_W2E); S.tsa = (size_t)256 * DFE; S.tsb = (size_t)256 * DFE;
        { Dims g{DFE / 2, DFE / 2, DFE / 2}; EpiY E{(bf16*)(ws + WS_Y), (const float*)(ws + WS_SLOTGATE), 1.0f / WS8};
          gemm_phase<EpiY, MoeOrder, true, true, true>(ring, g, S, E); }
        { Dims g{DFE / 2, DFE / 2, DFE / 8}; EpiYp E{(bf16*)(ws + WS_YP), (const float*)(ws + WS_SLOTGATE), 1.0f / WS8};
          gemm_phase<EpiYp, SplitOrder, true, true, true>(ring, g, T, E); } }
    }
    GRID_BAR();
    final_phase(F, args);
#endif
}

extern "C" void kernel_launch(void* const* d_in, const int* in_sizes, int n_in, void* d_out, int out_size, void* d_ws, size_t ws_size, hipStream_t stream) {
    static int grid = 0;
    if (grid == 0) {
        if (n_in != 24 || out_size != NTOK * DM || ws_size < WS_END) { fprintf(stderr, "kernel_launch: unexpected shapes (n_in %d, out %d, ws %zu < %zu); nothing launched\n", n_in, out_size, ws_size, (size_t)WS_END); grid = -1; return; }
        int dev = 0, cus = 0, per_cu = 0;
        if (hipGetDevice(&dev) != hipSuccess || hipDeviceGetAttribute(&cus, hipDeviceAttributeMultiprocessorCount, dev) != hipSuccess) { grid = -1; return; }
        if (hipFuncSetAttribute((const void*)hybrid_fwd, hipFuncAttributeMaxDynamicSharedMemorySize, LDS_BYTES) != hipSuccess) { fprintf(stderr, "kernel_launch: hipFuncSetAttribute failed\n"); grid = -1; return; }
        if (hipOccupancyMaxActiveBlocksPerMultiprocessor(&per_cu, (const void*)hybrid_fwd, NWAVES * 64, LDS_BYTES) != hipSuccess || per_cu < 1)
            fprintf(stderr, "kernel_launch: note: occupancy query reports %d workgroups per CU\n", per_cu);
        (void)hipGetLastError();
        grid = cus;
    }
    if (grid < 0) return;
    if (hipMemsetAsync((char*)d_ws + WS_CTL, 0, CTL_ZERO_BYTES, stream) != hipSuccess) return;
    Args a{};
    for (int i = 0; i < 24; ++i) a.in[i] = (const float*)d_in[i];
    a.out = (float*)d_out; a.ws = (unsigned char*)d_ws;
    hipLaunchKernelGGL(hybrid_fwd, dim3(grid), dim3(NWAVES * 64), LDS_BYTES, stream, a);
    const hipError_t le = hipPeekAtLastError();
    if (le != hipSuccess) fprintf(stderr, "kernel_launch: launch failed: %s\n", hipGetErrorName(le));
}
```
